# Optimizing an MI355X kernel written in HIP

```python
import jax
import jax.numpy as jnp
from jax import lax
import numpy as np

D_MODEL = 1024
BATCH = 2
SEQ = 8192
DEPTH = 1
DEC_BATCH = 128
DEC_SEQ = 8
PAST_LEN = 8192
PAGE_SIZE = 128

MIX_W = D_MODEL
ML_W = MIX_W // 2
MLA_W = MIX_W - ML_W
ML_DK = 128
ML_DV = 128
ML_H = ML_W // ML_DV
MLA_VD = 64
MLA_H = MLA_W // MLA_VD
MLA_NOPE = 64
MLA_ROPE = 32
MLA_SCALE = (MLA_NOPE + MLA_ROPE) ** -0.5
Q_LORA = 3 * D_MODEL // 8
KV_LORA = D_MODEL // 4
ROPE_THETA = 10000.0
ML_CHUNK = 128
Q_BLOCK = 128
EPS = 1e-6
ALPHA = (2.0 * DEPTH) ** 0.25
BETA = (8.0 * DEPTH) ** -0.25
IN_SIZES = (ML_H * ML_DK, ML_H * ML_DK, ML_W, ML_H, ML_H, ML_W, ML_W, Q_LORA, KV_LORA, MLA_ROPE, MLA_W)
IN_OFFS = tuple(int(o) for o in np.cumsum(IN_SIZES)[:-1])
N_IN = int(sum(IN_SIZES))

kernel_name = 'hymba_mlstm_mla_deepnorm_adaln_step'


def _layernorm(x, g, b):
    xf = x.astype(jnp.float32)
    mu = jnp.mean(xf, -1, keepdims=True)
    var = jnp.mean(jnp.square(xf - mu), -1, keepdims=True)
    return ((xf - mu) * lax.rsqrt(var + EPS) * g + b).astype(x.dtype)


def _rmsnorm(x, g):
    xf = x.astype(jnp.float32)
    return (xf * lax.rsqrt(jnp.mean(xf * xf, -1, keepdims=True) + EPS) * g).astype(x.dtype)


def _rope(x, pos):
    half = MLA_ROPE // 2
    inv = ROPE_THETA ** (-jnp.arange(half, dtype=jnp.float32) / half)
    ang = pos.astype(jnp.float32)[:, None] * inv[None, :]
    shape = (x.shape[1],) + (1,) * (x.ndim - 3) + (half,)
    cos = jnp.cos(ang).reshape(shape)
    sin = jnp.sin(ang).reshape(shape)
    xf = x.astype(jnp.float32)
    x1, x2 = xf[..., :half], xf[..., half:]
    return jnp.concatenate([x1 * cos - x2 * sin, x2 * cos + x1 * sin], -1).astype(x.dtype)


def _front(x, c, pos, w_ada, b_ada, w_in, ml_b_i, ml_b_f, mla_q_norm, mla_kv_norm, mla_w_uq, mla_w_uk):
    B, S, _ = x.shape
    f32 = jnp.float32
    shift, scale, gate = jnp.split(c @ w_ada + b_ada, 3, axis=-1)
    h = x * (1.0 + scale[:, None, :]) + shift[:, None, :]
    mq, mk, mv, mi, mf, mo, mz, cq, ckv, kr, az = jnp.split(h @ w_in, IN_OFFS, axis=-1)

    def heads(t, d):
        return jnp.moveaxis(t.reshape(B, S, ML_H, d), 2, 1).astype(f32)

    q = heads(mq, ML_DK)
    k = heads(mk, ML_DK) * (ML_DK ** -0.5)
    v = heads(mv, ML_DV)
    ig = jnp.moveaxis((mi + ml_b_i).astype(f32), 2, 1)
    lf = jax.nn.log_sigmoid(jnp.moveaxis((mf + ml_b_f).astype(f32), 2, 1))
    cq = _rmsnorm(cq, mla_q_norm)
    qh = (cq @ mla_w_uq).reshape(B, S, MLA_H, MLA_NOPE + MLA_ROPE)
    q_rope = _rope(qh[..., MLA_NOPE:], pos)
    q_lat = jnp.einsum('bshn,chn->bshc', qh[..., :MLA_NOPE],
                       mla_w_uk.reshape(KV_LORA, MLA_H, MLA_NOPE))
    ckv = _rmsnorm(ckv, mla_kv_norm)
    kr = _rope(kr, pos)
    return gate, (q, k, v, ig, lf), mo, mz, q_lat, q_rope, ckv, kr, az


def _mlstm_chunk(carry, inp):
    C, n, m = carry
    q, k, v, ig, lf = inp
    L = q.shape[2]
    F = jnp.cumsum(lf, axis=-1)
    causal = jnp.tril(jnp.ones((L, L), bool))
    D = jnp.where(causal, F[..., :, None] - F[..., None, :] + ig[..., None, :], -jnp.inf)
    m_inter = F + m[..., None]
    m_t = jnp.maximum(m_inter, jnp.max(D, -1))
    W = jnp.exp(D - m_t[..., None])
    a = jnp.exp(m_inter - m_t)
    Sq = jnp.einsum('bhtd,bhsd->bhts', q, k) * W
    num = jnp.einsum('bhts,bhsv->bhtv', Sq, v) + a[..., None] * jnp.einsum('bhtd,bhdv->bhtv', q, C)
    den = jnp.sum(Sq, -1) + a * jnp.einsum('bhtd,bhd->bht', q, n)
    h = num / jnp.maximum(jnp.abs(den), jnp.exp(-m_t))[..., None]
    wl = W[..., -1, :]
    al = a[..., -1]
    C_new = al[..., None, None] * C + jnp.einsum('bhs,bhsd,bhsv->bhdv', wl, k, v)
    n_new = al[..., None] * n + jnp.einsum('bhs,bhsd->bhd', wl, k)
    return (C_new, n_new, m_t[..., -1]), h


def _mlstm(mlin, C0, n0, m0, chunk):
    q = mlin[0]
    B, H, S, _ = q.shape
    nc = S // chunk

    def to_chunks(t):
        return jnp.moveaxis(t.reshape((B, H, nc, chunk) + t.shape[3:]), 2, 0)

    (C, n, m), h = lax.scan(_mlstm_chunk, (C0, n0, m0), tuple(to_chunks(t) for t in mlin))
    h = jnp.moveaxis(h, 0, 2).reshape(B, H, S, ML_DV)
    return h, C, n, m


def _mla_scores(q_lat, q_rope, ckv, kr):
    s = jnp.einsum('bqhc,bkc->bhqk', q_lat, ckv) + jnp.einsum('bqhr,bkr->bhqk', q_rope, kr)
    return s.astype(jnp.float32) * MLA_SCALE


def _mla_prompt(q_lat, q_rope, ckv, kr):
    B, S = q_lat.shape[:2]
    qb = min(Q_BLOCK, S)
    nb = S // qb

    def blk(t):
        return jnp.moveaxis(t.reshape((B, nb, qb) + t.shape[2:]), 1, 0)

    kpos = jnp.arange(S)

    def one(args):
        ql, qr, i = args
        s = _mla_scores(ql, qr, ckv, kr)
        qpos = i * qb + jnp.arange(qb)
        s = jnp.where(kpos[None, :] <= qpos[:, None], s, -jnp.inf)
        p = jax.nn.softmax(s, axis=-1).astype(ckv.dtype)
        return jnp.einsum('bhqk,bkc->bqhc', p, ckv)

    o = lax.map(one, (blk(q_lat), blk(q_rope), jnp.arange(nb)))
    return jnp.moveaxis(o, 0, 1).reshape(B, S, MLA_H, KV_LORA)


def _mla_sample(q_lat, q_rope, ckv, kr, pool_ckv, pool_kr, page_table):
    B, S = q_lat.shape[:2]
    past_ckv = pool_ckv[page_table].reshape(B, -1, KV_LORA)
    past_kr = pool_kr[page_table].reshape(B, -1, MLA_ROPE)
    P = past_ckv.shape[1]
    s_past = _mla_scores(q_lat, q_rope, past_ckv, past_kr)
    s_new = _mla_scores(q_lat, q_rope, ckv, kr)
    s_new = jnp.where(jnp.tril(jnp.ones((S, S), bool)), s_new, -jnp.inf)
    p = jax.nn.softmax(jnp.concatenate([s_past, s_new], -1), axis=-1)
    o = (jnp.einsum('bhqk,bkc->bqhc', p[..., :P].astype(past_ckv.dtype), past_ckv)
         + jnp.einsum('bhqk,bkc->bqhc', p[..., P:].astype(ckv.dtype), ckv))
    return o


def _back(x, gate, h_ml, mo, mz, o_lat, az, ml_gn, mla_w_uv, w_out, ln_g, ln_b):
    B, S, _ = x.shape
    hm = jnp.moveaxis(h_ml, 1, 2)
    hm = hm * jax.nn.sigmoid(mo.astype(jnp.float32)).reshape(B, S, ML_H, ML_DV)
    mu = jnp.mean(hm, -1, keepdims=True)
    var = jnp.mean(jnp.square(hm - mu), -1, keepdims=True)
    hm = ((hm - mu) * lax.rsqrt(var + EPS)).reshape(B, S, ML_W) * ml_gn
    y_ml = hm.astype(x.dtype) * jax.nn.silu(mz)
    o_mla = jnp.einsum('bshc,chv->bshv', o_lat, mla_w_uv.reshape(KV_LORA, MLA_H, MLA_VD)).reshape(B, S, MLA_W)
    y_mla = o_mla * jax.nn.silu(az)
    out = jnp.concatenate([y_ml, y_mla], -1) @ w_out
    return _layernorm(ALPHA * x + gate[:, None, :] * out, ln_g, ln_b)


def setup_inputs(seed: int = 0) -> dict:
    key = jax.random.key(seed)
    ks = jax.random.split(key, 32)
    f32 = jnp.float32

    def nrm(k, shape, s=1.0):
        return jax.random.normal(k, shape, f32) * s

    n_pages = PAST_LEN // PAGE_SIZE
    n_used = DEC_BATCH * n_pages
    n_pool = n_used + max(1, n_used // 4)
    page_table = jax.random.permutation(ks[0], n_pool)[:n_used].reshape(DEC_BATCH, n_pages).astype(jnp.int32)
    Dm = D_MODEL
    return {
        'x_prompt': nrm(ks[1], (BATCH, SEQ, Dm)),
        'x_sample': nrm(ks[2], (DEC_BATCH, DEC_SEQ, Dm)),
        'c_prompt': nrm(ks[3], (BATCH, Dm)),
        'c_sample': nrm(ks[4], (DEC_BATCH, Dm)),
        'cache_ckv': nrm(ks[5], (DEPTH, n_pool, PAGE_SIZE, KV_LORA)),
        'cache_krope': nrm(ks[6], (DEPTH, n_pool, PAGE_SIZE, MLA_ROPE)),
        'state_C': nrm(ks[7], (DEPTH, DEC_BATCH, ML_H, ML_DK, ML_DV), 0.1),
        'state_n': jnp.abs(nrm(ks[8], (DEPTH, DEC_BATCH, ML_H, ML_DK), 0.5)),
        'state_m': nrm(ks[9], (DEPTH, DEC_BATCH, ML_H)),
        'page_table': page_table,
        'w_ada': nrm(ks[10], (DEPTH, Dm, 3 * Dm), 0.5 * Dm ** -0.5),
        'b_ada': nrm(ks[11], (DEPTH, 3 * Dm), 0.02),
        'w_in': nrm(ks[12], (DEPTH, Dm, N_IN), Dm ** -0.5),
        'ml_b_i': nrm(ks[13], (DEPTH, ML_H), 0.1),
        'ml_b_f': jnp.broadcast_to(jnp.linspace(3.0, 6.0, ML_H, dtype=f32), (DEPTH, ML_H)) + nrm(ks[14], (DEPTH, ML_H), 0.01),
        'ml_gn': 1.0 + nrm(ks[15], (DEPTH, ML_W), 0.02),
        'mla_q_norm': 1.0 + nrm(ks[16], (DEPTH, Q_LORA), 0.02),
        'mla_kv_norm': 1.0 + nrm(ks[17], (DEPTH, KV_LORA), 0.02),
        'mla_w_uq': nrm(ks[18], (DEPTH, Q_LORA, MLA_H * (MLA_NOPE + MLA_ROPE)), Q_LORA ** -0.5),
        'mla_w_uk': nrm(ks[19], (DEPTH, KV_LORA, MLA_H * MLA_NOPE), KV_LORA ** -0.5),
        'mla_w_uv': nrm(ks[20], (DEPTH, KV_LORA, MLA_H * MLA_VD), KV_LORA ** -0.5),
        'w_out': nrm(ks[21], (DEPTH, MIX_W, Dm), BETA * MIX_W ** -0.5),
        'ln_g': 1.0 + nrm(ks[22], (DEPTH, Dm), 0.02),
        'ln_b': nrm(ks[23], (DEPTH, Dm), 0.02),
    }


def reference(x_prompt, x_sample, c_prompt, c_sample, cache_ckv, cache_krope, state_C, state_n, state_m,
              page_table, w_ada, b_ada, w_in, ml_b_i, ml_b_f, ml_gn, mla_q_norm, mla_kv_norm,
              mla_w_uq, mla_w_uk, mla_w_uv, w_out, ln_g, ln_b):
    f32 = jnp.float32
    B, S, _ = x_prompt.shape
    DB, DS, _ = x_sample.shape
    past = page_table.shape[1] * PAGE_SIZE
    pos_p = jnp.arange(S)
    pos_s = past + jnp.arange(DS)
    xp, xs = x_prompt, x_sample
    ckv_p_l, kr_p_l, Cp_l, np_l, mp_l = [], [], [], [], []
    ckv_s_l, kr_s_l, Cs_l, ns_l, ms_l = [], [], [], [], []
    for l in range(DEPTH):
        fw = (w_ada[l], b_ada[l], w_in[l], ml_b_i[l], ml_b_f[l], mla_q_norm[l], mla_kv_norm[l], mla_w_uq[l], mla_w_uk[l])
        bw = (ml_gn[l], mla_w_uv[l], w_out[l], ln_g[l], ln_b[l])
        gate, mlin, mo, mz, q_lat, q_rope, ckv, kr, az = _front(xp, c_prompt, pos_p, *fw)
        C0 = jnp.zeros((B, ML_H, ML_DK, ML_DV), f32)
        n0 = jnp.zeros((B, ML_H, ML_DK), f32)
        m0 = jnp.full((B, ML_H), -jnp.inf, f32)
        h_ml, Cp, n_p, mp = _mlstm(mlin, C0, n0, m0, min(ML_CHUNK, S))
        o_lat = _mla_prompt(q_lat, q_rope, ckv, kr)
        yp = _back(xp, gate, h_ml, mo, mz, o_lat, az, *bw)
        ckv_p_l.append(ckv)
        kr_p_l.append(kr)
        Cp_l.append(Cp.astype(state_C.dtype))
        np_l.append(n_p.astype(state_n.dtype))
        mp_l.append(mp.astype(state_m.dtype))
        gate, mlin, mo, mz, q_lat, q_rope, ckv, kr, az = _front(xs, c_sample, pos_s, *fw)
        h_ml, Cs, n_s, ms = _mlstm(mlin, state_C[l].astype(f32), state_n[l].astype(f32), state_m[l].astype(f32), DS)
        o_lat = _mla_sample(q_lat, q_rope, ckv, kr, cache_ckv[l], cache_krope[l], page_table)
        ys = _back(xs, gate, h_ml, mo, mz, o_lat, az, *bw)
        ckv_s_l.append(ckv.astype(cache_ckv.dtype))
        kr_s_l.append(kr.astype(cache_krope.dtype))
        Cs_l.append(Cs.astype(state_C.dtype))
        ns_l.append(n_s.astype(state_n.dtype))
        ms_l.append(ms.astype(state_m.dtype))
        xp, xs = yp, ys
    ckv_prompt = jnp.stack(ckv_p_l)
    krope_prompt = jnp.stack(kr_p_l)
    C_prompt = jnp.stack(Cp_l)
    n_prompt = jnp.stack(np_l)
    m_prompt = jnp.stack(mp_l)
    ckv_sample = jnp.stack(ckv_s_l)
    krope_sample = jnp.stack(kr_s_l)
    C_sample = jnp.stack(Cs_l)
    n_sample = jnp.stack(ns_l)
    m_sample = jnp.stack(ms_l)
    return (xp, xs, ckv_prompt, krope_prompt, C_prompt, n_prompt, m_prompt,
            ckv_sample, krope_sample, C_sample, n_sample, m_sample)
```

```cpp
#include <hip/hip_runtime.h>
#include <cstdio>
#include <cstdint>
#include <cmath>

constexpr int D = 1024, BP = 2, SP = 8192, MP = BP * SP, DB = 128, DS = 8, MS = DB * DS, MT = MP + MS;
constexpr int NIN = 3752, NINP = 3840;
constexpr int QL = 384, KVL = 256, ROPE = 32, NOPE = 64, MH = 8, VD = 64, QHD = NOPE + ROPE;
constexpr int LH = 4, DK = 128, DV = 128, LC = 128, NCH = SP / LC;
constexpr int PAGE = 128, NPAGES = 64, PAST = 8192;
constexpr float EPS = 1e-6f, ALPHA = 1.189207115002721f, MLA_SCALE = 0.10206207261596575f  , KSCALE = 0.08838834764831845f  ;
constexpr int ZQ = 0, ZK = 512, ZV = 1024, ZO = 1536, ZZ = 2048, ZAZ = 2560, ZCKV = 3072, ZCQ = 3328, ZKR = 3712, ZMI = 3744, ZMF = 3748;
constexpr size_t O_YP = 0, O_YS = 16777216, O_CKVP = 17825792, O_KRP = 22020096, O_CP = 22544384, O_NP = 22675456, O_MPR = 22676480,
                 O_CKVS = 22676488, O_KRS = 22938632, O_CS = 22971400, O_NS = 31360008, O_MS = 31425544, O_END = 31426056;
constexpr size_t MiB = 1u << 20;
constexpr size_t WS_CTL = 0, WS_MOD = 1 * MiB, WS_WIN = 4 * MiB, WS_WUQ = 12 * MiB, WS_WKV = 13 * MiB, WS_WOUT = 14 * MiB, WS_H = 16 * MiB,
                 WS_Z = 64 * MiB, WS_CQN = 320 * MiB, WS_CKVN = 336 * MiB, WS_QH = 352 * MiB, WS_KVU = 416 * MiB, WS_KRR = 480 * MiB, WS_QLAT = 484 * MiB,
                 WS_OLAT = 492 * MiB, WS_OMLA = 500 * MiB, WS_HML = 536 * MiB, WS_MLG = 572 * MiB, WS_MLU = 573 * MiB, WS_MLDC = 576 * MiB, WS_MLDN = 608 * MiB,
                 WS_MLCS = 612 * MiB, WS_MLNS = 644 * MiB, WS_MLMS = 646 * MiB, WS_YCAT = 648 * MiB, WS_OUT = 684 * MiB, WS_END = 752 * MiB;

__host__ __device__ __forceinline__ int zsrc(int j) {
    if (j < 1536) return j;
    if (j < 2560) return j + 8;
    if (j < 3072) return 3240 + (j - 2560);
    if (j < 3328) return 2952 + (j - 3072);
    if (j < 3712) return 2568 + (j - 3328);
    if (j < 3744) return 3208 + (j - 3712);
    if (j < 3752) return 1536 + (j - 3744);
    return -1;
}
__device__ __forceinline__ unsigned short f2bf(float f) { unsigned u = __builtin_bit_cast(unsigned, f); return (unsigned short)((u + 0x7fffu + ((u >> 16) & 1u)) >> 16); }
__device__ __forceinline__ float bf2f(unsigned short h) { return __builtin_bit_cast(float, (unsigned)h << 16); }
__device__ __forceinline__ float wave_sum(float v) {
#pragma unroll
    for (int o = 1; o < 64; o <<= 1) v += __shfl_xor(v, o);
    return v;
}
__device__ __forceinline__ float wave_max(float v) {
#pragma unroll
    for (int o = 1; o < 64; o <<= 1) v = fmaxf(v, __shfl_xor(v, o));
    return v;
}
__device__ __forceinline__ float sigmoidf_(float x) { return 1.f / (1.f + __expf(-x)); }
__device__ __forceinline__ float siluf_(float x) { return x / (1.f + __expf(-x)); }
__device__ __forceinline__ float logsigmoidf_(float x) { return x >= 0.f ? -log1pf(expf(-x)) : x - log1pf(expf(x)); }
__device__ __forceinline__ int row_pos(int m) { return m < MP ? (m & (SP - 1)) : PAST + ((m - MP) & (DS - 1)); }
__device__ __forceinline__ int row_modrow(int m) { return m < MP ? (m >> 13) : 2 + ((m - MP) >> 3); }
namespace pg8 {
#define PG8_LAS __attribute__((address_space(3)))
typedef unsigned short bf16_t;
typedef short bf16x8 __attribute__((ext_vector_type(8)));
typedef float f32x4 __attribute__((ext_vector_type(4)));
typedef unsigned u32x4 __attribute__((ext_vector_type(4)));
constexpr int BM = 256, BK = 64, HALF = 128, HTB = HALF * BK * 2  , STAGE_BYTES = 8 * HTB, NXCD = 8, WGM = 8;

__host__ __device__ __forceinline__ int lds_byte(int r, int c) { const int st = (r >> 4) * 2 + (c >> 5), rr = r & 15, cc = c & 31, ob = rr * 64 + cc * 2; return st * 1024 + (ob ^ (((ob >> 9) & 1) << 5)); }
__host__ __device__ __forceinline__ void stage_rc(int b, int& R, int& C) { const int st = b / 1024, sb = b % 1024, swz = sb ^ (((sb >> 9) & 1) << 5); R = (st >> 1) * 16 + swz / 64; C = (st & 1) * 32 + (swz % 64) / 2; }
__host__ __device__ __forceinline__ int perm32(int rho) { const int n = rho >> 4, i = rho & 15; return 8 * (i >> 2) + 4 * n + (i & 3); }

struct Unit { int pm, pn; };
struct Gemm { const bf16_t* A; const bf16_t* Bt; int M, N, K; };

struct StaticOrder {
    int nM, nN, nwg, G, c;
    __host__ __device__ void init(int M, int N, int G_, int c_) { nM = M / BM; nN = N / BM; nwg = nM * nN; G = G_; c = c_; }
    __host__ __device__ bool next(int i, Unit& u) const {
        const long L = (long)i * G + c; if (L >= nwg) return false;
        int wgid = (int)L; { const int q = nwg / NXCD, r = nwg % NXCD, xcd = wgid % NXCD, off = wgid / NXCD; wgid = (xcd < r ? xcd * (q + 1) : r * (q + 1) + (xcd - r) * q) + off; }
        const int nig = WGM * nN, gid = wgid / nig, fm = gid * WGM, gsz = (nM - fm) < WGM ? (nM - fm) : WGM;
        u.pm = fm + ((wgid % nig) % gsz); u.pn = (wgid % nig) / gsz; return true;
    }
    __device__ __forceinline__ void a_ready(const Unit&) const {}
    __device__ __forceinline__ void done(const Unit&) const {}
};

__device__ __forceinline__ unsigned cvt_pk_bf16(float lo, float hi) { unsigned r; asm volatile("v_cvt_pk_bf16_f32 %0, %1, %2" : "=v"(r) : "v"(lo), "v"(hi)); return r; }
struct EpiF32 {
    static constexpr bool PERM = false, AFTER_DRAIN = false;
    float* C; int ldc;
    __device__ __forceinline__ void operator()(const f32x4 (&acc)[2][2][4][2], const Unit& u, int wr, int wc, int fr, int fq) const {
        const int row0 = u.pm * BM + wr * 64 + fr, col0 = u.pn * BM + wc * 32 + 4 * fq;
#pragma unroll
        for (int ai = 0; ai < 2; ++ai)
#pragma unroll
            for (int m = 0; m < 4; ++m) { float* rowp = C + (size_t)(row0 + ai * HALF + m * 16) * ldc + col0;
#pragma unroll
                for (int bj = 0; bj < 2; ++bj)
#pragma unroll
                    for (int n = 0; n < 2; ++n) *(f32x4*)(rowp + bj * HALF + n * 16) = acc[ai][bj][m][n]; }
    }
    __device__ __forceinline__ void fused(f32x4 (&)[2][2][4][2], const Unit&, int, int, int, int, PG8_LAS unsigned char*, int, int) const {}
};
template <class Epi, class Sched, bool ALIGN_EPI = false, bool SP2 = false>
__device__ __forceinline__ void gemm_phase(PG8_LAS unsigned char* lds, const Gemm g, const Sched& S, const Epi& E) {
    const int tid = threadIdx.x, wid = __builtin_amdgcn_readfirstlane(tid >> 6), lane = tid & 63, wr = wid >> 2, wc = wid & 3, fr = lane & 15, fq = lane >> 4;
    const int K = g.K, nt = K / BK;
    unsigned voffA[2], voffB[2];
#pragma unroll
    for (int i = 0; i < 2; ++i) { int R, C; stage_rc(tid * 16 + i * 8192, R, C); const int Rb = Epi::PERM ? ((R & ~31) + perm32(R & 31)) : R;
        voffA[i] = (unsigned)(R * K + C) * 2u; voffB[i] = (unsigned)(Rb * K + C) * 2u; }
    const size_t kstep = (size_t)(BK * 2);
    const size_t hstep = (size_t)HALF * K * 2;
    const size_t tstep = 2 * hstep;
    const unsigned ldsw = (unsigned)wid * 1024u;
    const int aoff = lds_byte(wr * 64 + fr, fq * 8), boff = lds_byte(wc * 32 + fr, fq * 8);
#define PG8_SA(b, h) (((b) * 2 + (h)) * HTB)
#define PG8_SB(b, h) ((4 + (b) * 2 + (h)) * HTB)
#define PG8_STAGE(bufoff, gbase, voff) do { _Pragma("unroll") for (int _i = 0; _i < 2; ++_i) \
        __builtin_amdgcn_global_load_lds((const unsigned*)((const char*)(gbase) + (voff)[_i]), (PG8_LAS unsigned*)(lds + (bufoff) + ldsw + _i * 8192), 16, 0, 0); } while (0)
#define PG8_LDA(dst, b, h) do { _Pragma("unroll") for (int m = 0; m < 4; ++m) _Pragma("unroll") for (int k = 0; k < 2; ++k) dst[m][k] = *(const PG8_LAS bf16x8*)(lds + PG8_SA(b, h) + aoff + m * 2048 + k * 1024); } while (0)
#define PG8_LDB(dst, b, h) do { _Pragma("unroll") for (int n = 0; n < 2; ++n) _Pragma("unroll") for (int k = 0; k < 2; ++k) dst[n][k] = *(const PG8_LAS bf16x8*)(lds + PG8_SB(b, h) + boff + n * 2048 + k * 1024); } while (0)
#define PG8_MMA(ai, bj, At, Bt) do { __builtin_amdgcn_s_setprio(1); _Pragma("unroll") for (int m = 0; m < 4; ++m) _Pragma("unroll") for (int n = 0; n < 2; ++n) _Pragma("unroll") for (int k = 0; k < 2; ++k) \
        acc[ai][bj][m][n] = __builtin_amdgcn_mfma_f32_16x16x32_bf16(Bt[n][k], At[m][k], acc[ai][bj][m][n], 0, 0, 0); __builtin_amdgcn_s_setprio(0); } while (0)
#define PG8_WAIT_V(n) asm volatile("s_waitcnt vmcnt(" #n ")" ::: "memory")
#define PG8_WAIT_L(n) asm volatile("s_waitcnt lgkmcnt(" #n ")" ::: "memory")
#define PG8_BAR __builtin_amdgcn_s_barrier()
#define PG8_SCHED __builtin_amdgcn_sched_barrier(0)
    Unit cur, nxt; int ui = 0;
    if (!S.next(0, cur)) return;
    f32x4 acc[2][2][4][2];
#pragma unroll
    for (int a = 0; a < 2; ++a)
#pragma unroll
        for (int b = 0; b < 2; ++b)
#pragma unroll
            for (int m = 0; m < 4; ++m)
#pragma unroll
                for (int n = 0; n < 2; ++n) acc[a][b][m][n] = (f32x4){0.f, 0.f, 0.f, 0.f};
    bf16x8 At[4][2], B0[2][2], B1[2][2];
    const char* cA = (const char*)g.A + (size_t)cur.pm * tstep; const char* cB = (const char*)g.Bt + (size_t)cur.pn * tstep;
    S.a_ready(cur);
    if constexpr (SP2) {
        PG8_STAGE(PG8_SB(0, 0), cB, voffB); PG8_STAGE(PG8_SB(0, 1), cB + hstep, voffB); PG8_STAGE(PG8_SA(0, 0), cA, voffA); PG8_STAGE(PG8_SA(0, 1), cA + hstep, voffA);
        if (wr == 1) PG8_BAR;
        PG8_WAIT_V(2); PG8_BAR;
        PG8_STAGE(PG8_SB(1, 0), cB + kstep, voffB); PG8_STAGE(PG8_SA(1, 0), cA + kstep, voffA); PG8_STAGE(PG8_SB(1, 1), cB + hstep + kstep, voffB);
        PG8_WAIT_V(6); PG8_BAR;
    } else {
        PG8_STAGE(PG8_SB(0, 0), cB, voffB); PG8_STAGE(PG8_SA(0, 0), cA, voffA); PG8_STAGE(PG8_SB(0, 1), cB + hstep, voffB); PG8_STAGE(PG8_SA(0, 1), cA + hstep, voffA);
        if (wr == 1) PG8_BAR;
        PG8_WAIT_V(4); PG8_BAR;
        PG8_STAGE(PG8_SB(1, 0), cB + kstep, voffB); PG8_STAGE(PG8_SA(1, 0), cA + kstep, voffA); PG8_STAGE(PG8_SB(1, 1), cB + hstep + kstep, voffB);
        PG8_WAIT_V(6); PG8_BAR;
    }
    for (;;) {
        const bool has_next = S.next(ui + 1, nxt);
        const char* nA = has_next ? (const char*)g.A + (size_t)nxt.pm * tstep : cA; const char* nB = has_next ? (const char*)g.Bt + (size_t)nxt.pn * tstep : cB;
        for (int t = 0; t < nt; t += 2) {
            const bool last = (t == nt - 2);
            const char* a1 = cA + (size_t)(t + 1) * kstep;
            const char* a2 = last ? nA : cA + (size_t)(t + 2) * kstep; const char* b2 = last ? nB : cB + (size_t)(t + 2) * kstep;
            const char* a3 = a2 + kstep; const char* b3 = b2 + kstep;
            if (last && has_next) S.a_ready(nxt);
            if constexpr (SP2) {
            PG8_LDB(B0, 0, 0); PG8_LDB(B1, 0, 1); PG8_SCHED; PG8_LDA(At, 0, 0); PG8_STAGE(PG8_SA(1, 1), a1 + hstep, voffA);
            PG8_WAIT_V(8); PG8_WAIT_L(0); PG8_BAR; PG8_MMA(0, 0, At, B0); PG8_MMA(0, 1, At, B1); PG8_BAR; PG8_SCHED;
            PG8_LDA(At, 0, 1); PG8_STAGE(PG8_SB(0, 0), b2, voffB); PG8_STAGE(PG8_SB(0, 1), b2 + hstep, voffB); PG8_STAGE(PG8_SA(0, 0), a2, voffA);
            PG8_WAIT_V(8); PG8_WAIT_L(0); PG8_BAR; PG8_MMA(1, 0, At, B0); PG8_MMA(1, 1, At, B1); PG8_BAR; PG8_SCHED;
            PG8_LDB(B0, 1, 0); PG8_LDB(B1, 1, 1); PG8_SCHED; PG8_LDA(At, 1, 0); PG8_STAGE(PG8_SA(0, 1), a2 + hstep, voffA);
            PG8_WAIT_V(8); PG8_WAIT_L(0); PG8_BAR; PG8_MMA(0, 0, At, B0); PG8_MMA(0, 1, At, B1); PG8_BAR; PG8_SCHED;
            PG8_LDA(At, 1, 1); PG8_STAGE(PG8_SB(1, 0), b3, voffB); PG8_STAGE(PG8_SB(1, 1), b3 + hstep, voffB); PG8_STAGE(PG8_SA(1, 0), a3, voffA);
            PG8_WAIT_V(8); PG8_WAIT_L(0); PG8_BAR; PG8_MMA(1, 0, At, B0); PG8_MMA(1, 1, At, B1); PG8_BAR; PG8_SCHED;
            } else {
            PG8_LDB(B0, 0, 0); PG8_SCHED; PG8_LDA(At, 0, 0); PG8_STAGE(PG8_SA(1, 1), a1 + hstep, voffA);
            PG8_WAIT_L(8); PG8_BAR; PG8_WAIT_L(0); PG8_MMA(0, 0, At, B0); PG8_BAR; PG8_SCHED;
            PG8_LDB(B1, 0, 1); PG8_STAGE(PG8_SB(0, 0), b2, voffB);
            PG8_BAR; PG8_WAIT_L(0); PG8_MMA(0, 1, At, B1); PG8_BAR;
            PG8_LDA(At, 0, 1); PG8_STAGE(PG8_SA(0, 0), a2, voffA);
            PG8_BAR; PG8_WAIT_L(0); PG8_MMA(1, 0, At, B0); PG8_BAR; PG8_SCHED;
            PG8_STAGE(PG8_SB(0, 1), b2 + hstep, voffB);
            PG8_WAIT_V(6); PG8_BAR; PG8_MMA(1, 1, At, B1); PG8_BAR;
            PG8_LDB(B0, 1, 0); PG8_SCHED; PG8_LDA(At, 1, 0); PG8_STAGE(PG8_SA(0, 1), a2 + hstep, voffA);
            PG8_WAIT_L(8); PG8_BAR; PG8_WAIT_L(0); PG8_MMA(0, 0, At, B0); PG8_BAR; PG8_SCHED;
            PG8_LDB(B1, 1, 1); PG8_STAGE(PG8_SB(1, 0), b3, voffB);
            PG8_BAR; PG8_WAIT_L(0); PG8_MMA(0, 1, At, B1); PG8_BAR;
            PG8_LDA(At, 1, 1); PG8_STAGE(PG8_SA(1, 0), a3, voffA);
            PG8_BAR; PG8_WAIT_L(0); PG8_MMA(1, 0, At, B0); PG8_BAR; PG8_SCHED;
            PG8_STAGE(PG8_SB(1, 1), b3 + hstep, voffB);
            PG8_WAIT_V(6); PG8_BAR; PG8_MMA(1, 1, At, B1); PG8_BAR;
            }
        }
        if constexpr (ALIGN_EPI) { if (wr == 0) PG8_BAR; }
        if constexpr (!Epi::AFTER_DRAIN) { E(acc, cur, wr, wc, fr, fq); S.done(cur); }
        if (!has_next) break;
#pragma unroll
        for (int a = 0; a < 2; ++a)
#pragma unroll
            for (int b = 0; b < 2; ++b)
#pragma unroll
                for (int m = 0; m < 4; ++m)
#pragma unroll
                    for (int n = 0; n < 2; ++n) acc[a][b][m][n] = (f32x4){0.f, 0.f, 0.f, 0.f};
        cur = nxt; cA = nA; cB = nB; ++ui;
        if constexpr (ALIGN_EPI) { if (wr == 1) PG8_BAR; }
    }
    PG8_WAIT_V(0);
    if constexpr (!ALIGN_EPI) { if (wr == 0) PG8_BAR; }
    PG8_BAR;
    if constexpr (Epi::AFTER_DRAIN) { E.fused(acc, cur, wr, wc, fr, fq, lds, wid, lane); S.done(cur); }
#undef PG8_SA
#undef PG8_SB
#undef PG8_STAGE
#undef PG8_LDA
#undef PG8_LDB
#undef PG8_MMA
#undef PG8_WAIT_V
#undef PG8_WAIT_L
#undef PG8_BAR
#undef PG8_SCHED
}
}
typedef unsigned short bf16;
typedef float f32x4v __attribute__((ext_vector_type(4)));
#define LAS __attribute__((address_space(3)))

struct GemmArgs { const bf16* A; const bf16* Bt; float* C; int M, N, K, ldc; };
__global__ void __launch_bounds__(512, 2) k_gemm_f32(GemmArgs a) {
    extern __shared__ __attribute__((aligned(16))) unsigned char lds[];
    pg8::Gemm g{a.A, a.Bt, a.M, a.N, a.K}; pg8::StaticOrder S; S.init(a.M, a.N, (int)gridDim.x, (int)blockIdx.x);
    pg8::EpiF32 E{a.C, a.ldc};
    pg8::gemm_phase<pg8::EpiF32, pg8::StaticOrder, true, true>((LAS unsigned char*)lds, g, S, E);
}

__global__ void __launch_bounds__(256) k_mod(const float* __restrict__ c_p, const float* __restrict__ c_s, const float* __restrict__ w_ada, const float* __restrict__ b_ada, float* __restrict__ mod) {
    const int n = blockIdx.x * 256 + threadIdx.x, r0 = blockIdx.y * 13;
    float acc[13];
#pragma unroll
    for (int i = 0; i < 13; ++i) acc[i] = 0.f;
    for (int k = 0; k < D; ++k) {
        const float w = w_ada[(size_t)k * 3072 + n];
#pragma unroll
        for (int i = 0; i < 13; ++i) { const int r = r0 + i; const float cv = r < 2 ? c_p[r * D + k] : c_s[(r - 2) * D + k]; acc[i] += cv * w; }
    }
    const float bb = b_ada[n];
#pragma unroll
    for (int i = 0; i < 13; ++i) mod[(size_t)(r0 + i) * 3072 + n] = acc[i] + bb;
}
__global__ void __launch_bounds__(256) k_wt(const float* __restrict__ W, int ldw, int K, bf16* __restrict__ WT, int mode) {
    __shared__ float tile[32][33];
    const int k0 = blockIdx.x * 32, n0 = blockIdx.y * 32, tx = threadIdx.x, ty = threadIdx.y;
    const int n = n0 + tx, src = mode ? zsrc(n) : n;
    for (int i = ty; i < 32; i += 8) tile[i][tx] = src >= 0 ? W[(size_t)(k0 + i) * ldw + src] : 0.f;
    __syncthreads();
    for (int i = ty; i < 32; i += 8) WT[(size_t)(n0 + i) * K + k0 + tx] = f2bf(tile[tx][i]);
}
__global__ void __launch_bounds__(256) k_hprep(const float* __restrict__ xp, const float* __restrict__ xs, const float* __restrict__ mod, bf16* __restrict__ H) {
    const size_t i4 = (size_t)blockIdx.x * 256 + threadIdx.x;
    const int m = (int)(i4 >> 8), c = (int)(i4 & 255) * 4;
    const float* x = m < MP ? xp + (size_t)m * D : xs + (size_t)(m - MP) * D;
    const float* mr = mod + (size_t)row_modrow(m) * 3072;
    const f32x4v xv = *(const f32x4v*)(x + c), sh = *(const f32x4v*)(mr + c), sc = *(const f32x4v*)(mr + 1024 + c);
    ushort4 o; o.x = f2bf(xv.x * (1.f + sc.x) + sh.x); o.y = f2bf(xv.y * (1.f + sc.y) + sh.y); o.z = f2bf(xv.z * (1.f + sc.z) + sh.z); o.w = f2bf(xv.w * (1.f + sc.w) + sh.w);
    *(ushort4*)(H + (size_t)m * D + c) = o;
}

__global__ void __launch_bounds__(256) k_rows1(const float* __restrict__ Z, const float* __restrict__ qnorm, const float* __restrict__ kvnorm, bf16* __restrict__ CQN, bf16* __restrict__ CKVN,
                                               float* __restrict__ KRR, float* __restrict__ out) {
    const int lane = threadIdx.x & 63, m = blockIdx.x * 4 + (threadIdx.x >> 6);
    const float* z = Z + (size_t)m * NINP;
    {   float v[6], s = 0.f;
#pragma unroll
        for (int i = 0; i < 6; ++i) { v[i] = z[ZCQ + lane + 64 * i]; s += v[i] * v[i]; }
        const float r = rsqrtf(wave_sum(s) * (1.f / QL) + EPS);
#pragma unroll
        for (int i = 0; i < 6; ++i) CQN[(size_t)m * QL + lane + 64 * i] = f2bf(v[i] * r * qnorm[lane + 64 * i]); }
    {   float v[4], s = 0.f;
#pragma unroll
        for (int i = 0; i < 4; ++i) { v[i] = z[ZCKV + lane + 64 * i]; s += v[i] * v[i]; }
        const float r = rsqrtf(wave_sum(s) * (1.f / KVL) + EPS);
        float* o = m < MP ? out + O_CKVP + (size_t)m * KVL : out + O_CKVS + (size_t)(m - MP) * KVL;
#pragma unroll
        for (int i = 0; i < 4; ++i) { const float y = v[i] * r * kvnorm[lane + 64 * i]; o[lane + 64 * i] = y; CKVN[(size_t)m * KVL + lane + 64 * i] = f2bf(y); } }
    if (lane < 16) {
        const float pos = (float)row_pos(m), inv = powf(10000.f, -(float)lane / 16.f), ang = pos * inv;
        float sn, cs; sincosf(ang, &sn, &cs);
        const float x1 = z[ZKR + lane], x2 = z[ZKR + 16 + lane], y1 = x1 * cs - x2 * sn, y2 = x2 * cs + x1 * sn;
        float* o = m < MP ? out + O_KRP + (size_t)m * ROPE : out + O_KRS + (size_t)(m - MP) * ROPE;
        o[lane] = y1; o[lane + 16] = y2; KRR[(size_t)m * ROPE + lane] = y1; KRR[(size_t)m * ROPE + 16 + lane] = y2;
    }
}
__global__ void __launch_bounds__(256) k_qpost(float* __restrict__ QH) {
    const int lane = threadIdx.x & 63, m = blockIdx.x * 4 + (threadIdx.x >> 6);
    float* q = QH + (size_t)m * (MH * QHD);
    const float pos = (float)row_pos(m);
    const int j = lane & 15; const float inv = powf(10000.f, -(float)j / 16.f), ang = pos * inv; float sn, cs; sincosf(ang, &sn, &cs);
#pragma unroll
    for (int hh = 0; hh < 2; ++hh) { const int h = (lane >> 4) + 4 * hh; float* p = q + h * QHD + NOPE;
        const float x1 = p[j], x2 = p[16 + j]; p[j] = (x1 * cs - x2 * sn) * MLA_SCALE; p[16 + j] = (x2 * cs + x1 * sn) * MLA_SCALE; }
#pragma unroll
    for (int i = 0; i < 8; ++i) { const int e = lane + 64 * i; const int h = e >> 6, n = e & 63; q[h * QHD + n] *= MLA_SCALE; }
}
__global__ void __launch_bounds__(256) k_qlat(const float* __restrict__ QH, const float* __restrict__ w_uk, float* __restrict__ QLAT) {
    __shared__ float qs[MH * NOPE];
    const int ms = blockIdx.x, c = threadIdx.x;
    for (int e = threadIdx.x; e < MH * NOPE; e += 256) qs[e] = QH[(size_t)(MP + ms) * (MH * QHD) + (e >> 6) * QHD + (e & 63)];
    __syncthreads();
    for (int h = 0; h < MH; ++h) { float acc = 0.f;
        for (int n = 0; n < NOPE; ++n) acc += qs[h * NOPE + n] * w_uk[(size_t)c * (MH * NOPE) + h * NOPE + n];
        QLAT[((size_t)ms * MH + h) * KVL + c] = acc; }
}

__global__ void __launch_bounds__(256) k_attn_prompt_naive(const float* __restrict__ QH, const float* __restrict__ KVU, const float* __restrict__ KRR, float* __restrict__ OMLA) {
    const int qb = (int)gridDim.x - 1 - (int)blockIdx.x, b = blockIdx.y / MH, h = blockIdx.y % MH;
    const int t = qb * 256 + threadIdx.x, m = b * SP + t;
    float q[QHD], acc[VD];
#pragma unroll
    for (int j = 0; j < QHD; ++j) q[j] = QH[(size_t)m * (MH * QHD) + h * QHD + j];
#pragma unroll
    for (int j = 0; j < VD; ++j) acc[j] = 0.f;
    float mx = -INFINITY, l = 0.f;
    const int jend = qb * 256 + 256;
    for (int j = 0; j < jend; ++j) {
        const float* kn = KVU + (size_t)(b * SP + j) * 1024 + h * NOPE; const float* kr = KRR + (size_t)(b * SP + j) * ROPE; const float* vv = KVU + (size_t)(b * SP + j) * 1024 + 512 + h * VD;
        float s = 0.f;
#pragma unroll
        for (int d = 0; d < NOPE; ++d) s += q[d] * kn[d];
#pragma unroll
        for (int d = 0; d < ROPE; ++d) s += q[NOPE + d] * kr[d];
        if (j <= t) {
            const float mn = fmaxf(mx, s), al = __expf(mx - mn), p = __expf(s - mn);
            l = l * al + p; mx = mn;
#pragma unroll
            for (int d = 0; d < VD; ++d) acc[d] = acc[d] * al + p * vv[d];
        }
    }
    const float il = 1.f / l;
#pragma unroll
    for (int d = 0; d < VD; ++d) OMLA[(size_t)m * 512 + h * VD + d] = acc[d] * il;
}

__global__ void __launch_bounds__(256) k_attn_sample_naive(const float* __restrict__ QLAT, const float* __restrict__ QH, const float* __restrict__ cache_ckv, const float* __restrict__ cache_kr,
                                                           const int* __restrict__ page_table, const float* __restrict__ ckv_new  , const float* __restrict__ KRR, float* __restrict__ OLAT) {
    __shared__ float s_m[4][DS], s_l[4][DS], s_acc[4][DS][KVL];
    const int b = blockIdx.x / MH, h = blockIdx.x % MH, lane = threadIdx.x & 63, w = threadIdx.x >> 6;
    float ql[DS][4], qr[DS], acc[DS][4], mx[DS], l[DS];
#pragma unroll
    for (int i = 0; i < DS; ++i) {
#pragma unroll
        for (int j = 0; j < 4; ++j) { ql[i][j] = QLAT[((size_t)(b * DS + i) * MH + h) * KVL + lane + 64 * j]; acc[i][j] = 0.f; }
        qr[i] = lane < ROPE ? QH[(size_t)(MP + b * DS + i) * (MH * QHD) + h * QHD + NOPE + lane] : 0.f;
        mx[i] = -INFINITY; l[i] = 0.f;
    }
    for (int key = w; key < PAST + DS; key += 4) {
        const float* kc; const float* kr;
        if (key < PAST) { const int pg = page_table[b * NPAGES + (key >> 7)]; kc = cache_ckv + ((size_t)pg * PAGE + (key & 127)) * KVL; kr = cache_kr + ((size_t)pg * PAGE + (key & 127)) * ROPE; }
        else { kc = ckv_new + (size_t)(b * DS + key - PAST) * KVL; kr = KRR + (size_t)(MP + b * DS + key - PAST) * ROPE; }
        float kv[4];
#pragma unroll
        for (int j = 0; j < 4; ++j) kv[j] = kc[lane + 64 * j];
        const float krv = lane < ROPE ? kr[lane] : 0.f;
#pragma unroll
        for (int i = 0; i < DS; ++i) {
            float s = ql[i][0] * kv[0] + ql[i][1] * kv[1] + ql[i][2] * kv[2] + ql[i][3] * kv[3] + qr[i] * krv;
            s = wave_sum(s);
            if (key < PAST + i + 1) {
                const float mn = fmaxf(mx[i], s), al = __expf(mx[i] - mn), p = __expf(s - mn);
                l[i] = l[i] * al + p; mx[i] = mn;
#pragma unroll
                for (int j = 0; j < 4; ++j) acc[i][j] = acc[i][j] * al + p * kv[j];
            }
        }
    }
#pragma unroll
    for (int i = 0; i < DS; ++i) { if (lane == 0) { s_m[w][i] = mx[i]; s_l[w][i] = l[i]; }
#pragma unroll
        for (int j = 0; j < 4; ++j) s_acc[w][i][lane + 64 * j] = acc[i][j]; }
    __syncthreads();
    for (int e = threadIdx.x; e < DS * KVL; e += 256) { const int i = e >> 8, c = e & 255;
        const float mm = fmaxf(fmaxf(s_m[0][i], s_m[1][i]), fmaxf(s_m[2][i], s_m[3][i]));
        float num = 0.f, den = 0.f;
#pragma unroll
        for (int ww = 0; ww < 4; ++ww) { const float f = __expf(s_m[ww][i] - mm); num += f * s_acc[ww][i][c]; den += f * s_l[ww][i]; }
        OLAT[((size_t)(b * DS + i) * MH + h) * KVL + c] = num / den; }
}
__global__ void __launch_bounds__(512) k_olat_uv(const float* __restrict__ OLAT, const float* __restrict__ w_uv, float* __restrict__ OMLA) {
    __shared__ float os[MH * KVL];
    const int ms = blockIdx.x, tid = threadIdx.x, h = tid >> 6;
    for (int e = tid; e < MH * KVL; e += 512) os[e] = OLAT[(size_t)ms * MH * KVL + e];
    __syncthreads();
    float acc = 0.f;
    for (int c = 0; c < KVL; ++c) acc += os[h * KVL + c] * w_uv[(size_t)c * 512 + tid];
    OMLA[(size_t)(MP + ms) * 512 + tid] = acc;
}

__global__ void __launch_bounds__(256) k_ml_a(const float* __restrict__ Z, const float* __restrict__ b_i, const float* __restrict__ b_f, float* __restrict__ G, float* __restrict__ U, float* __restrict__ DC, float* __restrict__ DN) {
    __shared__ float s_w[LC], s_F[LC], s_ig[LC], s_red[2];
    const int bh = blockIdx.x / NCH, c = blockIdx.x % NCH, b = bh / LH, h = bh % LH, tid = threadIdx.x;
    const size_t row0 = (size_t)b * SP + (size_t)c * LC;
    if (tid < LC) { const float* z = Z + (row0 + tid) * NINP; s_ig[tid] = z[ZMI + h] + b_i[h]; s_F[tid] = logsigmoidf_(z[ZMF + h] + b_f[h]); }
    __syncthreads();
    if (tid == 0) { float f = 0.f; for (int s = 0; s < LC; ++s) { f += s_F[s]; s_F[s] = f; } const float g = f; float u = -INFINITY;
        for (int s = 0; s < LC; ++s) u = fmaxf(u, g - s_F[s] + s_ig[s]); s_red[0] = g; s_red[1] = u; }
    __syncthreads();
    const float g = s_red[0], u = s_red[1];
    if (tid < LC) s_w[tid] = __expf(g - s_F[tid] + s_ig[tid] - u);
    __syncthreads();
    const int dk = tid >> 1, dv0 = (tid & 1) * 64;
    float acc[64]; float an = 0.f;
#pragma unroll
    for (int j = 0; j < 64; ++j) acc[j] = 0.f;
    for (int s = 0; s < LC; ++s) { const float* z = Z + (row0 + s) * NINP; const float kw = z[ZK + h * DK + dk] * KSCALE * s_w[s]; an += kw;
#pragma unroll
        for (int j = 0; j < 64; ++j) acc[j] += kw * z[ZV + h * DV + dv0 + j]; }
    float* dc = DC + ((size_t)blockIdx.x * DK + dk) * DV + dv0;
#pragma unroll
    for (int j = 0; j < 64; ++j) dc[j] = acc[j];
    if ((tid & 1) == 0) DN[(size_t)blockIdx.x * DK + dk] = an;
    if (tid == 0) { G[blockIdx.x] = g; U[blockIdx.x] = u; }
}
__global__ void __launch_bounds__(256) k_ml_b(const float* __restrict__ G, const float* __restrict__ U, const float* __restrict__ DC, const float* __restrict__ DN,
                                              float* __restrict__ CS, float* __restrict__ NS, float* __restrict__ MSs, float* __restrict__ out) {
    const int gid = blockIdx.x * 256 + threadIdx.x, bh = gid / (DK * DV + DK), e = gid % (DK * DV + DK);
    float m = -INFINITY, x = 0.f;
    for (int c = 0; c < NCH; ++c) {
        const int ci = bh * NCH + c;
        if (e < DK * DV) CS[(size_t)ci * DK * DV + e] = x; else NS[(size_t)ci * DK + (e - DK * DV)] = x;
        if (e == 0) MSs[ci] = m;
        const float g = G[ci], u = U[ci], mn = fmaxf(g + m, u), al = __expf(g + m - mn), be = __expf(u - mn);
        const float d = e < DK * DV ? DC[(size_t)ci * DK * DV + e] : DN[(size_t)ci * DK + (e - DK * DV)];
        x = al * x + be * d; m = mn;
    }
    if (e < DK * DV) out[O_CP + (size_t)bh * DK * DV + e] = x; else out[O_NP + (size_t)bh * DK + (e - DK * DV)] = x;
    if (e == 0) out[O_MPR + bh] = m;
}
__global__ void __launch_bounds__(256) k_ml_c(const float* __restrict__ Z, const float* __restrict__ b_i, const float* __restrict__ b_f, const float* __restrict__ CS, const float* __restrict__ NS, const float* __restrict__ MSs, float* __restrict__ HML) {
    __shared__ float s_F[LC], s_ig[LC];
    const int bh = blockIdx.x / NCH, c = blockIdx.x % NCH, b = bh / LH, h = bh % LH, tid = threadIdx.x;
    const size_t row0 = (size_t)b * SP + (size_t)c * LC;
    if (tid < LC) { const float* z = Z + (row0 + tid) * NINP; s_ig[tid] = z[ZMI + h] + b_i[h]; s_F[tid] = logsigmoidf_(z[ZMF + h] + b_f[h]); }
    __syncthreads();
    if (tid == 0) { float f = 0.f; for (int s = 0; s < LC; ++s) { f += s_F[s]; s_F[s] = f; } }
    __syncthreads();
    const int t = tid >> 1, dv0 = (tid & 1) * 64;
    const float mprev = MSs[blockIdx.x], Ft = s_F[t];
    float mt = Ft + mprev;
    for (int s = 0; s <= t; ++s) mt = fmaxf(mt, Ft - s_F[s] + s_ig[s]);
    const float a = __expf(Ft + mprev - mt);
    const float* zq = Z + (row0 + t) * NINP + ZQ + h * DK;
    float acc[64]; float den = 0.f;
#pragma unroll
    for (int j = 0; j < 64; ++j) acc[j] = 0.f;
    for (int s = 0; s <= t; ++s) {
        const float* z = Z + (row0 + s) * NINP; float dot = 0.f;
        for (int d = 0; d < DK; ++d) dot += zq[d] * z[ZK + h * DK + d];
        const float sq = dot * KSCALE * __expf(Ft - s_F[s] + s_ig[s] - mt); den += sq;
#pragma unroll
        for (int j = 0; j < 64; ++j) acc[j] += sq * z[ZV + h * DV + dv0 + j];
    }
    const float* cs = CS + (size_t)blockIdx.x * DK * DV; const float* ns = NS + (size_t)blockIdx.x * DK;
    float qn = 0.f;
    for (int d = 0; d < DK; ++d) { const float qa = zq[d] * a; qn += qa * ns[d];
#pragma unroll
        for (int j = 0; j < 64; ++j) acc[j] += qa * cs[(size_t)d * DV + dv0 + j]; }
    den += qn;
    const float inv = 1.f / fmaxf(fabsf(den), __expf(-mt));
    float* o = HML + (row0 + t) * 512 + h * DV + dv0;
#pragma unroll
    for (int j = 0; j < 64; ++j) o[j] = acc[j] * inv;
}
__global__ void __launch_bounds__(256) k_ml_sample(const float* __restrict__ Z, const float* __restrict__ b_i, const float* __restrict__ b_f, const float* __restrict__ C0, const float* __restrict__ n0, const float* __restrict__ m0,
                                                   float* __restrict__ HML, float* __restrict__ out) {
    __shared__ float s_q[DS][DK], s_k[DS][DK], s_v[DS][DV], s_F[DS], s_ig[DS], s_mt[DS], s_a[DS], s_S[DS][DS], s_den[DS], s_qc[2][DS][DV], s_wl[DS];
    const int b = blockIdx.x / LH, h = blockIdx.x % LH, tid = threadIdx.x;
    const size_t row0 = (size_t)MP + (size_t)b * DS;
    for (int e = tid; e < DS * DK; e += 256) { const int t = e >> 7, d = e & 127; const float* z = Z + (row0 + t) * NINP;
        s_q[t][d] = z[ZQ + h * DK + d]; s_k[t][d] = z[ZK + h * DK + d] * KSCALE; s_v[t][d] = z[ZV + h * DV + d]; }
    if (tid < DS) { const float* z = Z + (row0 + tid) * NINP; s_ig[tid] = z[ZMI + h] + b_i[h]; s_F[tid] = logsigmoidf_(z[ZMF + h] + b_f[h]); }
    __syncthreads();
    const float mprev = m0[b * LH + h];
    if (tid == 0) { float f = 0.f; for (int s = 0; s < DS; ++s) { f += s_F[s]; s_F[s] = f; }
        for (int t = 0; t < DS; ++t) { float mt = s_F[t] + mprev; for (int s = 0; s <= t; ++s) mt = fmaxf(mt, s_F[t] - s_F[s] + s_ig[s]); s_mt[t] = mt; s_a[t] = __expf(s_F[t] + mprev - mt); }
        for (int s = 0; s < DS; ++s) s_wl[s] = __expf(s_F[DS - 1] - s_F[s] + s_ig[s] - s_mt[DS - 1]); }
    __syncthreads();
    if (tid < DS * DS) { const int t = tid >> 3, s = tid & 7; float v = 0.f;
        if (s <= t) { float dot = 0.f; for (int d = 0; d < DK; ++d) dot += s_q[t][d] * s_k[s][d]; v = dot * __expf(s_F[t] - s_F[s] + s_ig[s] - s_mt[t]); }
        s_S[t][s] = v; }
    __syncthreads();
    const int dv = tid & 127, hf = tid >> 7;
    const float* c0 = C0 + (size_t)blockIdx.x * DK * DV; float* cn = out + O_CS + (size_t)blockIdx.x * DK * DV;
    const float al = s_a[DS - 1];
    float qc[DS];
#pragma unroll
    for (int t = 0; t < DS; ++t) qc[t] = 0.f;
    for (int d = hf * 64; d < hf * 64 + 64; ++d) {
        const float cv = c0[(size_t)d * DV + dv]; float nv = al * cv;
#pragma unroll
        for (int t = 0; t < DS; ++t) { qc[t] += s_q[t][d] * cv; nv += s_wl[t] * s_k[t][d] * s_v[t][dv]; }
        cn[(size_t)d * DV + dv] = nv;
    }
#pragma unroll
    for (int t = 0; t < DS; ++t) s_qc[hf][t][dv] = qc[t];
    if (tid < DS) { const int t = tid; float dn = 0.f; for (int s = 0; s <= t; ++s) dn += s_S[t][s]; float qn = 0.f; const float* nn = n0 + (size_t)blockIdx.x * DK;
        for (int d = 0; d < DK; ++d) qn += s_q[t][d] * nn[d]; s_den[t] = dn + s_a[t] * qn; }
    if (tid >= 128 && tid < 128 + DK) { const int d = tid - 128; float nv = al * n0[(size_t)blockIdx.x * DK + d];
        for (int s = 0; s < DS; ++s) nv += s_wl[s] * s_k[s][d]; out[O_NS + (size_t)blockIdx.x * DK + d] = nv; }
    if (tid == 0) out[O_MS + blockIdx.x] = s_mt[DS - 1];
    __syncthreads();
    for (int e = tid; e < DS * DV; e += 256) { const int t = e >> 7, d = e & 127; float num = s_a[t] * (s_qc[0][t][d] + s_qc[1][t][d]);
        for (int s = 0; s <= t; ++s) num += s_S[t][s] * s_v[s][d];
        HML[(row0 + t) * 512 + h * DV + d] = num / fmaxf(fabsf(s_den[t]), __expf(-s_mt[t])); }
}

__global__ void __launch_bounds__(256) k_back_rows(const float* __restrict__ Z, const float* __restrict__ HML, const float* __restrict__ OMLA, const float* __restrict__ gn, bf16* __restrict__ YCAT) {
    const int lane = threadIdx.x & 63, m = blockIdx.x * 4 + (threadIdx.x >> 6);
    const float* z = Z + (size_t)m * NINP;
#pragma unroll
    for (int h = 0; h < LH; ++h) {
        const int c0 = h * DV + lane, c1 = c0 + 64;
        const float a0 = HML[(size_t)m * 512 + c0] * sigmoidf_(z[ZO + c0]), a1 = HML[(size_t)m * 512 + c1] * sigmoidf_(z[ZO + c1]);
        const float mu = wave_sum(a0 + a1) * (1.f / DV), d0 = a0 - mu, d1 = a1 - mu, var = wave_sum(d0 * d0 + d1 * d1) * (1.f / DV), r = rsqrtf(var + EPS);
        YCAT[(size_t)m * D + c0] = f2bf(d0 * r * gn[c0] * siluf_(z[ZZ + c0])); YCAT[(size_t)m * D + c1] = f2bf(d1 * r * gn[c1] * siluf_(z[ZZ + c1]));
    }
#pragma unroll
    for (int i = 0; i < 8; ++i) { const int c = lane + 64 * i; YCAT[(size_t)m * D + 512 + c] = f2bf(OMLA[(size_t)m * 512 + c] * siluf_(z[ZAZ + c])); }
}
__global__ void __launch_bounds__(256) k_final_ln(const float* __restrict__ xp, const float* __restrict__ xs, const float* __restrict__ mod, const float* __restrict__ OUT, const float* __restrict__ lg, const float* __restrict__ lb, float* __restrict__ out) {
    const int lane = threadIdx.x & 63, m = blockIdx.x * 4 + (threadIdx.x >> 6);
    const float* x = m < MP ? xp + (size_t)m * D : xs + (size_t)(m - MP) * D;
    const float* gate = mod + (size_t)row_modrow(m) * 3072 + 2048;
    float* y = m < MP ? out + O_YP + (size_t)m * D : out + O_YS + (size_t)(m - MP) * D;
    f32x4v v[4]; float s = 0.f;
#pragma unroll
    for (int j = 0; j < 4; ++j) { const int c = 4 * lane + 256 * j; const f32x4v xv = *(const f32x4v*)(x + c), gv = *(const f32x4v*)(gate + c), ov = *(const f32x4v*)(OUT + (size_t)m * D + c);
        v[j] = xv * ALPHA + gv * ov; s += (v[j].x + v[j].y) + (v[j].z + v[j].w); }
    const float mu = wave_sum(s) * (1.f / D); float s2 = 0.f;
#pragma unroll
    for (int j = 0; j < 4; ++j) { v[j] = v[j] - mu; s2 += (v[j].x * v[j].x + v[j].y * v[j].y) + (v[j].z * v[j].z + v[j].w * v[j].w); }
    const float r = rsqrtf(wave_sum(s2) * (1.f / D) + EPS);
#pragma unroll
    for (int j = 0; j < 4; ++j) { const int c = 4 * lane + 256 * j; const f32x4v g = *(const f32x4v*)(lg + c), bb = *(const f32x4v*)(lb + c); *(f32x4v*)(y + c) = v[j] * r * g + bb; }
}

static void launch_gemm(const bf16* A, const bf16* Bt, float* C, int M, int N, int K, int ldc, hipStream_t stream) {
    GemmArgs a{}; a.A = A; a.Bt = Bt; a.C = C; a.M = M; a.N = N; a.K = K; a.ldc = ldc;
    hipLaunchKernelGGL(k_gemm_f32, dim3(256), dim3(512), pg8::STAGE_BYTES, stream, a);
}
extern "C" void kernel_launch(void* const* d_in, const int* in_sizes, int n_in, void* d_out, int out_size, void* d_ws, size_t ws_size, hipStream_t stream) {
    static int ready = 0;
    if (ready == 0) {
        if (n_in != 24 || out_size != (int)O_END || ws_size < WS_END) { fprintf(stderr, "kernel_launch: unexpected shapes: n_in %d out %d ws %zu\n", n_in, out_size, ws_size); ready = -1; return; }
        if (hipFuncSetAttribute((const void*)k_gemm_f32, hipFuncAttributeMaxDynamicSharedMemorySize, pg8::STAGE_BYTES) != hipSuccess) { fprintf(stderr, "kernel_launch: hipFuncSetAttribute failed\n"); ready = -1; return; }
        ready = 1;
    }
    if (ready < 0) return;
    const float* xp = (const float*)d_in[0]; const float* xs = (const float*)d_in[1]; const float* cp = (const float*)d_in[2]; const float* cs = (const float*)d_in[3];
    const float* cache_ckv = (const float*)d_in[4]; const float* cache_kr = (const float*)d_in[5]; const float* st_C = (const float*)d_in[6]; const float* st_n = (const float*)d_in[7]; const float* st_m = (const float*)d_in[8];
    const int* page_table = (const int*)d_in[9];
    const float* w_ada = (const float*)d_in[10]; const float* b_ada = (const float*)d_in[11]; const float* w_in = (const float*)d_in[12]; const float* b_i = (const float*)d_in[13]; const float* b_f = (const float*)d_in[14];
    const float* ml_gn = (const float*)d_in[15]; const float* qnorm = (const float*)d_in[16]; const float* kvnorm = (const float*)d_in[17]; const float* w_uq = (const float*)d_in[18]; const float* w_uk = (const float*)d_in[19];
    const float* w_uv = (const float*)d_in[20]; const float* w_out = (const float*)d_in[21]; const float* ln_g = (const float*)d_in[22]; const float* ln_b = (const float*)d_in[23];
    float* out = (float*)d_out; unsigned char* ws = (unsigned char*)d_ws;
    float* MOD = (float*)(ws + WS_MOD); bf16* WIN = (bf16*)(ws + WS_WIN); bf16* WUQ = (bf16*)(ws + WS_WUQ); bf16* WKV = (bf16*)(ws + WS_WKV); bf16* WOUT = (bf16*)(ws + WS_WOUT);
    bf16* H = (bf16*)(ws + WS_H); float* Z = (float*)(ws + WS_Z); bf16* CQN = (bf16*)(ws + WS_CQN); bf16* CKVN = (bf16*)(ws + WS_CKVN); float* QH = (float*)(ws + WS_QH);
    float* KVU = (float*)(ws + WS_KVU); float* KRR = (float*)(ws + WS_KRR); float* QLAT = (float*)(ws + WS_QLAT); float* OLAT = (float*)(ws + WS_OLAT); float* OMLA = (float*)(ws + WS_OMLA);
    float* HML = (float*)(ws + WS_HML); float* MLG = (float*)(ws + WS_MLG); float* MLU = (float*)(ws + WS_MLU); float* MLDC = (float*)(ws + WS_MLDC); float* MLDN = (float*)(ws + WS_MLDN);
    float* MLCS = (float*)(ws + WS_MLCS); float* MLNS = (float*)(ws + WS_MLNS); float* MLMS = (float*)(ws + WS_MLMS); bf16* YCAT = (bf16*)(ws + WS_YCAT); float* OUT = (float*)(ws + WS_OUT);

    hipLaunchKernelGGL(k_mod, dim3(12, 10), dim3(256), 0, stream, cp, cs, w_ada, b_ada, MOD);
    hipLaunchKernelGGL(k_wt, dim3(D / 32, NINP / 32), dim3(32, 8), 0, stream, w_in, NIN, D, WIN, 1);
    hipLaunchKernelGGL(k_wt, dim3(QL / 32, (MH * QHD) / 32), dim3(32, 8), 0, stream, w_uq, MH * QHD, QL, WUQ, 0);
    hipLaunchKernelGGL(k_wt, dim3(KVL / 32, 512 / 32), dim3(32, 8), 0, stream, w_uk, 512, KVL, WKV, 0);
    hipLaunchKernelGGL(k_wt, dim3(KVL / 32, 512 / 32), dim3(32, 8), 0, stream, w_uv, 512, KVL, WKV + (size_t)512 * KVL, 0);
    hipLaunchKernelGGL(k_wt, dim3(D / 32, D / 32), dim3(32, 8), 0, stream, w_out, D, D, WOUT, 0);
    hipLaunchKernelGGL(k_hprep, dim3(MT), dim3(256), 0, stream, xp, xs, MOD, H);
    launch_gemm(H, WIN, Z, MT, NINP, D, NINP, stream);
    hipLaunchKernelGGL(k_rows1, dim3(MT / 4), dim3(256), 0, stream, Z, qnorm, kvnorm, CQN, CKVN, KRR, out);
    launch_gemm(CQN, WUQ, QH, MT, MH * QHD, QL, MH * QHD, stream);
    launch_gemm(CKVN, WKV, KVU, MP, 1024, KVL, 1024, stream);
    hipLaunchKernelGGL(k_qpost, dim3(MT / 4), dim3(256), 0, stream, QH);
    hipLaunchKernelGGL(k_qlat, dim3(MS), dim3(256), 0, stream, QH, w_uk, QLAT);
    hipLaunchKernelGGL(k_attn_prompt_naive, dim3(SP / 256, BP * MH), dim3(256), 0, stream, QH, KVU, KRR, OMLA);
    hipLaunchKernelGGL(k_attn_sample_naive, dim3(DB * MH), dim3(256), 0, stream, QLAT, QH, cache_ckv, cache_kr, page_table, out + O_CKVS, KRR, OLAT);
    hipLaunchKernelGGL(k_olat_uv, dim3(MS), dim3(512), 0, stream, OLAT, w_uv, OMLA);
    hipLaunchKernelGGL(k_ml_a, dim3(BP * LH * NCH), dim3(256), 0, stream, Z, b_i, b_f, MLG, MLU, MLDC, MLDN);
    hipLaunchKernelGGL(k_ml_b, dim3(BP * LH * (DK * DV + DK) / 256), dim3(256), 0, stream, MLG, MLU, MLDC, MLDN, MLCS, MLNS, MLMS, out);
    hipLaunchKernelGGL(k_ml_c, dim3(BP * LH * NCH), dim3(256), 0, stream, Z, b_i, b_f, MLCS, MLNS, MLMS, HML);
    hipLaunchKernelGGL(k_ml_sample, dim3(DB * LH), dim3(256), 0, stream, Z, b_i, b_f, st_C, st_n, st_m, HML, out);
    hipLaunchKernelGGL(k_back_rows, dim3(MT / 4), dim3(256), 0, stream, Z, HML, OMLA, ml_gn, YCAT);
    launch_gemm(YCAT, WOUT, OUT, MT, D, D, D, stream);
    hipLaunchKernelGGL(k_final_ln, dim3(MT / 4), dim3(256), 0, stream, xp, xs, MOD, OUT, ln_g, ln_b, out);
}
```

```cpp
#include <hip/hip_runtime.h>
#include <cstdio>
#include <cstdint>
#include <cmath>

constexpr int D = 1024, BP = 2, SP = 8192, MP = BP * SP, DB = 128, DS = 8, MS = DB * DS, MT = MP + MS;
constexpr int NIN = 3752, NINP = 3840;
constexpr int QL = 384, KVL = 256, ROPE = 32, NOPE = 64, MH = 8, VD = 64, QHD = NOPE + ROPE;
constexpr int LH = 4, DK = 128, DV = 128, LC = 128, NCH = SP / LC;
constexpr int PAGE = 128, NPAGES = 64, PAST = 8192;
constexpr float EPS = 1e-6f, ALPHA = 1.189207115002721f, MLA_SCALE = 0.10206207261596575f  , KSCALE = 0.08838834764831845f  ;
constexpr int ZQ = 0, ZK = 512, ZV = 1024, ZO = 1536, ZZ = 2048, ZAZ = 2560, ZCKV = 3072, ZCQ = 3328, ZKR = 3712, ZMI = 3744, ZMF = 3748;
constexpr size_t O_YP = 0, O_YS = 16777216, O_CKVP = 17825792, O_KRP = 22020096, O_CP = 22544384, O_NP = 22675456, O_MPR = 22676480,
                 O_CKVS = 22676488, O_KRS = 22938632, O_CS = 22971400, O_NS = 31360008, O_MS = 31425544, O_END = 31426056;
constexpr size_t MiB = 1u << 20;
constexpr size_t WS_CTL = 0, WS_MOD = 1 * MiB, WS_ROPET = 260 * MiB, WS_WIN = 4 * MiB, WS_WUQ = 12 * MiB, WS_WKV = 13 * MiB, WS_WOUT = 14 * MiB, WS_H = 16 * MiB,
                 WS_ZB = 64 * MiB  , WS_GATES = 168 * MiB, WS_CKVR = 170 * MiB  , WS_CQR = 180 * MiB  , WS_SSKV = 194 * MiB, WS_SSQ = 195 * MiB,
                 WS_KRB = 196 * MiB  , WS_Q96 = 198 * MiB  , WS_KVB = 224 * MiB  , WS_QLAT = 484 * MiB,
                 WS_OLAT = 492 * MiB, WS_OMLA = 500 * MiB, WS_HML = 536 * MiB, WS_MLG = 572 * MiB, WS_MLU = 573 * MiB, WS_MLDC = 576 * MiB, WS_MLDN = 608 * MiB,
                 WS_MLCS = 612 * MiB, WS_MLNS = 644 * MiB, WS_MLMS = 646 * MiB, WS_YCAT = 648 * MiB, WS_OUT = 684 * MiB, WS_END = 752 * MiB;
constexpr float LOG2E = 1.4426950408889634f;

__host__ __device__ __forceinline__ int zsrc(int j) {
    if (j < 1536) return j;
    if (j < 2560) return j + 8;
    if (j < 3072) return 3240 + (j - 2560);
    if (j < 3328) return 2952 + (j - 3072);
    if (j < 3712) return 2568 + (j - 3328);
    if (j < 3744) return 3208 + (j - 3712);
    if (j < 3752) return 1536 + (j - 3744);
    return -1;
}
__device__ __forceinline__ unsigned short f2bf(float f) { unsigned u = __builtin_bit_cast(unsigned, f); return (unsigned short)((u + 0x7fffu + ((u >> 16) & 1u)) >> 16); }
__device__ __forceinline__ float bf2f(unsigned short h) { return __builtin_bit_cast(float, (unsigned)h << 16); }
__device__ __forceinline__ float wave_sum(float v) {
#pragma unroll
    for (int o = 1; o < 64; o <<= 1) v += __shfl_xor(v, o);
    return v;
}
__device__ __forceinline__ float wave_max(float v) {
#pragma unroll
    for (int o = 1; o < 64; o <<= 1) v = fmaxf(v, __shfl_xor(v, o));
    return v;
}
__device__ __forceinline__ float sigmoidf_(float x) { return 1.f / (1.f + __expf(-x)); }
__device__ __forceinline__ float siluf_(float x) { return x / (1.f + __expf(-x)); }
__device__ __forceinline__ float logsigmoidf_(float x) { return x >= 0.f ? -log1pf(expf(-x)) : x - log1pf(expf(x)); }
__device__ __forceinline__ int row_pos(int m) { return m < MP ? (m & (SP - 1)) : PAST + ((m - MP) & (DS - 1)); }
__device__ __forceinline__ int row_modrow(int m) { return m < MP ? (m >> 13) : 2 + ((m - MP) >> 3); }
namespace pg8 {
#define PG8_LAS __attribute__((address_space(3)))
typedef unsigned short bf16_t;
typedef short bf16x8 __attribute__((ext_vector_type(8)));
typedef float f32x4 __attribute__((ext_vector_type(4)));
typedef unsigned u32x4 __attribute__((ext_vector_type(4)));
constexpr int BM = 256, BK = 64, HALF = 128, HTB = HALF * BK * 2  , STAGE_BYTES = 8 * HTB, NXCD = 8, WGM = 8;

__host__ __device__ __forceinline__ int lds_byte(int r, int c) { const int st = (r >> 4) * 2 + (c >> 5), rr = r & 15, cc = c & 31, ob = rr * 64 + cc * 2; return st * 1024 + (ob ^ (((ob >> 9) & 1) << 5)); }
__host__ __device__ __forceinline__ void stage_rc(int b, int& R, int& C) { const int st = b / 1024, sb = b % 1024, swz = sb ^ (((sb >> 9) & 1) << 5); R = (st >> 1) * 16 + swz / 64; C = (st & 1) * 32 + (swz % 64) / 2; }
__host__ __device__ __forceinline__ int perm32(int rho) { const int n = rho >> 4, i = rho & 15; return 8 * (i >> 2) + 4 * n + (i & 3); }

struct Unit { int pm, pn; };
struct Gemm { const bf16_t* A; const bf16_t* Bt; int M, N, K; };

struct StaticOrder {
    int nM, nN, nwg, G, c;
    __host__ __device__ void init(int M, int N, int G_, int c_) { nM = M / BM; nN = N / BM; nwg = nM * nN; G = G_; c = c_; }
    __host__ __device__ bool next(int i, Unit& u) const {
        const long L = (long)i * G + c; if (L >= nwg) return false;
        int wgid = (int)L; { const int q = nwg / NXCD, r = nwg % NXCD, xcd = wgid % NXCD, off = wgid / NXCD; wgid = (xcd < r ? xcd * (q + 1) : r * (q + 1) + (xcd - r) * q) + off; }
        const int nig = WGM * nN, gid = wgid / nig, fm = gid * WGM, gsz = (nM - fm) < WGM ? (nM - fm) : WGM;
        u.pm = fm + ((wgid % nig) % gsz); u.pn = (wgid % nig) / gsz; return true;
    }
    __device__ __forceinline__ void a_ready(const Unit&) const {}
    __device__ __forceinline__ void done(const Unit&) const {}
};

__device__ __forceinline__ unsigned cvt_pk_bf16(float lo, float hi) { unsigned r; asm volatile("v_cvt_pk_bf16_f32 %0, %1, %2" : "=v"(r) : "v"(lo), "v"(hi)); return r; }
__device__ __forceinline__ u32x4 pack8(const f32x4& v0, const f32x4& v1) { u32x4 w; w.x = cvt_pk_bf16(v0[0], v0[1]); w.y = cvt_pk_bf16(v0[2], v0[3]); w.z = cvt_pk_bf16(v1[0], v1[1]); w.w = cvt_pk_bf16(v1[2], v1[3]); return w; }
__device__ __forceinline__ float sq8(const f32x4& a, const f32x4& b) { return (a[0] * a[0] + a[1] * a[1]) + (a[2] * a[2] + a[3] * a[3]) + (b[0] * b[0] + b[1] * b[1]) + (b[2] * b[2] + b[3] * b[3]); }
__device__ __forceinline__ int epi_row_pos(int m) { return m < 16384 ? (m & 8191) : 8192 + ((m - 16384) & 7); }
__device__ __forceinline__ void rope8(f32x4& v0, f32x4& v1, const float* tab, int fq) {
    const int j0 = 8 * (fq & 1);
    const f32x4 c0 = *(const f32x4*)(tab + j0), c1 = *(const f32x4*)(tab + j0 + 4), s0 = *(const f32x4*)(tab + 16 + j0), s1 = *(const f32x4*)(tab + 16 + j0 + 4);
    f32x4 o0, o1;
#pragma unroll
    for (int i = 0; i < 4; ++i) { o0[i] = __shfl_xor(v0[i], 32); o1[i] = __shfl_xor(v1[i], 32); }
    if (fq < 2) { v0 = v0 * c0 - o0 * s0; v1 = v1 * c1 - o1 * s1; } else { v0 = v0 * c0 + o0 * s0; v1 = v1 * c1 + o1 * s1; }
}
struct EpiInProj {
    static constexpr bool PERM = true, AFTER_DRAIN = false;
    bf16_t* ZB; bf16_t* CKVR; bf16_t* CQR; float* SSKV; float* SSQ; float* GATES; bf16_t* KRB; float* out_krp; float* out_krs; const float* ropet;
    __device__ __forceinline__ void operator()(const f32x4 (&acc)[2][2][4][2], const Unit& u, int wr, int wc, int fr, int fq) const {
        const int row0 = u.pm * BM + wr * 64 + fr, cw = wc * 32 + 8 * fq;
        if (u.pn < 12) {
#pragma unroll
            for (int ai = 0; ai < 2; ++ai)
#pragma unroll
                for (int m = 0; m < 4; ++m) { bf16_t* rowp = ZB + (size_t)(row0 + ai * HALF + m * 16) * 3072 + u.pn * BM + cw;
#pragma unroll
                    for (int bj = 0; bj < 2; ++bj) *(u32x4*)(rowp + bj * HALF) = pack8(acc[ai][bj][m][0], acc[ai][bj][m][1]); }
        } else if (u.pn < 14) {
            bf16_t* dst = u.pn == 12 ? CKVR : CQR; const int ld = u.pn == 12 ? 256 : 384; float* ss = u.pn == 12 ? SSKV : SSQ; const int ssl = u.pn == 12 ? 4 : 8;
#pragma unroll
            for (int ai = 0; ai < 2; ++ai)
#pragma unroll
                for (int m = 0; m < 4; ++m) { const int row = row0 + ai * HALF + m * 16; bf16_t* rowp = dst + (size_t)row * ld + cw;
                    float s = 0.f;
#pragma unroll
                    for (int bj = 0; bj < 2; ++bj) { *(u32x4*)(rowp + bj * HALF) = pack8(acc[ai][bj][m][0], acc[ai][bj][m][1]); s += sq8(acc[ai][bj][m][0], acc[ai][bj][m][1]); }
                    s += __shfl_xor(s, 16); s += __shfl_xor(s, 32);
                    if (fq == 0) ss[(size_t)row * ssl + wc] = s; }
        } else {
#pragma unroll
            for (int ai = 0; ai < 2; ++ai)
#pragma unroll
                for (int m = 0; m < 4; ++m) { const int row = row0 + ai * HALF + m * 16;
                    *(u32x4*)(CQR + (size_t)row * 384 + 256 + cw) = pack8(acc[ai][0][m][0], acc[ai][0][m][1]);
                    float s = sq8(acc[ai][0][m][0], acc[ai][0][m][1]);
                    s += __shfl_xor(s, 16); s += __shfl_xor(s, 32);
                    if (fq == 0) SSQ[(size_t)row * 8 + 4 + wc] = s;
                    if (wc == 0) {
                        f32x4 v0 = acc[ai][1][m][0], v1 = acc[ai][1][m][1];
                        rope8(v0, v1, ropet + (size_t)epi_row_pos(row) * 32, fq);
                        float* o = row < 16384 ? out_krp + (size_t)row * 32 : out_krs + (size_t)(row - 16384) * 32;
                        *(f32x4*)(o + 8 * fq) = v0; *(f32x4*)(o + 8 * fq + 4) = v1;
                        *(u32x4*)(KRB + (size_t)row * 32 + 8 * fq) = pack8(v0, v1);
                    } else if (wc == 1 && fq == 0) {
                        *(f32x4*)(GATES + (size_t)row * 8) = acc[ai][1][m][0]; *(f32x4*)(GATES + (size_t)row * 8 + 4) = acc[ai][1][m][1];
                    } }
        }
    }
    __device__ __forceinline__ void fused(f32x4 (&)[2][2][4][2], const Unit&, int, int, int, int, PG8_LAS unsigned char*, int, int) const {}
};
struct EpiQ {
    static constexpr bool PERM = true, AFTER_DRAIN = false;
    bf16_t* Q96; const float* SSQ; float qscale;
    __device__ __forceinline__ void operator()(const f32x4 (&acc)[2][2][4][2], const Unit& u, int wr, int wc, int fr, int fq) const {
        const int row0 = u.pm * BM + wr * 64 + fr, cw = wc * 32 + 8 * fq;
#pragma unroll
        for (int ai = 0; ai < 2; ++ai)
#pragma unroll
            for (int m = 0; m < 4; ++m) { const int row = row0 + ai * HALF + m * 16;
                const f32x4 p0 = *(const f32x4*)(SSQ + (size_t)row * 8), p1 = *(const f32x4*)(SSQ + (size_t)row * 8 + 4);
                const float ssum = ((p0[0] + p0[1]) + (p0[2] + p0[3])) + ((p1[0] + p1[1]) + (p1[2] + p1[3]));
                const float rs = __builtin_amdgcn_rsqf(ssum * (1.0f / 384.0f) + 1e-6f) * qscale;
#pragma unroll
                for (int bj = 0; bj < 2; ++bj) *(u32x4*)(Q96 + (size_t)row * 768 + u.pn * BM + bj * HALF + cw) = pack8(acc[ai][bj][m][0] * rs, acc[ai][bj][m][1] * rs); }
    }
    __device__ __forceinline__ void fused(f32x4 (&)[2][2][4][2], const Unit&, int, int, int, int, PG8_LAS unsigned char*, int, int) const {}
};
struct EpiKV {
    static constexpr bool PERM = true, AFTER_DRAIN = false;
    bf16_t* KVB; const float* SSKV;
    __device__ __forceinline__ void operator()(const f32x4 (&acc)[2][2][4][2], const Unit& u, int wr, int wc, int fr, int fq) const {
        const int row0 = u.pm * BM + wr * 64 + fr, cw = wc * 32 + 8 * fq;
#pragma unroll
        for (int ai = 0; ai < 2; ++ai)
#pragma unroll
            for (int m = 0; m < 4; ++m) { const int row = row0 + ai * HALF + m * 16;
                const f32x4 p0 = *(const f32x4*)(SSKV + (size_t)row * 4);
                const float rs = __builtin_amdgcn_rsqf(((p0[0] + p0[1]) + (p0[2] + p0[3])) * (1.0f / 256.0f) + 1e-6f);
#pragma unroll
                for (int bj = 0; bj < 2; ++bj) *(u32x4*)(KVB + (size_t)row * 1024 + u.pn * BM + bj * HALF + cw) = pack8(acc[ai][bj][m][0] * rs, acc[ai][bj][m][1] * rs); }
    }
    __device__ __forceinline__ void fused(f32x4 (&)[2][2][4][2], const Unit&, int, int, int, int, PG8_LAS unsigned char*, int, int) const {}
};
struct EpiF32 {
    static constexpr bool PERM = false, AFTER_DRAIN = false;
    float* C; int ldc;
    __device__ __forceinline__ void operator()(const f32x4 (&acc)[2][2][4][2], const Unit& u, int wr, int wc, int fr, int fq) const {
        const int row0 = u.pm * BM + wr * 64 + fr, col0 = u.pn * BM + wc * 32 + 4 * fq;
#pragma unroll
        for (int ai = 0; ai < 2; ++ai)
#pragma unroll
            for (int m = 0; m < 4; ++m) { float* rowp = C + (size_t)(row0 + ai * HALF + m * 16) * ldc + col0;
#pragma unroll
                for (int bj = 0; bj < 2; ++bj)
#pragma unroll
                    for (int n = 0; n < 2; ++n) *(f32x4*)(rowp + bj * HALF + n * 16) = acc[ai][bj][m][n]; }
    }
    __device__ __forceinline__ void fused(f32x4 (&)[2][2][4][2], const Unit&, int, int, int, int, PG8_LAS unsigned char*, int, int) const {}
};
template <class Epi, class Sched, bool ALIGN_EPI = false, bool SP2 = false>
__device__ __forceinline__ void gemm_phase(PG8_LAS unsigned char* lds, const Gemm g, const Sched& S, const Epi& E) {
    const int tid = threadIdx.x, wid = __builtin_amdgcn_readfirstlane(tid >> 6), lane = tid & 63, wr = wid >> 2, wc = wid & 3, fr = lane & 15, fq = lane >> 4;
    const int K = g.K, nt = K / BK;
    unsigned voffA[2], voffB[2];
#pragma unroll
    for (int i = 0; i < 2; ++i) { int R, C; stage_rc(tid * 16 + i * 8192, R, C); const int Rb = Epi::PERM ? ((R & ~31) + perm32(R & 31)) : R;
        voffA[i] = (unsigned)(R * K + C) * 2u; voffB[i] = (unsigned)(Rb * K + C) * 2u; }
    const size_t kstep = (size_t)(BK * 2);
    const size_t hstep = (size_t)HALF * K * 2;
    const size_t tstep = 2 * hstep;
    const unsigned ldsw = (unsigned)wid * 1024u;
    const int aoff = lds_byte(wr * 64 + fr, fq * 8), boff = lds_byte(wc * 32 + fr, fq * 8);
#define PG8_SA(b, h) (((b) * 2 + (h)) * HTB)
#define PG8_SB(b, h) ((4 + (b) * 2 + (h)) * HTB)
#define PG8_STAGE(bufoff, gbase, voff) do { _Pragma("unroll") for (int _i = 0; _i < 2; ++_i) \
        __builtin_amdgcn_global_load_lds((const unsigned*)((const char*)(gbase) + (voff)[_i]), (PG8_LAS unsigned*)(lds + (bufoff) + ldsw + _i * 8192), 16, 0, 0); } while (0)
#define PG8_LDA(dst, b, h) do { _Pragma("unroll") for (int m = 0; m < 4; ++m) _Pragma("unroll") for (int k = 0; k < 2; ++k) dst[m][k] = *(const PG8_LAS bf16x8*)(lds + PG8_SA(b, h) + aoff + m * 2048 + k * 1024); } while (0)
#define PG8_LDB(dst, b, h) do { _Pragma("unroll") for (int n = 0; n < 2; ++n) _Pragma("unroll") for (int k = 0; k < 2; ++k) dst[n][k] = *(const PG8_LAS bf16x8*)(lds + PG8_SB(b, h) + boff + n * 2048 + k * 1024); } while (0)
#define PG8_MMA(ai, bj, At, Bt) do { __builtin_amdgcn_s_setprio(1); _Pragma("unroll") for (int m = 0; m < 4; ++m) _Pragma("unroll") for (int n = 0; n < 2; ++n) _Pragma("unroll") for (int k = 0; k < 2; ++k) \
        acc[ai][bj][m][n] = __builtin_amdgcn_mfma_f32_16x16x32_bf16(Bt[n][k], At[m][k], acc[ai][bj][m][n], 0, 0, 0); __builtin_amdgcn_s_setprio(0); } while (0)
#define PG8_WAIT_V(n) asm volatile("s_waitcnt vmcnt(" #n ")" ::: "memory")
#define PG8_WAIT_L(n) asm volatile("s_waitcnt lgkmcnt(" #n ")" ::: "memory")
#define PG8_BAR __builtin_amdgcn_s_barrier()
#define PG8_SCHED __builtin_amdgcn_sched_barrier(0)
    Unit cur, nxt; int ui = 0;
    if (!S.next(0, cur)) return;
    f32x4 acc[2][2][4][2];
#pragma unroll
    for (int a = 0; a < 2; ++a)
#pragma unroll
        for (int b = 0; b < 2; ++b)
#pragma unroll
            for (int m = 0; m < 4; ++m)
#pragma unroll
                for (int n = 0; n < 2; ++n) acc[a][b][m][n] = (f32x4){0.f, 0.f, 0.f, 0.f};
    bf16x8 At[4][2], B0[2][2], B1[2][2];
    const char* cA = (const char*)g.A + (size_t)cur.pm * tstep; const char* cB = (const char*)g.Bt + (size_t)cur.pn * tstep;
    S.a_ready(cur);
    if constexpr (SP2) {
        PG8_STAGE(PG8_SB(0, 0), cB, voffB); PG8_STAGE(PG8_SB(0, 1), cB + hstep, voffB); PG8_STAGE(PG8_SA(0, 0), cA, voffA); PG8_STAGE(PG8_SA(0, 1), cA + hstep, voffA);
        if (wr == 1) PG8_BAR;
        PG8_WAIT_V(2); PG8_BAR;
        PG8_STAGE(PG8_SB(1, 0), cB + kstep, voffB); PG8_STAGE(PG8_SA(1, 0), cA + kstep, voffA); PG8_STAGE(PG8_SB(1, 1), cB + hstep + kstep, voffB);
        PG8_WAIT_V(6); PG8_BAR;
    } else {
        PG8_STAGE(PG8_SB(0, 0), cB, voffB); PG8_STAGE(PG8_SA(0, 0), cA, voffA); PG8_STAGE(PG8_SB(0, 1), cB + hstep, voffB); PG8_STAGE(PG8_SA(0, 1), cA + hstep, voffA);
        if (wr == 1) PG8_BAR;
        PG8_WAIT_V(4); PG8_BAR;
        PG8_STAGE(PG8_SB(1, 0), cB + kstep, voffB); PG8_STAGE(PG8_SA(1, 0), cA + kstep, voffA); PG8_STAGE(PG8_SB(1, 1), cB + hstep + kstep, voffB);
        PG8_WAIT_V(6); PG8_BAR;
    }
    for (;;) {
        const bool has_next = S.next(ui + 1, nxt);
        const char* nA = has_next ? (const char*)g.A + (size_t)nxt.pm * tstep : cA; const char* nB = has_next ? (const char*)g.Bt + (size_t)nxt.pn * tstep : cB;
        for (int t = 0; t < nt; t += 2) {
            const bool last = (t == nt - 2);
            const char* a1 = cA + (size_t)(t + 1) * kstep;
            const char* a2 = last ? nA : cA + (size_t)(t + 2) * kstep; const char* b2 = last ? nB : cB + (size_t)(t + 2) * kstep;
            const char* a3 = a2 + kstep; const char* b3 = b2 + kstep;
            if (last && has_next) S.a_ready(nxt);
            if constexpr (SP2) {
            PG8_LDB(B0, 0, 0); PG8_LDB(B1, 0, 1); PG8_SCHED; PG8_LDA(At, 0, 0); PG8_STAGE(PG8_SA(1, 1), a1 + hstep, voffA);
            PG8_WAIT_V(8); PG8_WAIT_L(0); PG8_BAR; PG8_MMA(0, 0, At, B0); PG8_MMA(0, 1, At, B1); PG8_BAR; PG8_SCHED;
            PG8_LDA(At, 0, 1); PG8_STAGE(PG8_SB(0, 0), b2, voffB); PG8_STAGE(PG8_SB(0, 1), b2 + hstep, voffB); PG8_STAGE(PG8_SA(0, 0), a2, voffA);
            PG8_WAIT_V(8); PG8_WAIT_L(0); PG8_BAR; PG8_MMA(1, 0, At, B0); PG8_MMA(1, 1, At, B1); PG8_BAR; PG8_SCHED;
            PG8_LDB(B0, 1, 0); PG8_LDB(B1, 1, 1); PG8_SCHED; PG8_LDA(At, 1, 0); PG8_STAGE(PG8_SA(0, 1), a2 + hstep, voffA);
            PG8_WAIT_V(8); PG8_WAIT_L(0); PG8_BAR; PG8_MMA(0, 0, At, B0); PG8_MMA(0, 1, At, B1); PG8_BAR; PG8_SCHED;
            PG8_LDA(At, 1, 1); PG8_STAGE(PG8_SB(1, 0), b3, voffB); PG8_STAGE(PG8_SB(1, 1), b3 + hstep, voffB); PG8_STAGE(PG8_SA(1, 0), a3, voffA);
            PG8_WAIT_V(8); PG8_WAIT_L(0); PG8_BAR; PG8_MMA(1, 0, At, B0); PG8_MMA(1, 1, At, B1); PG8_BAR; PG8_SCHED;
            } else {
            PG8_LDB(B0, 0, 0); PG8_SCHED; PG8_LDA(At, 0, 0); PG8_STAGE(PG8_SA(1, 1), a1 + hstep, voffA);
            PG8_WAIT_L(8); PG8_BAR; PG8_WAIT_L(0); PG8_MMA(0, 0, At, B0); PG8_BAR; PG8_SCHED;
            PG8_LDB(B1, 0, 1); PG8_STAGE(PG8_SB(0, 0), b2, voffB);
            PG8_BAR; PG8_WAIT_L(0); PG8_MMA(0, 1, At, B1); PG8_BAR;
            PG8_LDA(At, 0, 1); PG8_STAGE(PG8_SA(0, 0), a2, voffA);
            PG8_BAR; PG8_WAIT_L(0); PG8_MMA(1, 0, At, B0); PG8_BAR; PG8_SCHED;
            PG8_STAGE(PG8_SB(0, 1), b2 + hstep, voffB);
            PG8_WAIT_V(6); PG8_BAR; PG8_MMA(1, 1, At, B1); PG8_BAR;
            PG8_LDB(B0, 1, 0); PG8_SCHED; PG8_LDA(At, 1, 0); PG8_STAGE(PG8_SA(0, 1), a2 + hstep, voffA);
            PG8_WAIT_L(8); PG8_BAR; PG8_WAIT_L(0); PG8_MMA(0, 0, At, B0); PG8_BAR; PG8_SCHED;
            PG8_LDB(B1, 1, 1); PG8_STAGE(PG8_SB(1, 0), b3, voffB);
            PG8_BAR; PG8_WAIT_L(0); PG8_MMA(0, 1, At, B1); PG8_BAR;
            PG8_LDA(At, 1, 1); PG8_STAGE(PG8_SA(1, 0), a3, voffA);
            PG8_BAR; PG8_WAIT_L(0); PG8_MMA(1, 0, At, B0); PG8_BAR; PG8_SCHED;
            PG8_STAGE(PG8_SB(1, 1), b3 + hstep, voffB);
            PG8_WAIT_V(6); PG8_BAR; PG8_MMA(1, 1, At, B1); PG8_BAR;
            }
        }
        if constexpr (ALIGN_EPI) { if (wr == 0) PG8_BAR; }
        if constexpr (!Epi::AFTER_DRAIN) { E(acc, cur, wr, wc, fr, fq); S.done(cur); }
        if (!has_next) break;
#pragma unroll
        for (int a = 0; a < 2; ++a)
#pragma unroll
            for (int b = 0; b < 2; ++b)
#pragma unroll
                for (int m = 0; m < 4; ++m)
#pragma unroll
                    for (int n = 0; n < 2; ++n) acc[a][b][m][n] = (f32x4){0.f, 0.f, 0.f, 0.f};
        cur = nxt; cA = nA; cB = nB; ++ui;
        if constexpr (ALIGN_EPI) { if (wr == 1) PG8_BAR; }
    }
    PG8_WAIT_V(0);
    if constexpr (!ALIGN_EPI) { if (wr == 0) PG8_BAR; }
    PG8_BAR;
    if constexpr (Epi::AFTER_DRAIN) { E.fused(acc, cur, wr, wc, fr, fq, lds, wid, lane); S.done(cur); }
#undef PG8_SA
#undef PG8_SB
#undef PG8_STAGE
#undef PG8_LDA
#undef PG8_LDB
#undef PG8_MMA
#undef PG8_WAIT_V
#undef PG8_WAIT_L
#undef PG8_BAR
#undef PG8_SCHED
}
}
typedef unsigned short bf16;
typedef float f32x4v __attribute__((ext_vector_type(4)));
#define LAS __attribute__((address_space(3)))

struct GemmArgs { const bf16* A; const bf16* Bt; float* C; int M, N, K, ldc; };
__global__ void __launch_bounds__(512, 2) k_gemm_f32(GemmArgs a) {
    extern __shared__ __attribute__((aligned(16))) unsigned char lds[];
    pg8::Gemm g{a.A, a.Bt, a.M, a.N, a.K}; pg8::StaticOrder S; S.init(a.M, a.N, (int)gridDim.x, (int)blockIdx.x);
    pg8::EpiF32 E{a.C, a.ldc};
    pg8::gemm_phase<pg8::EpiF32, pg8::StaticOrder, true, true>((LAS unsigned char*)lds, g, S, E);
}
struct InProjArgs { const bf16* A; const bf16* Bt; pg8::EpiInProj E; };
__global__ void __launch_bounds__(512, 2) k_gemm_inproj(InProjArgs a) {
    extern __shared__ __attribute__((aligned(16))) unsigned char lds[];
    pg8::Gemm g{a.A, a.Bt, MT, NINP, D}; pg8::StaticOrder S; S.init(MT, NINP, (int)gridDim.x, (int)blockIdx.x);
    pg8::gemm_phase<pg8::EpiInProj, pg8::StaticOrder, true, true>((LAS unsigned char*)lds, g, S, a.E);
}
struct QArgs { const bf16* A; const bf16* Bt; pg8::EpiQ E; };
__global__ void __launch_bounds__(512, 2) k_gemm_q(QArgs a) {
    extern __shared__ __attribute__((aligned(16))) unsigned char lds[];
    pg8::Gemm g{a.A, a.Bt, MT, MH * QHD, QL}; pg8::StaticOrder S; S.init(MT, MH * QHD, (int)gridDim.x, (int)blockIdx.x);
    pg8::gemm_phase<pg8::EpiQ, pg8::StaticOrder, true, true>((LAS unsigned char*)lds, g, S, a.E);
}
struct KVArgs { const bf16* A; const bf16* Bt; pg8::EpiKV E; };
__global__ void __launch_bounds__(512, 2) k_gemm_kv(KVArgs a) {
    extern __shared__ __attribute__((aligned(16))) unsigned char lds[];
    pg8::Gemm g{a.A, a.Bt, MP, 1024, KVL}; pg8::StaticOrder S; S.init(MP, 1024, (int)gridDim.x, (int)blockIdx.x);
    pg8::gemm_phase<pg8::EpiKV, pg8::StaticOrder, true, true>((LAS unsigned char*)lds, g, S, a.E);
}

__global__ void __launch_bounds__(256) k_mod(const float* __restrict__ c_p, const float* __restrict__ c_s, const float* __restrict__ w_ada, const float* __restrict__ b_ada, float* __restrict__ mod) {
    const int n = blockIdx.x * 256 + threadIdx.x, r0 = blockIdx.y * 13;
    float acc[13];
#pragma unroll
    for (int i = 0; i < 13; ++i) acc[i] = 0.f;
    for (int k = 0; k < D; ++k) {
        const float w = w_ada[(size_t)k * 3072 + n];
#pragma unroll
        for (int i = 0; i < 13; ++i) { const int r = r0 + i; const float cv = r < 2 ? c_p[r * D + k] : c_s[(r - 2) * D + k]; acc[i] += cv * w; }
    }
    const float bb = b_ada[n];
#pragma unroll
    for (int i = 0; i < 13; ++i) mod[(size_t)(r0 + i) * 3072 + n] = acc[i] + bb;
}
__global__ void __launch_bounds__(256) k_wt(const float* __restrict__ W, int ldw, int K, bf16* __restrict__ WT, int mode, const float* __restrict__ gain) {
    __shared__ float tile[32][33];
    const int k0 = blockIdx.x * 32, n0 = blockIdx.y * 32, tx = threadIdx.x, ty = threadIdx.y;
    const int n = n0 + tx, src = mode ? zsrc(n) : n;
    const float cs = (mode && n >= ZK && n < ZV) ? KSCALE : 1.f;
    for (int i = ty; i < 32; i += 8) tile[i][tx] = src >= 0 ? W[(size_t)(k0 + i) * ldw + src] * cs * (gain ? gain[k0 + i] : 1.f) : 0.f;
    __syncthreads();
    for (int i = ty; i < 32; i += 8) WT[(size_t)(n0 + i) * K + k0 + tx] = f2bf(tile[tx][i]);
}
__global__ void __launch_bounds__(256) k_ropetab(float* __restrict__ T) {
    const int i = blockIdx.x * 256 + threadIdx.x; if (i >= (PAST + DS) * 16) return;
    const int pos = i >> 4, j = i & 15; const float inv = powf(10000.f, -(float)j / 16.f), ang = (float)pos * inv; float sn, cs; sincosf(ang, &sn, &cs);
    T[pos * 32 + j] = cs; T[pos * 32 + 16 + j] = sn;
}
__global__ void __launch_bounds__(256) k_hprep(const float* __restrict__ xp, const float* __restrict__ xs, const float* __restrict__ mod, bf16* __restrict__ H) {
    const size_t i4 = (size_t)blockIdx.x * 256 + threadIdx.x;
    const int m = (int)(i4 >> 8), c = (int)(i4 & 255) * 4;
    const float* x = m < MP ? xp + (size_t)m * D : xs + (size_t)(m - MP) * D;
    const float* mr = mod + (size_t)row_modrow(m) * 3072;
    const f32x4v xv = *(const f32x4v*)(x + c), sh = *(const f32x4v*)(mr + c), sc = *(const f32x4v*)(mr + 1024 + c);
    ushort4 o; o.x = f2bf(xv.x * (1.f + sc.x) + sh.x); o.y = f2bf(xv.y * (1.f + sc.y) + sh.y); o.z = f2bf(xv.z * (1.f + sc.z) + sh.z); o.w = f2bf(xv.w * (1.f + sc.w) + sh.w);
    *(ushort4*)(H + (size_t)m * D + c) = o;
}

__global__ void __launch_bounds__(256) k_rows_ckv(const bf16* __restrict__ CKVR, const float* __restrict__ SSKV, const float* __restrict__ kvnorm, float* __restrict__ out) {
    const int lane = threadIdx.x & 63, m = blockIdx.x * 4 + (threadIdx.x >> 6);
    const float4 p = *(const float4*)(SSKV + (size_t)m * 4);
    const float r = rsqrtf(((p.x + p.y) + (p.z + p.w)) * (1.f / KVL) + EPS);
    const ushort4 v = *(const ushort4*)(CKVR + (size_t)m * KVL + 4 * lane); const float4 g = *(const float4*)(kvnorm + 4 * lane);
    float* o = m < MP ? out + O_CKVP + (size_t)m * KVL : out + O_CKVS + (size_t)(m - MP) * KVL;
    *(float4*)(o + 4 * lane) = make_float4(bf2f(v.x) * r * g.x, bf2f(v.y) * r * g.y, bf2f(v.z) * r * g.z, bf2f(v.w) * r * g.w);
}
__global__ void __launch_bounds__(256) k_qlat(const bf16* __restrict__ Q96, const float* __restrict__ w_uk, float* __restrict__ QLAT) {
    __shared__ float qs[MH * NOPE];
    const int ms = blockIdx.x, c = threadIdx.x;
    for (int e = threadIdx.x; e < MH * NOPE; e += 256) qs[e] = bf2f(Q96[(size_t)(MP + ms) * (MH * QHD) + (e >> 6) * QHD + (e & 63)]);
    __syncthreads();
    for (int h = 0; h < MH; ++h) { float acc = 0.f;
        for (int n = 0; n < NOPE; ++n) acc += qs[h * NOPE + n] * w_uk[(size_t)c * (MH * NOPE) + h * NOPE + n];
        QLAT[((size_t)ms * MH + h) * KVL + c] = acc; }
}

__global__ void __launch_bounds__(256) k_attn_prompt_naive(const bf16* __restrict__ Q96, const bf16* __restrict__ KVB, const bf16* __restrict__ KRB, const float* __restrict__ ropet, float* __restrict__ OMLA) {
    const int qb = (int)gridDim.x - 1 - (int)blockIdx.x, b = blockIdx.y / MH, h = blockIdx.y % MH;
    const int t = qb * 256 + threadIdx.x, m = b * SP + t;
    float q[QHD], acc[VD];
#pragma unroll
    for (int j = 0; j < QHD; ++j) q[j] = bf2f(Q96[(size_t)m * (MH * QHD) + h * QHD + j]);
#pragma unroll
    for (int j = 0; j < VD; ++j) acc[j] = 0.f;
#pragma unroll
    for (int j = 0; j < 16; ++j) { const float cs = ropet[t * 32 + j], sn = ropet[t * 32 + 16 + j], x1 = q[NOPE + j], x2 = q[NOPE + 16 + j]; q[NOPE + j] = x1 * cs - x2 * sn; q[NOPE + 16 + j] = x2 * cs + x1 * sn; }
    float mx = -INFINITY, l = 0.f;
    const int jend = qb * 256 + 256;
    for (int j = 0; j < jend; ++j) {
        const bf16* kn = KVB + (size_t)(b * SP + j) * 1024 + h * NOPE; const bf16* kr = KRB + (size_t)(b * SP + j) * ROPE; const bf16* vv = KVB + (size_t)(b * SP + j) * 1024 + 512 + h * VD;
        float s = 0.f;
#pragma unroll
        for (int d = 0; d < NOPE; ++d) s += q[d] * bf2f(kn[d]);
#pragma unroll
        for (int d = 0; d < ROPE; ++d) s += q[NOPE + d] * bf2f(kr[d]);
        if (j <= t) {
            const float mn = fmaxf(mx, s), al = exp2f(mx - mn), p = exp2f(s - mn);
            l = l * al + p; mx = mn;
#pragma unroll
            for (int d = 0; d < VD; ++d) acc[d] = acc[d] * al + p * bf2f(vv[d]);
        }
    }
    const float il = 1.f / l;
#pragma unroll
    for (int d = 0; d < VD; ++d) OMLA[(size_t)m * 512 + h * VD + d] = acc[d] * il;
}

__global__ void __launch_bounds__(256) k_attn_sample_naive(const float* __restrict__ QLAT, const bf16* __restrict__ Q96, const float* __restrict__ cache_ckv, const float* __restrict__ cache_kr,
                                                           const int* __restrict__ page_table, const float* __restrict__ ckv_new  , const bf16* __restrict__ KRB, const float* __restrict__ ropet, float* __restrict__ OLAT) {
    __shared__ float s_m[4][DS], s_l[4][DS], s_acc[4][DS][KVL];
    const int b = blockIdx.x / MH, h = blockIdx.x % MH, lane = threadIdx.x & 63, w = threadIdx.x >> 6;
    float ql[DS][4], qr[DS], acc[DS][4], mx[DS], l[DS];
#pragma unroll
    for (int i = 0; i < DS; ++i) {
#pragma unroll
        for (int j = 0; j < 4; ++j) { ql[i][j] = QLAT[((size_t)(b * DS + i) * MH + h) * KVL + lane + 64 * j]; acc[i][j] = 0.f; }
        { const float x = lane < ROPE ? bf2f(Q96[(size_t)(MP + b * DS + i) * (MH * QHD) + h * QHD + NOPE + lane]) : 0.f, o = __shfl_xor(x, 16);
          const float cs = ropet[(PAST + i) * 32 + (lane & 15)], sn = ropet[(PAST + i) * 32 + 16 + (lane & 15)];
          qr[i] = lane < 16 ? x * cs - o * sn : (lane < 32 ? x * cs + o * sn : 0.f); }
        mx[i] = -INFINITY; l[i] = 0.f;
    }
    for (int key = w; key < PAST + DS; key += 4) {
        const float* kc; const float* kr = nullptr; const bf16* krn = nullptr;
        if (key < PAST) { const int pg = page_table[b * NPAGES + (key >> 7)]; kc = cache_ckv + ((size_t)pg * PAGE + (key & 127)) * KVL; kr = cache_kr + ((size_t)pg * PAGE + (key & 127)) * ROPE; }
        else { kc = ckv_new + (size_t)(b * DS + key - PAST) * KVL; krn = KRB + (size_t)(MP + b * DS + key - PAST) * ROPE; }
        float kv[4];
#pragma unroll
        for (int j = 0; j < 4; ++j) kv[j] = kc[lane + 64 * j];
        const float krv = lane < ROPE ? (kr ? kr[lane] : bf2f(krn[lane])) : 0.f;
#pragma unroll
        for (int i = 0; i < DS; ++i) {
            float s = ql[i][0] * kv[0] + ql[i][1] * kv[1] + ql[i][2] * kv[2] + ql[i][3] * kv[3] + qr[i] * krv;
            s = wave_sum(s);
            if (key < PAST + i + 1) {
                const float mn = fmaxf(mx[i], s), al = exp2f(mx[i] - mn), p = exp2f(s - mn);
                l[i] = l[i] * al + p; mx[i] = mn;
#pragma unroll
                for (int j = 0; j < 4; ++j) acc[i][j] = acc[i][j] * al + p * kv[j];
            }
        }
    }
#pragma unroll
    for (int i = 0; i < DS; ++i) { if (lane == 0) { s_m[w][i] = mx[i]; s_l[w][i] = l[i]; }
#pragma unroll
        for (int j = 0; j < 4; ++j) s_acc[w][i][lane + 64 * j] = acc[i][j]; }
    __syncthreads();
    for (int e = threadIdx.x; e < DS * KVL; e += 256) { const int i = e >> 8, c = e & 255;
        const float mm = fmaxf(fmaxf(s_m[0][i], s_m[1][i]), fmaxf(s_m[2][i], s_m[3][i]));
        float num = 0.f, den = 0.f;
#pragma unroll
        for (int ww = 0; ww < 4; ++ww) { const float f = exp2f(s_m[ww][i] - mm); num += f * s_acc[ww][i][c]; den += f * s_l[ww][i]; }
        OLAT[((size_t)(b * DS + i) * MH + h) * KVL + c] = num / den; }
}
__global__ void __launch_bounds__(512) k_olat_uv(const float* __restrict__ OLAT, const float* __restrict__ w_uv, float* __restrict__ OMLA) {
    __shared__ float os[MH * KVL];
    const int ms = blockIdx.x, tid = threadIdx.x, h = tid >> 6;
    for (int e = tid; e < MH * KVL; e += 512) os[e] = OLAT[(size_t)ms * MH * KVL + e];
    __syncthreads();
    float acc = 0.f;
    for (int c = 0; c < KVL; ++c) acc += os[h * KVL + c] * w_uv[(size_t)c * 512 + tid];
    OMLA[(size_t)(MP + ms) * 512 + tid] = acc;
}

__global__ void __launch_bounds__(256) k_ml_a(const bf16* __restrict__ ZB, const float* __restrict__ GATES, const float* __restrict__ b_i, const float* __restrict__ b_f, float* __restrict__ G, float* __restrict__ U, float* __restrict__ DC, float* __restrict__ DN) {
    __shared__ float s_w[LC], s_F[LC], s_ig[LC], s_red[2];
    const int bh = blockIdx.x / NCH, c = blockIdx.x % NCH, b = bh / LH, h = bh % LH, tid = threadIdx.x;
    const size_t row0 = (size_t)b * SP + (size_t)c * LC;
    if (tid < LC) { const float* z = GATES + (row0 + tid) * 8; s_ig[tid] = z[h] + b_i[h]; s_F[tid] = logsigmoidf_(z[4 + h] + b_f[h]); }
    __syncthreads();
    if (tid == 0) { float f = 0.f; for (int s = 0; s < LC; ++s) { f += s_F[s]; s_F[s] = f; } const float g = f; float u = -INFINITY;
        for (int s = 0; s < LC; ++s) u = fmaxf(u, g - s_F[s] + s_ig[s]); s_red[0] = g; s_red[1] = u; }
    __syncthreads();
    const float g = s_red[0], u = s_red[1];
    if (tid < LC) s_w[tid] = __expf(g - s_F[tid] + s_ig[tid] - u);
    __syncthreads();
    const int dk = tid >> 1, dv0 = (tid & 1) * 64;
    float acc[64]; float an = 0.f;
#pragma unroll
    for (int j = 0; j < 64; ++j) acc[j] = 0.f;
    for (int s = 0; s < LC; ++s) { const bf16* z = ZB + (row0 + s) * 3072; const float kw = bf2f(z[ZK + h * DK + dk]) * s_w[s]; an += kw;
#pragma unroll
        for (int j = 0; j < 64; ++j) acc[j] += kw * bf2f(z[ZV + h * DV + dv0 + j]); }
    float* dc = DC + ((size_t)blockIdx.x * DK + dk) * DV + dv0;
#pragma unroll
    for (int j = 0; j < 64; ++j) dc[j] = acc[j];
    if ((tid & 1) == 0) DN[(size_t)blockIdx.x * DK + dk] = an;
    if (tid == 0) { G[blockIdx.x] = g; U[blockIdx.x] = u; }
}
__global__ void __launch_bounds__(256) k_ml_b(const float* __restrict__ G, const float* __restrict__ U, const float* __restrict__ DC, const float* __restrict__ DN,
                                              float* __restrict__ CS, float* __restrict__ NS, float* __restrict__ MSs, float* __restrict__ out) {
    const int gid = blockIdx.x * 256 + threadIdx.x, bh = gid / (DK * DV + DK), e = gid % (DK * DV + DK);
    float m = -INFINITY, x = 0.f;
    for (int c = 0; c < NCH; ++c) {
        const int ci = bh * NCH + c;
        if (e < DK * DV) CS[(size_t)ci * DK * DV + e] = x; else NS[(size_t)ci * DK + (e - DK * DV)] = x;
        if (e == 0) MSs[ci] = m;
        const float g = G[ci], u = U[ci], mn = fmaxf(g + m, u), al = __expf(g + m - mn), be = __expf(u - mn);
        const float d = e < DK * DV ? DC[(size_t)ci * DK * DV + e] : DN[(size_t)ci * DK + (e - DK * DV)];
        x = al * x + be * d; m = mn;
    }
    if (e < DK * DV) out[O_CP + (size_t)bh * DK * DV + e] = x; else out[O_NP + (size_t)bh * DK + (e - DK * DV)] = x;
    if (e == 0) out[O_MPR + bh] = m;
}
__global__ void __launch_bounds__(256) k_ml_c(const bf16* __restrict__ ZB, const float* __restrict__ GATES, const float* __restrict__ b_i, const float* __restrict__ b_f, const float* __restrict__ CS, const float* __restrict__ NS, const float* __restrict__ MSs, float* __restrict__ HML) {
    __shared__ float s_F[LC], s_ig[LC];
    const int bh = blockIdx.x / NCH, c = blockIdx.x % NCH, b = bh / LH, h = bh % LH, tid = threadIdx.x;
    const size_t row0 = (size_t)b * SP + (size_t)c * LC;
    if (tid < LC) { const float* z = GATES + (row0 + tid) * 8; s_ig[tid] = z[h] + b_i[h]; s_F[tid] = logsigmoidf_(z[4 + h] + b_f[h]); }
    __syncthreads();
    if (tid == 0) { float f = 0.f; for (int s = 0; s < LC; ++s) { f += s_F[s]; s_F[s] = f; } }
    __syncthreads();
    const int t = tid >> 1, dv0 = (tid & 1) * 64;
    const float mprev = MSs[blockIdx.x], Ft = s_F[t];
    float mt = Ft + mprev;
    for (int s = 0; s <= t; ++s) mt = fmaxf(mt, Ft - s_F[s] + s_ig[s]);
    const float a = __expf(Ft + mprev - mt);
    const bf16* zq = ZB + (row0 + t) * 3072 + ZQ + h * DK;
    float acc[64]; float den = 0.f;
#pragma unroll
    for (int j = 0; j < 64; ++j) acc[j] = 0.f;
    for (int s = 0; s <= t; ++s) {
        const bf16* z = ZB + (row0 + s) * 3072; float dot = 0.f;
        for (int d = 0; d < DK; ++d) dot += bf2f(zq[d]) * bf2f(z[ZK + h * DK + d]);
        const float sq = dot * __expf(Ft - s_F[s] + s_ig[s] - mt); den += sq;
#pragma unroll
        for (int j = 0; j < 64; ++j) acc[j] += sq * bf2f(z[ZV + h * DV + dv0 + j]);
    }
    const float* cs = CS + (size_t)blockIdx.x * DK * DV; const float* ns = NS + (size_t)blockIdx.x * DK;
    float qn = 0.f;
    for (int d = 0; d < DK; ++d) { const float qa = bf2f(zq[d]) * a; qn += qa * ns[d];
#pragma unroll
        for (int j = 0; j < 64; ++j) acc[j] += qa * cs[(size_t)d * DV + dv0 + j]; }
    den += qn;
    const float inv = 1.f / fmaxf(fabsf(den), __expf(-mt));
    float* o = HML + (row0 + t) * 512 + h * DV + dv0;
#pragma unroll
    for (int j = 0; j < 64; ++j) o[j] = acc[j] * inv;
}
__global__ void __launch_bounds__(256) k_ml_sample(const bf16* __restrict__ ZB, const float* __restrict__ GATES, const float* __restrict__ b_i, const float* __restrict__ b_f, const float* __restrict__ C0, const float* __restrict__ n0, const float* __restrict__ m0,
                                                   float* __restrict__ HML, float* __restrict__ out) {
    __shared__ float s_q[DS][DK], s_k[DS][DK], s_v[DS][DV], s_F[DS], s_ig[DS], s_mt[DS], s_a[DS], s_S[DS][DS], s_den[DS], s_qc[2][DS][DV], s_wl[DS];
    const int b = blockIdx.x / LH, h = blockIdx.x % LH, tid = threadIdx.x;
    const size_t row0 = (size_t)MP + (size_t)b * DS;
    for (int e = tid; e < DS * DK; e += 256) { const int t = e >> 7, d = e & 127; const bf16* z = ZB + (row0 + t) * 3072;
        s_q[t][d] = bf2f(z[ZQ + h * DK + d]); s_k[t][d] = bf2f(z[ZK + h * DK + d]); s_v[t][d] = bf2f(z[ZV + h * DV + d]); }
    if (tid < DS) { const float* z = GATES + (row0 + tid) * 8; s_ig[tid] = z[h] + b_i[h]; s_F[tid] = logsigmoidf_(z[4 + h] + b_f[h]); }
    __syncthreads();
    const float mprev = m0[b * LH + h];
    if (tid == 0) { float f = 0.f; for (int s = 0; s < DS; ++s) { f += s_F[s]; s_F[s] = f; }
        for (int t = 0; t < DS; ++t) { float mt = s_F[t] + mprev; for (int s = 0; s <= t; ++s) mt = fmaxf(mt, s_F[t] - s_F[s] + s_ig[s]); s_mt[t] = mt; s_a[t] = __expf(s_F[t] + mprev - mt); }
        for (int s = 0; s < DS; ++s) s_wl[s] = __expf(s_F[DS - 1] - s_F[s] + s_ig[s] - s_mt[DS - 1]); }
    __syncthreads();
    if (tid < DS * DS) { const int t = tid >> 3, s = tid & 7; float v = 0.f;
        if (s <= t) { float dot = 0.f; for (int d = 0; d < DK; ++d) dot += s_q[t][d] * s_k[s][d]; v = dot * __expf(s_F[t] - s_F[s] + s_ig[s] - s_mt[t]); }
        s_S[t][s] = v; }
    __syncthreads();
    const int dv = tid & 127, hf = tid >> 7;
    const float* c0 = C0 + (size_t)blockIdx.x * DK * DV; float* cn = out + O_CS + (size_t)blockIdx.x * DK * DV;
    const float al = s_a[DS - 1];
    float qc[DS];
#pragma unroll
    for (int t = 0; t < DS; ++t) qc[t] = 0.f;
    for (int d = hf * 64; d < hf * 64 + 64; ++d) {
        const float cv = c0[(size_t)d * DV + dv]; float nv = al * cv;
#pragma unroll
        for (int t = 0; t < DS; ++t) { qc[t] += s_q[t][d] * cv; nv += s_wl[t] * s_k[t][d] * s_v[t][dv]; }
        cn[(size_t)d * DV + dv] = nv;
    }
#pragma unroll
    for (int t = 0; t < DS; ++t) s_qc[hf][t][dv] = qc[t];
    if (tid < DS) { const int t = tid; float dn = 0.f; for (int s = 0; s <= t; ++s) dn += s_S[t][s]; float qn = 0.f; const float* nn = n0 + (size_t)blockIdx.x * DK;
        for (int d = 0; d < DK; ++d) qn += s_q[t][d] * nn[d]; s_den[t] = dn + s_a[t] * qn; }
    if (tid >= 128 && tid < 128 + DK) { const int d = tid - 128; float nv = al * n0[(size_t)blockIdx.x * DK + d];
        for (int s = 0; s < DS; ++s) nv += s_wl[s] * s_k[s][d]; out[O_NS + (size_t)blockIdx.x * DK + d] = nv; }
    if (tid == 0) out[O_MS + blockIdx.x] = s_mt[DS - 1];
    __syncthreads();
    for (int e = tid; e < DS * DV; e += 256) { const int t = e >> 7, d = e & 127; float num = s_a[t] * (s_qc[0][t][d] + s_qc[1][t][d]);
        for (int s = 0; s <= t; ++s) num += s_S[t][s] * s_v[s][d];
        HML[(row0 + t) * 512 + h * DV + d] = num / fmaxf(fabsf(s_den[t]), __expf(-s_mt[t])); }
}

__global__ void __launch_bounds__(256) k_back_rows(const bf16* __restrict__ ZB, const float* __restrict__ HML, const float* __restrict__ OMLA, const float* __restrict__ gn, bf16* __restrict__ YCAT) {
    const int lane = threadIdx.x & 63, m = blockIdx.x * 4 + (threadIdx.x >> 6);
    const bf16* z = ZB + (size_t)m * 3072;
#pragma unroll
    for (int h = 0; h < LH; ++h) {
        const int c0 = h * DV + lane, c1 = c0 + 64;
        const float a0 = HML[(size_t)m * 512 + c0] * sigmoidf_(bf2f(z[ZO + c0])), a1 = HML[(size_t)m * 512 + c1] * sigmoidf_(bf2f(z[ZO + c1]));
        const float mu = wave_sum(a0 + a1) * (1.f / DV), d0 = a0 - mu, d1 = a1 - mu, var = wave_sum(d0 * d0 + d1 * d1) * (1.f / DV), r = rsqrtf(var + EPS);
        YCAT[(size_t)m * D + c0] = f2bf(d0 * r * gn[c0] * siluf_(bf2f(z[ZZ + c0]))); YCAT[(size_t)m * D + c1] = f2bf(d1 * r * gn[c1] * siluf_(bf2f(z[ZZ + c1])));
    }
#pragma unroll
    for (int i = 0; i < 8; ++i) { const int c = lane + 64 * i; YCAT[(size_t)m * D + 512 + c] = f2bf(OMLA[(size_t)m * 512 + c] * siluf_(bf2f(z[ZAZ + c]))); }
}
__global__ void __launch_bounds__(256) k_final_ln(const float* __restrict__ xp, const float* __restrict__ xs, const float* __restrict__ mod, const float* __restrict__ OUT, const float* __restrict__ lg, const float* __restrict__ lb, float* __restrict__ out) {
    const int lane = threadIdx.x & 63, m = blockIdx.x * 4 + (threadIdx.x >> 6);
    const float* x = m < MP ? xp + (size_t)m * D : xs + (size_t)(m - MP) * D;
    const float* gate = mod + (size_t)row_modrow(m) * 3072 + 2048;
    float* y = m < MP ? out + O_YP + (size_t)m * D : out + O_YS + (size_t)(m - MP) * D;
    f32x4v v[4]; float s = 0.f;
#pragma unroll
    for (int j = 0; j < 4; ++j) { const int c = 4 * lane + 256 * j; const f32x4v xv = *(const f32x4v*)(x + c), gv = *(const f32x4v*)(gate + c), ov = *(const f32x4v*)(OUT + (size_t)m * D + c);
        v[j] = xv * ALPHA + gv * ov; s += (v[j].x + v[j].y) + (v[j].z + v[j].w); }
    const float mu = wave_sum(s) * (1.f / D); float s2 = 0.f;
#pragma unroll
    for (int j = 0; j < 4; ++j) { v[j] = v[j] - mu; s2 += (v[j].x * v[j].x + v[j].y * v[j].y) + (v[j].z * v[j].z + v[j].w * v[j].w); }
    const float r = rsqrtf(wave_sum(s2) * (1.f / D) + EPS);
#pragma unroll
    for (int j = 0; j < 4; ++j) { const int c = 4 * lane + 256 * j; const f32x4v g = *(const f32x4v*)(lg + c), bb = *(const f32x4v*)(lb + c); *(f32x4v*)(y + c) = v[j] * r * g + bb; }
}

static void launch_gemm(const bf16* A, const bf16* Bt, float* C, int M, int N, int K, int ldc, hipStream_t stream) {
    GemmArgs a{}; a.A = A; a.Bt = Bt; a.C = C; a.M = M; a.N = N; a.K = K; a.ldc = ldc;
    hipLaunchKernelGGL(k_gemm_f32, dim3(256), dim3(512), pg8::STAGE_BYTES, stream, a);
}
extern "C" void kernel_launch(void* const* d_in, const int* in_sizes, int n_in, void* d_out, int out_size, void* d_ws, size_t ws_size, hipStream_t stream) {
    static int ready = 0;
    if (ready == 0) {
        if (n_in != 24 || out_size != (int)O_END || ws_size < WS_END) { fprintf(stderr, "kernel_launch: unexpected shapes: n_in %d out %d ws %zu\n", n_in, out_size, ws_size); ready = -1; return; }
        const void* gk[4] = {(const void*)k_gemm_f32, (const void*)k_gemm_inproj, (const void*)k_gemm_q, (const void*)k_gemm_kv};
        for (int i = 0; i < 4; ++i) if (hipFuncSetAttribute(gk[i], hipFuncAttributeMaxDynamicSharedMemorySize, pg8::STAGE_BYTES) != hipSuccess) { fprintf(stderr, "kernel_launch: hipFuncSetAttribute failed\n"); ready = -1; return; }
        ready = 1;
    }
    if (ready < 0) return;
    const float* xp = (const float*)d_in[0]; const float* xs = (const float*)d_in[1]; const float* cp = (const float*)d_in[2]; const float* cs = (const float*)d_in[3];
    const float* cache_ckv = (const float*)d_in[4]; const float* cache_kr = (const float*)d_in[5]; const float* st_C = (const float*)d_in[6]; const float* st_n = (const float*)d_in[7]; const float* st_m = (const float*)d_in[8];
    const int* page_table = (const int*)d_in[9];
    const float* w_ada = (const float*)d_in[10]; const float* b_ada = (const float*)d_in[11]; const float* w_in = (const float*)d_in[12]; const float* b_i = (const float*)d_in[13]; const float* b_f = (const float*)d_in[14];
    const float* ml_gn = (const float*)d_in[15]; const float* qnorm = (const float*)d_in[16]; const float* kvnorm = (const float*)d_in[17]; const float* w_uq = (const float*)d_in[18]; const float* w_uk = (const float*)d_in[19];
    const float* w_uv = (const float*)d_in[20]; const float* w_out = (const float*)d_in[21]; const float* ln_g = (const float*)d_in[22]; const float* ln_b = (const float*)d_in[23];
    float* out = (float*)d_out; unsigned char* ws = (unsigned char*)d_ws;
    float* MOD = (float*)(ws + WS_MOD); float* ROPET = (float*)(ws + WS_ROPET); bf16* WIN = (bf16*)(ws + WS_WIN); bf16* WUQ = (bf16*)(ws + WS_WUQ); bf16* WKV = (bf16*)(ws + WS_WKV); bf16* WOUT = (bf16*)(ws + WS_WOUT);
    bf16* H = (bf16*)(ws + WS_H); bf16* ZB = (bf16*)(ws + WS_ZB); float* GATES = (float*)(ws + WS_GATES); bf16* CKVR = (bf16*)(ws + WS_CKVR); bf16* CQR = (bf16*)(ws + WS_CQR);
    float* SSKV = (float*)(ws + WS_SSKV); float* SSQ = (float*)(ws + WS_SSQ); bf16* KRB = (bf16*)(ws + WS_KRB); bf16* Q96 = (bf16*)(ws + WS_Q96); bf16* KVB = (bf16*)(ws + WS_KVB);
    float* QLAT = (float*)(ws + WS_QLAT); float* OLAT = (float*)(ws + WS_OLAT); float* OMLA = (float*)(ws + WS_OMLA);
    float* HML = (float*)(ws + WS_HML); float* MLG = (float*)(ws + WS_MLG); float* MLU = (float*)(ws + WS_MLU); float* MLDC = (float*)(ws + WS_MLDC); float* MLDN = (float*)(ws + WS_MLDN);
    float* MLCS = (float*)(ws + WS_MLCS); float* MLNS = (float*)(ws + WS_MLNS); float* MLMS = (float*)(ws + WS_MLMS); bf16* YCAT = (bf16*)(ws + WS_YCAT); float* OUT = (float*)(ws + WS_OUT);

    hipLaunchKernelGGL(k_mod, dim3(12, 10), dim3(256), 0, stream, cp, cs, w_ada, b_ada, MOD);
    hipLaunchKernelGGL(k_ropetab, dim3(((PAST + DS) * 16 + 255) / 256), dim3(256), 0, stream, ROPET);
    hipLaunchKernelGGL(k_wt, dim3(D / 32, NINP / 32), dim3(32, 8), 0, stream, w_in, NIN, D, WIN, 1, (const float*)nullptr);
    hipLaunchKernelGGL(k_wt, dim3(QL / 32, (MH * QHD) / 32), dim3(32, 8), 0, stream, w_uq, MH * QHD, QL, WUQ, 0, qnorm);
    hipLaunchKernelGGL(k_wt, dim3(KVL / 32, 512 / 32), dim3(32, 8), 0, stream, w_uk, 512, KVL, WKV, 0, kvnorm);
    hipLaunchKernelGGL(k_wt, dim3(KVL / 32, 512 / 32), dim3(32, 8), 0, stream, w_uv, 512, KVL, WKV + (size_t)512 * KVL, 0, kvnorm);
    hipLaunchKernelGGL(k_wt, dim3(D / 32, D / 32), dim3(32, 8), 0, stream, w_out, D, D, WOUT, 0, (const float*)nullptr);
    hipLaunchKernelGGL(k_hprep, dim3(MT), dim3(256), 0, stream, xp, xs, MOD, H);
    { InProjArgs a{}; a.A = H; a.Bt = WIN; a.E.ZB = ZB; a.E.CKVR = CKVR; a.E.CQR = CQR; a.E.SSKV = SSKV; a.E.SSQ = SSQ; a.E.GATES = GATES; a.E.KRB = KRB; a.E.out_krp = out + O_KRP; a.E.out_krs = out + O_KRS; a.E.ropet = ROPET;
      hipLaunchKernelGGL(k_gemm_inproj, dim3(256), dim3(512), pg8::STAGE_BYTES, stream, a); }
    { QArgs a{}; a.A = CQR; a.Bt = WUQ; a.E.Q96 = Q96; a.E.SSQ = SSQ; a.E.qscale = MLA_SCALE * LOG2E;
      hipLaunchKernelGGL(k_gemm_q, dim3(256), dim3(512), pg8::STAGE_BYTES, stream, a); }
    { KVArgs a{}; a.A = CKVR; a.Bt = WKV; a.E.KVB = KVB; a.E.SSKV = SSKV;
      hipLaunchKernelGGL(k_gemm_kv, dim3(256), dim3(512), pg8::STAGE_BYTES, stream, a); }
    hipLaunchKernelGGL(k_rows_ckv, dim3(MT / 4), dim3(256), 0, stream, CKVR, SSKV, kvnorm, out);
    hipLaunchKernelGGL(k_qlat, dim3(MS), dim3(256), 0, stream, Q96, w_uk, QLAT);
    hipLaunchKernelGGL(k_attn_prompt_naive, dim3(SP / 256, BP * MH), dim3(256), 0, stream, Q96, KVB, KRB, ROPET, OMLA);
    hipLaunchKernelGGL(k_attn_sample_naive, dim3(DB * MH), dim3(256), 0, stream, QLAT, Q96, cache_ckv, cache_kr, page_table, out + O_CKVS, KRB, ROPET, OLAT);
    hipLaunchKernelGGL(k_olat_uv, dim3(MS), dim3(512), 0, stream, OLAT, w_uv, OMLA);
    hipLaunchKernelGGL(k_ml_a, dim3(BP * LH * NCH), dim3(256), 0, stream, ZB, GATES, b_i, b_f, MLG, MLU, MLDC, MLDN);
    hipLaunchKernelGGL(k_ml_b, dim3(BP * LH * (DK * DV + DK) / 256), dim3(256), 0, stream, MLG, MLU, MLDC, MLDN, MLCS, MLNS, MLMS, out);
    hipLaunchKernelGGL(k_ml_c, dim3(BP * LH * NCH), dim3(256), 0, stream, ZB, GATES, b_i, b_f, MLCS, MLNS, MLMS, HML);
    hipLaunchKernelGGL(k_ml_sample, dim3(DB * LH), dim3(256), 0, stream, ZB, GATES, b_i, b_f, st_C, st_n, st_m, HML, out);
    hipLaunchKernelGGL(k_back_rows, dim3(MT / 4), dim3(256), 0, stream, ZB, HML, OMLA, ml_gn, YCAT);
    launch_gemm(YCAT, WOUT, OUT, MT, D, D, D, stream);
    hipLaunchKernelGGL(k_final_ln, dim3(MT / 4), dim3(256), 0, stream, xp, xs, MOD, OUT, ln_g, ln_b, out);
}
```

```cpp
#include <hip/hip_runtime.h>
#include <cstdio>
#include <cstdint>
#include <cmath>

constexpr int D = 1024, BP = 2, SP = 8192, MP = BP * SP, DB = 128, DS = 8, MS = DB * DS, MT = MP + MS;
constexpr int NIN = 3752, NINP = 3840;
constexpr int QL = 384, KVL = 256, ROPE = 32, NOPE = 64, MH = 8, VD = 64, QHD = NOPE + ROPE;
constexpr int LH = 4, DK = 128, DV = 128, LC = 128, NCH = SP / LC;
constexpr int PAGE = 128, NPAGES = 64, PAST = 8192;
constexpr float EPS = 1e-6f, ALPHA = 1.189207115002721f, MLA_SCALE = 0.10206207261596575f  , KSCALE = 0.08838834764831845f  ;
constexpr int ZQ = 0, ZK = 512, ZV = 1024, ZO = 1536, ZZ = 2048, ZAZ = 2560, ZCKV = 3072, ZCQ = 3328, ZKR = 3712, ZMI = 3744, ZMF = 3748;
constexpr size_t O_YP = 0, O_YS = 16777216, O_CKVP = 17825792, O_KRP = 22020096, O_CP = 22544384, O_NP = 22675456, O_MPR = 22676480,
                 O_CKVS = 22676488, O_KRS = 22938632, O_CS = 22971400, O_NS = 31360008, O_MS = 31425544, O_END = 31426056;
constexpr size_t MiB = 1u << 20;
constexpr size_t WS_CTL = 0, WS_MOD = 1 * MiB, WS_ROPET = 260 * MiB, WS_WIN = 4 * MiB, WS_WUQ = 12 * MiB, WS_WKV = 13 * MiB, WS_WOUT = 14 * MiB, WS_H = 16 * MiB,
                 WS_ZB = 64 * MiB  , WS_GATES = 168 * MiB, WS_CKVR = 170 * MiB  , WS_CQR = 180 * MiB  , WS_SSKV = 194 * MiB, WS_SSQ = 195 * MiB,
                 WS_KRB = 196 * MiB  , WS_Q96 = 198 * MiB  , WS_KVB = 224 * MiB  , WS_QLAT = 484 * MiB,
                 WS_OLAT = 492 * MiB, WS_OMLA = 500 * MiB, WS_HML = 536 * MiB, WS_MLG = 572 * MiB, WS_MLU = 573 * MiB, WS_MLDC = 576 * MiB, WS_MLDN = 608 * MiB,
                 WS_MLCS = 612 * MiB, WS_MLNS = 644 * MiB, WS_MLMS = 646 * MiB, WS_YCAT = 648 * MiB, WS_OUT = 684 * MiB, WS_END = 752 * MiB;
constexpr float LOG2E = 1.4426950408889634f;

__host__ __device__ __forceinline__ int zsrc(int j) {
    if (j < 1536) return j;
    if (j < 2560) return j + 8;
    if (j < 3072) return 3240 + (j - 2560);
    if (j < 3328) return 2952 + (j - 3072);
    if (j < 3712) return 2568 + (j - 3328);
    if (j < 3744) return 3208 + (j - 3712);
    if (j < 3752) return 1536 + (j - 3744);
    return -1;
}
__device__ __forceinline__ unsigned short f2bf(float f) { unsigned u = __builtin_bit_cast(unsigned, f); return (unsigned short)((u + 0x7fffu + ((u >> 16) & 1u)) >> 16); }
__device__ __forceinline__ float bf2f(unsigned short h) { return __builtin_bit_cast(float, (unsigned)h << 16); }
__device__ __forceinline__ float wave_sum(float v) {
#pragma unroll
    for (int o = 1; o < 64; o <<= 1) v += __shfl_xor(v, o);
    return v;
}
__device__ __forceinline__ float wave_max(float v) {
#pragma unroll
    for (int o = 1; o < 64; o <<= 1) v = fmaxf(v, __shfl_xor(v, o));
    return v;
}
__device__ __forceinline__ float sigmoidf_(float x) { return 1.f / (1.f + __expf(-x)); }
__device__ __forceinline__ float siluf_(float x) { return x / (1.f + __expf(-x)); }
__device__ __forceinline__ float logsigmoidf_(float x) { return x >= 0.f ? -log1pf(expf(-x)) : x - log1pf(expf(x)); }
__device__ __forceinline__ int row_pos(int m) { return m < MP ? (m & (SP - 1)) : PAST + ((m - MP) & (DS - 1)); }
__device__ __forceinline__ int row_modrow(int m) { return m < MP ? (m >> 13) : 2 + ((m - MP) >> 3); }
namespace pg8 {
#define PG8_LAS __attribute__((address_space(3)))
typedef unsigned short bf16_t;
typedef short bf16x8 __attribute__((ext_vector_type(8)));
typedef float f32x4 __attribute__((ext_vector_type(4)));
typedef unsigned u32x4 __attribute__((ext_vector_type(4)));
constexpr int BM = 256, BK = 64, HALF = 128, HTB = HALF * BK * 2  , STAGE_BYTES = 8 * HTB, NXCD = 8, WGM = 8;

__host__ __device__ __forceinline__ int lds_byte(int r, int c) { const int st = (r >> 4) * 2 + (c >> 5), rr = r & 15, cc = c & 31, ob = rr * 64 + cc * 2; return st * 1024 + (ob ^ (((ob >> 9) & 1) << 5)); }
__host__ __device__ __forceinline__ void stage_rc(int b, int& R, int& C) { const int st = b / 1024, sb = b % 1024, swz = sb ^ (((sb >> 9) & 1) << 5); R = (st >> 1) * 16 + swz / 64; C = (st & 1) * 32 + (swz % 64) / 2; }
__host__ __device__ __forceinline__ int perm32(int rho) { const int n = rho >> 4, i = rho & 15; return 8 * (i >> 2) + 4 * n + (i & 3); }

struct Unit { int pm, pn; };
struct Gemm { const bf16_t* A; const bf16_t* Bt; int M, N, K; };

struct StaticOrder {
    int nM, nN, nwg, G, c;
    __host__ __device__ void init(int M, int N, int G_, int c_) { nM = M / BM; nN = N / BM; nwg = nM * nN; G = G_; c = c_; }
    __host__ __device__ bool next(int i, Unit& u) const {
        const long L = (long)i * G + c; if (L >= nwg) return false;
        int wgid = (int)L; { const int q = nwg / NXCD, r = nwg % NXCD, xcd = wgid % NXCD, off = wgid / NXCD; wgid = (xcd < r ? xcd * (q + 1) : r * (q + 1) + (xcd - r) * q) + off; }
        const int nig = WGM * nN, gid = wgid / nig, fm = gid * WGM, gsz = (nM - fm) < WGM ? (nM - fm) : WGM;
        u.pm = fm + ((wgid % nig) % gsz); u.pn = (wgid % nig) / gsz; return true;
    }
    __device__ __forceinline__ void a_ready(const Unit&) const {}
    __device__ __forceinline__ void done(const Unit&) const {}
};

__device__ __forceinline__ unsigned cvt_pk_bf16(float lo, float hi) { unsigned r; asm volatile("v_cvt_pk_bf16_f32 %0, %1, %2" : "=v"(r) : "v"(lo), "v"(hi)); return r; }
__device__ __forceinline__ u32x4 pack8(const f32x4& v0, const f32x4& v1) { u32x4 w; w.x = cvt_pk_bf16(v0[0], v0[1]); w.y = cvt_pk_bf16(v0[2], v0[3]); w.z = cvt_pk_bf16(v1[0], v1[1]); w.w = cvt_pk_bf16(v1[2], v1[3]); return w; }
__device__ __forceinline__ float sq8(const f32x4& a, const f32x4& b) { return (a[0] * a[0] + a[1] * a[1]) + (a[2] * a[2] + a[3] * a[3]) + (b[0] * b[0] + b[1] * b[1]) + (b[2] * b[2] + b[3] * b[3]); }
__device__ __forceinline__ int epi_row_pos(int m) { return m < 16384 ? (m & 8191) : 8192 + ((m - 16384) & 7); }
__device__ __forceinline__ void rope8(f32x4& v0, f32x4& v1, const float* tab, int fq) {
    const int j0 = 8 * (fq & 1);
    const f32x4 c0 = *(const f32x4*)(tab + j0), c1 = *(const f32x4*)(tab + j0 + 4), s0 = *(const f32x4*)(tab + 16 + j0), s1 = *(const f32x4*)(tab + 16 + j0 + 4);
    f32x4 o0, o1;
#pragma unroll
    for (int i = 0; i < 4; ++i) { o0[i] = __shfl_xor(v0[i], 32); o1[i] = __shfl_xor(v1[i], 32); }
    if (fq < 2) { v0 = v0 * c0 - o0 * s0; v1 = v1 * c1 - o1 * s1; } else { v0 = v0 * c0 + o0 * s0; v1 = v1 * c1 + o1 * s1; }
}
struct EpiInProj {
    static constexpr bool PERM = true, AFTER_DRAIN = false;
    bf16_t* ZB; bf16_t* CKVR; bf16_t* CQR; float* SSKV; float* SSQ; float* GATES; bf16_t* KRB; float* out_krp; float* out_krs; const float* ropet;
    __device__ __forceinline__ void operator()(const f32x4 (&acc)[2][2][4][2], const Unit& u, int wr, int wc, int fr, int fq) const {
        const int row0 = u.pm * BM + wr * 64 + fr, cw = wc * 32 + 8 * fq;
        if (u.pn < 12) {
#pragma unroll
            for (int ai = 0; ai < 2; ++ai)
#pragma unroll
                for (int m = 0; m < 4; ++m) { bf16_t* rowp = ZB + (size_t)(row0 + ai * HALF + m * 16) * 3072 + u.pn * BM + cw;
#pragma unroll
                    for (int bj = 0; bj < 2; ++bj) *(u32x4*)(rowp + bj * HALF) = pack8(acc[ai][bj][m][0], acc[ai][bj][m][1]); }
        } else if (u.pn < 14) {
            bf16_t* dst = u.pn == 12 ? CKVR : CQR; const int ld = u.pn == 12 ? 256 : 384; float* ss = u.pn == 12 ? SSKV : SSQ; const int ssl = u.pn == 12 ? 4 : 8;
#pragma unroll
            for (int ai = 0; ai < 2; ++ai)
#pragma unroll
                for (int m = 0; m < 4; ++m) { const int row = row0 + ai * HALF + m * 16; bf16_t* rowp = dst + (size_t)row * ld + cw;
                    float s = 0.f;
#pragma unroll
                    for (int bj = 0; bj < 2; ++bj) { *(u32x4*)(rowp + bj * HALF) = pack8(acc[ai][bj][m][0], acc[ai][bj][m][1]); s += sq8(acc[ai][bj][m][0], acc[ai][bj][m][1]); }
                    s += __shfl_xor(s, 16); s += __shfl_xor(s, 32);
                    if (fq == 0) ss[(size_t)row * ssl + wc] = s; }
        } else {
#pragma unroll
            for (int ai = 0; ai < 2; ++ai)
#pragma unroll
                for (int m = 0; m < 4; ++m) { const int row = row0 + ai * HALF + m * 16;
                    *(u32x4*)(CQR + (size_t)row * 384 + 256 + cw) = pack8(acc[ai][0][m][0], acc[ai][0][m][1]);
                    float s = sq8(acc[ai][0][m][0], acc[ai][0][m][1]);
                    s += __shfl_xor(s, 16); s += __shfl_xor(s, 32);
                    if (fq == 0) SSQ[(size_t)row * 8 + 4 + wc] = s;
                    if (wc == 0) {
                        f32x4 v0 = acc[ai][1][m][0], v1 = acc[ai][1][m][1];
                        rope8(v0, v1, ropet + (size_t)epi_row_pos(row) * 32, fq);
                        float* o = row < 16384 ? out_krp + (size_t)row * 32 : out_krs + (size_t)(row - 16384) * 32;
                        *(f32x4*)(o + 8 * fq) = v0; *(f32x4*)(o + 8 * fq + 4) = v1;
                        *(u32x4*)(KRB + (size_t)row * 32 + 8 * fq) = pack8(v0, v1);
                    } else if (wc == 1 && fq == 0) {
                        *(f32x4*)(GATES + (size_t)row * 8) = acc[ai][1][m][0]; *(f32x4*)(GATES + (size_t)row * 8 + 4) = acc[ai][1][m][1];
                    } }
        }
    }
    __device__ __forceinline__ void fused(f32x4 (&)[2][2][4][2], const Unit&, int, int, int, int, PG8_LAS unsigned char*, int, int) const {}
};
struct EpiQ {
    static constexpr bool PERM = true, AFTER_DRAIN = false;
    bf16_t* Q96; const float* SSQ; float qscale;
    __device__ __forceinline__ void operator()(const f32x4 (&acc)[2][2][4][2], const Unit& u, int wr, int wc, int fr, int fq) const {
        const int row0 = u.pm * BM + wr * 64 + fr, cw = wc * 32 + 8 * fq;
#pragma unroll
        for (int ai = 0; ai < 2; ++ai)
#pragma unroll
            for (int m = 0; m < 4; ++m) { const int row = row0 + ai * HALF + m * 16;
                const f32x4 p0 = *(const f32x4*)(SSQ + (size_t)row * 8), p1 = *(const f32x4*)(SSQ + (size_t)row * 8 + 4);
                const float ssum = ((p0[0] + p0[1]) + (p0[2] + p0[3])) + ((p1[0] + p1[1]) + (p1[2] + p1[3]));
                const float rs = __builtin_amdgcn_rsqf(ssum * (1.0f / 384.0f) + 1e-6f) * qscale;
#pragma unroll
                for (int bj = 0; bj < 2; ++bj) *(u32x4*)(Q96 + (size_t)row * 768 + u.pn * BM + bj * HALF + cw) = pack8(acc[ai][bj][m][0] * rs, acc[ai][bj][m][1] * rs); }
    }
    __device__ __forceinline__ void fused(f32x4 (&)[2][2][4][2], const Unit&, int, int, int, int, PG8_LAS unsigned char*, int, int) const {}
};
struct EpiKV {
    static constexpr bool PERM = true, AFTER_DRAIN = false;
    bf16_t* KVB; const float* SSKV;
    __device__ __forceinline__ void operator()(const f32x4 (&acc)[2][2][4][2], const Unit& u, int wr, int wc, int fr, int fq) const {
        const int row0 = u.pm * BM + wr * 64 + fr, cw = wc * 32 + 8 * fq;
#pragma unroll
        for (int ai = 0; ai < 2; ++ai)
#pragma unroll
            for (int m = 0; m < 4; ++m) { const int row = row0 + ai * HALF + m * 16;
                const f32x4 p0 = *(const f32x4*)(SSKV + (size_t)row * 4);
                const float rs = __builtin_amdgcn_rsqf(((p0[0] + p0[1]) + (p0[2] + p0[3])) * (1.0f / 256.0f) + 1e-6f);
#pragma unroll
                for (int bj = 0; bj < 2; ++bj) *(u32x4*)(KVB + (size_t)row * 1024 + u.pn * BM + bj * HALF + cw) = pack8(acc[ai][bj][m][0] * rs, acc[ai][bj][m][1] * rs); }
    }
    __device__ __forceinline__ void fused(f32x4 (&)[2][2][4][2], const Unit&, int, int, int, int, PG8_LAS unsigned char*, int, int) const {}
};
struct EpiF32 {
    static constexpr bool PERM = false, AFTER_DRAIN = false;
    float* C; int ldc;
    __device__ __forceinline__ void operator()(const f32x4 (&acc)[2][2][4][2], const Unit& u, int wr, int wc, int fr, int fq) const {
        const int row0 = u.pm * BM + wr * 64 + fr, col0 = u.pn * BM + wc * 32 + 4 * fq;
#pragma unroll
        for (int ai = 0; ai < 2; ++ai)
#pragma unroll
            for (int m = 0; m < 4; ++m) { float* rowp = C + (size_t)(row0 + ai * HALF + m * 16) * ldc + col0;
#pragma unroll
                for (int bj = 0; bj < 2; ++bj)
#pragma unroll
                    for (int n = 0; n < 2; ++n) *(f32x4*)(rowp + bj * HALF + n * 16) = acc[ai][bj][m][n]; }
    }
    __device__ __forceinline__ void fused(f32x4 (&)[2][2][4][2], const Unit&, int, int, int, int, PG8_LAS unsigned char*, int, int) const {}
};
template <class Epi, class Sched, bool ALIGN_EPI = false, bool SP2 = false>
__device__ __forceinline__ void gemm_phase(PG8_LAS unsigned char* lds, const Gemm g, const Sched& S, const Epi& E) {
    const int tid = threadIdx.x, wid = __builtin_amdgcn_readfirstlane(tid >> 6), lane = tid & 63, wr = wid >> 2, wc = wid & 3, fr = lane & 15, fq = lane >> 4;
    const int K = g.K, nt = K / BK;
    unsigned voffA[2], voffB[2];
#pragma unroll
    for (int i = 0; i < 2; ++i) { int R, C; stage_rc(tid * 16 + i * 8192, R, C); const int Rb = Epi::PERM ? ((R & ~31) + perm32(R & 31)) : R;
        voffA[i] = (unsigned)(R * K + C) * 2u; voffB[i] = (unsigned)(Rb * K + C) * 2u; }
    const size_t kstep = (size_t)(BK * 2);
    const size_t hstep = (size_t)HALF * K * 2;
    const size_t tstep = 2 * hstep;
    const unsigned ldsw = (unsigned)wid * 1024u;
    const int aoff = lds_byte(wr * 64 + fr, fq * 8), boff = lds_byte(wc * 32 + fr, fq * 8);
#define PG8_SA(b, h) (((b) * 2 + (h)) * HTB)
#define PG8_SB(b, h) ((4 + (b) * 2 + (h)) * HTB)
#define PG8_STAGE(bufoff, gbase, voff) do { _Pragma("unroll") for (int _i = 0; _i < 2; ++_i) \
        __builtin_amdgcn_global_load_lds((const unsigned*)((const char*)(gbase) + (voff)[_i]), (PG8_LAS unsigned*)(lds + (bufoff) + ldsw + _i * 8192), 16, 0, 0); } while (0)
#define PG8_LDA(dst, b, h) do { _Pragma("unroll") for (int m = 0; m < 4; ++m) _Pragma("unroll") for (int k = 0; k < 2; ++k) dst[m][k] = *(const PG8_LAS bf16x8*)(lds + PG8_SA(b, h) + aoff + m * 2048 + k * 1024); } while (0)
#define PG8_LDB(dst, b, h) do { _Pragma("unroll") for (int n = 0; n < 2; ++n) _Pragma("unroll") for (int k = 0; k < 2; ++k) dst[n][k] = *(const PG8_LAS bf16x8*)(lds + PG8_SB(b, h) + boff + n * 2048 + k * 1024); } while (0)
#define PG8_MMA(ai, bj, At, Bt) do { __builtin_amdgcn_s_setprio(1); _Pragma("unroll") for (int m = 0; m < 4; ++m) _Pragma("unroll") for (int n = 0; n < 2; ++n) _Pragma("unroll") for (int k = 0; k < 2; ++k) \
        acc[ai][bj][m][n] = __builtin_amdgcn_mfma_f32_16x16x32_bf16(Bt[n][k], At[m][k], acc[ai][bj][m][n], 0, 0, 0); __builtin_amdgcn_s_setprio(0); } while (0)
#define PG8_WAIT_V(n) asm volatile("s_waitcnt vmcnt(" #n ")" ::: "memory")
#define PG8_WAIT_L(n) asm volatile("s_waitcnt lgkmcnt(" #n ")" ::: "memory")
#define PG8_BAR __builtin_amdgcn_s_barrier()
#define PG8_SCHED __builtin_amdgcn_sched_barrier(0)
    Unit cur, nxt; int ui = 0;
    if (!S.next(0, cur)) return;
    f32x4 acc[2][2][4][2];
#pragma unroll
    for (int a = 0; a < 2; ++a)
#pragma unroll
        for (int b = 0; b < 2; ++b)
#pragma unroll
            for (int m = 0; m < 4; ++m)
#pragma unroll
                for (int n = 0; n < 2; ++n) acc[a][b][m][n] = (f32x4){0.f, 0.f, 0.f, 0.f};
    bf16x8 At[4][2], B0[2][2], B1[2][2];
    const char* cA = (const char*)g.A + (size_t)cur.pm * tstep; const char* cB = (const char*)g.Bt + (size_t)cur.pn * tstep;
    S.a_ready(cur);
    if constexpr (SP2) {
        PG8_STAGE(PG8_SB(0, 0), cB, voffB); PG8_STAGE(PG8_SB(0, 1), cB + hstep, voffB); PG8_STAGE(PG8_SA(0, 0), cA, voffA); PG8_STAGE(PG8_SA(0, 1), cA + hstep, voffA);
        if (wr == 1) PG8_BAR;
        PG8_WAIT_V(2); PG8_BAR;
        PG8_STAGE(PG8_SB(1, 0), cB + kstep, voffB); PG8_STAGE(PG8_SA(1, 0), cA + kstep, voffA); PG8_STAGE(PG8_SB(1, 1), cB + hstep + kstep, voffB);
        PG8_WAIT_V(6); PG8_BAR;
    } else {
        PG8_STAGE(PG8_SB(0, 0), cB, voffB); PG8_STAGE(PG8_SA(0, 0), cA, voffA); PG8_STAGE(PG8_SB(0, 1), cB + hstep, voffB); PG8_STAGE(PG8_SA(0, 1), cA + hstep, voffA);
        if (wr == 1) PG8_BAR;
        PG8_WAIT_V(4); PG8_BAR;
        PG8_STAGE(PG8_SB(1, 0), cB + kstep, voffB); PG8_STAGE(PG8_SA(1, 0), cA + kstep, voffA); PG8_STAGE(PG8_SB(1, 1), cB + hstep + kstep, voffB);
        PG8_WAIT_V(6); PG8_BAR;
    }
    for (;;) {
        const bool has_next = S.next(ui + 1, nxt);
        const char* nA = has_next ? (const char*)g.A + (size_t)nxt.pm * tstep : cA; const char* nB = has_next ? (const char*)g.Bt + (size_t)nxt.pn * tstep : cB;
        for (int t = 0; t < nt; t += 2) {
            const bool last = (t == nt - 2);
            const char* a1 = cA + (size_t)(t + 1) * kstep;
            const char* a2 = last ? nA : cA + (size_t)(t + 2) * kstep; const char* b2 = last ? nB : cB + (size_t)(t + 2) * kstep;
            const char* a3 = a2 + kstep; const char* b3 = b2 + kstep;
            if (last && has_next) S.a_ready(nxt);
            if constexpr (SP2) {
            PG8_LDB(B0, 0, 0); PG8_LDB(B1, 0, 1); PG8_SCHED; PG8_LDA(At, 0, 0); PG8_STAGE(PG8_SA(1, 1), a1 + hstep, voffA);
            PG8_WAIT_V(8); PG8_WAIT_L(0); PG8_BAR; PG8_MMA(0, 0, At, B0); PG8_MMA(0, 1, At, B1); PG8_BAR; PG8_SCHED;
            PG8_LDA(At, 0, 1); PG8_STAGE(PG8_SB(0, 0), b2, voffB); PG8_STAGE(PG8_SB(0, 1), b2 + hstep, voffB); PG8_STAGE(PG8_SA(0, 0), a2, voffA);
            PG8_WAIT_V(8); PG8_WAIT_L(0); PG8_BAR; PG8_MMA(1, 0, At, B0); PG8_MMA(1, 1, At, B1); PG8_BAR; PG8_SCHED;
            PG8_LDB(B0, 1, 0); PG8_LDB(B1, 1, 1); PG8_SCHED; PG8_LDA(At, 1, 0); PG8_STAGE(PG8_SA(0, 1), a2 + hstep, voffA);
            PG8_WAIT_V(8); PG8_WAIT_L(0); PG8_BAR; PG8_MMA(0, 0, At, B0); PG8_MMA(0, 1, At, B1); PG8_BAR; PG8_SCHED;
            PG8_LDA(At, 1, 1); PG8_STAGE(PG8_SB(1, 0), b3, voffB); PG8_STAGE(PG8_SB(1, 1), b3 + hstep, voffB); PG8_STAGE(PG8_SA(1, 0), a3, voffA);
            PG8_WAIT_V(8); PG8_WAIT_L(0); PG8_BAR; PG8_MMA(1, 0, At, B0); PG8_MMA(1, 1, At, B1); PG8_BAR; PG8_SCHED;
            } else {
            PG8_LDB(B0, 0, 0); PG8_SCHED; PG8_LDA(At, 0, 0); PG8_STAGE(PG8_SA(1, 1), a1 + hstep, voffA);
            PG8_WAIT_L(8); PG8_BAR; PG8_WAIT_L(0); PG8_MMA(0, 0, At, B0); PG8_BAR; PG8_SCHED;
            PG8_LDB(B1, 0, 1); PG8_STAGE(PG8_SB(0, 0), b2, voffB);
            PG8_BAR; PG8_WAIT_L(0); PG8_MMA(0, 1, At, B1); PG8_BAR;
            PG8_LDA(At, 0, 1); PG8_STAGE(PG8_SA(0, 0), a2, voffA);
            PG8_BAR; PG8_WAIT_L(0); PG8_MMA(1, 0, At, B0); PG8_BAR; PG8_SCHED;
            PG8_STAGE(PG8_SB(0, 1), b2 + hstep, voffB);
            PG8_WAIT_V(6); PG8_BAR; PG8_MMA(1, 1, At, B1); PG8_BAR;
            PG8_LDB(B0, 1, 0); PG8_SCHED; PG8_LDA(At, 1, 0); PG8_STAGE(PG8_SA(0, 1), a2 + hstep, voffA);
            PG8_WAIT_L(8); PG8_BAR; PG8_WAIT_L(0); PG8_MMA(0, 0, At, B0); PG8_BAR; PG8_SCHED;
            PG8_LDB(B1, 1, 1); PG8_STAGE(PG8_SB(1, 0), b3, voffB);
            PG8_BAR; PG8_WAIT_L(0); PG8_MMA(0, 1, At, B1); PG8_BAR;
            PG8_LDA(At, 1, 1); PG8_STAGE(PG8_SA(1, 0), a3, voffA);
            PG8_BAR; PG8_WAIT_L(0); PG8_MMA(1, 0, At, B0); PG8_BAR; PG8_SCHED;
            PG8_STAGE(PG8_SB(1, 1), b3 + hstep, voffB);
            PG8_WAIT_V(6); PG8_BAR; PG8_MMA(1, 1, At, B1); PG8_BAR;
            }
        }
        if constexpr (ALIGN_EPI) { if (wr == 0) PG8_BAR; }
        if constexpr (!Epi::AFTER_DRAIN) { E(acc, cur, wr, wc, fr, fq); S.done(cur); }
        if (!has_next) break;
#pragma unroll
        for (int a = 0; a < 2; ++a)
#pragma unroll
            for (int b = 0; b < 2; ++b)
#pragma unroll
                for (int m = 0; m < 4; ++m)
#pragma unroll
                    for (int n = 0; n < 2; ++n) acc[a][b][m][n] = (f32x4){0.f, 0.f, 0.f, 0.f};
        cur = nxt; cA = nA; cB = nB; ++ui;
        if constexpr (ALIGN_EPI) { if (wr == 1) PG8_BAR; }
    }
    PG8_WAIT_V(0);
    if constexpr (!ALIGN_EPI) { if (wr == 0) PG8_BAR; }
    PG8_BAR;
    if constexpr (Epi::AFTER_DRAIN) { E.fused(acc, cur, wr, wc, fr, fq, lds, wid, lane); S.done(cur); }
#undef PG8_SA
#undef PG8_SB
#undef PG8_STAGE
#undef PG8_LDA
#undef PG8_LDB
#undef PG8_MMA
#undef PG8_WAIT_V
#undef PG8_WAIT_L
#undef PG8_BAR
#undef PG8_SCHED
}
}
typedef unsigned short bf16;
typedef float f32x4v __attribute__((ext_vector_type(4)));
#define LAS __attribute__((address_space(3)))

struct GemmArgs { const bf16* A; const bf16* Bt; float* C; int M, N, K, ldc; };
__global__ void __launch_bounds__(512, 2) k_gemm_f32(GemmArgs a) {
    extern __shared__ __attribute__((aligned(16))) unsigned char lds[];
    pg8::Gemm g{a.A, a.Bt, a.M, a.N, a.K}; pg8::StaticOrder S; S.init(a.M, a.N, (int)gridDim.x, (int)blockIdx.x);
    pg8::EpiF32 E{a.C, a.ldc};
    pg8::gemm_phase<pg8::EpiF32, pg8::StaticOrder, true, true>((LAS unsigned char*)lds, g, S, E);
}
struct InProjArgs { const bf16* A; const bf16* Bt; pg8::EpiInProj E; };
__global__ void __launch_bounds__(512, 2) k_gemm_inproj(InProjArgs a) {
    extern __shared__ __attribute__((aligned(16))) unsigned char lds[];
    pg8::Gemm g{a.A, a.Bt, MT, NINP, D}; pg8::StaticOrder S; S.init(MT, NINP, (int)gridDim.x, (int)blockIdx.x);
    pg8::gemm_phase<pg8::EpiInProj, pg8::StaticOrder, true, true>((LAS unsigned char*)lds, g, S, a.E);
}
struct QArgs { const bf16* A; const bf16* Bt; pg8::EpiQ E; };
__global__ void __launch_bounds__(512, 2) k_gemm_q(QArgs a) {
    extern __shared__ __attribute__((aligned(16))) unsigned char lds[];
    pg8::Gemm g{a.A, a.Bt, MT, MH * QHD, QL}; pg8::StaticOrder S; S.init(MT, MH * QHD, (int)gridDim.x, (int)blockIdx.x);
    pg8::gemm_phase<pg8::EpiQ, pg8::StaticOrder, true, true>((LAS unsigned char*)lds, g, S, a.E);
}
struct KVArgs { const bf16* A; const bf16* Bt; pg8::EpiKV E; };
__global__ void __launch_bounds__(512, 2) k_gemm_kv(KVArgs a) {
    extern __shared__ __attribute__((aligned(16))) unsigned char lds[];
    pg8::Gemm g{a.A, a.Bt, MP, 1024, KVL}; pg8::StaticOrder S; S.init(MP, 1024, (int)gridDim.x, (int)blockIdx.x);
    pg8::gemm_phase<pg8::EpiKV, pg8::StaticOrder, true, true>((LAS unsigned char*)lds, g, S, a.E);
}

__global__ void __launch_bounds__(256) k_mod(const float* __restrict__ c_p, const float* __restrict__ c_s, const float* __restrict__ w_ada, const float* __restrict__ b_ada, float* __restrict__ mod) {
    const int n = blockIdx.x * 256 + threadIdx.x, r0 = blockIdx.y * 13;
    float acc[13];
#pragma unroll
    for (int i = 0; i < 13; ++i) acc[i] = 0.f;
    for (int k = 0; k < D; ++k) {
        const float w = w_ada[(size_t)k * 3072 + n];
#pragma unroll
        for (int i = 0; i < 13; ++i) { const int r = r0 + i; const float cv = r < 2 ? c_p[r * D + k] : c_s[(r - 2) * D + k]; acc[i] += cv * w; }
    }
    const float bb = b_ada[n];
#pragma unroll
    for (int i = 0; i < 13; ++i) mod[(size_t)(r0 + i) * 3072 + n] = acc[i] + bb;
}
__global__ void __launch_bounds__(256) k_wt(const float* __restrict__ W, int ldw, int K, bf16* __restrict__ WT, int mode, const float* __restrict__ gain) {
    __shared__ float tile[32][33];
    const int k0 = blockIdx.x * 32, n0 = blockIdx.y * 32, tx = threadIdx.x, ty = threadIdx.y;
    const int n = n0 + tx, src = mode ? zsrc(n) : n;
    const float cs = (mode && n >= ZK && n < ZV) ? KSCALE : 1.f;
    for (int i = ty; i < 32; i += 8) tile[i][tx] = src >= 0 ? W[(size_t)(k0 + i) * ldw + src] * cs * (gain ? gain[k0 + i] : 1.f) : 0.f;
    __syncthreads();
    for (int i = ty; i < 32; i += 8) WT[(size_t)(n0 + i) * K + k0 + tx] = f2bf(tile[tx][i]);
}
__global__ void __launch_bounds__(256) k_ropetab(float* __restrict__ T) {
    const int i = blockIdx.x * 256 + threadIdx.x; if (i >= (PAST + DS) * 16) return;
    const int pos = i >> 4, j = i & 15; const float inv = powf(10000.f, -(float)j / 16.f), ang = (float)pos * inv; float sn, cs; sincosf(ang, &sn, &cs);
    T[pos * 32 + j] = cs; T[pos * 32 + 16 + j] = sn;
}
__global__ void __launch_bounds__(256) k_hprep(const float* __restrict__ xp, const float* __restrict__ xs, const float* __restrict__ mod, bf16* __restrict__ H) {
    const size_t i4 = (size_t)blockIdx.x * 256 + threadIdx.x;
    const int m = (int)(i4 >> 8), c = (int)(i4 & 255) * 4;
    const float* x = m < MP ? xp + (size_t)m * D : xs + (size_t)(m - MP) * D;
    const float* mr = mod + (size_t)row_modrow(m) * 3072;
    const f32x4v xv = *(const f32x4v*)(x + c), sh = *(const f32x4v*)(mr + c), sc = *(const f32x4v*)(mr + 1024 + c);
    ushort4 o; o.x = f2bf(xv.x * (1.f + sc.x) + sh.x); o.y = f2bf(xv.y * (1.f + sc.y) + sh.y); o.z = f2bf(xv.z * (1.f + sc.z) + sh.z); o.w = f2bf(xv.w * (1.f + sc.w) + sh.w);
    *(ushort4*)(H + (size_t)m * D + c) = o;
}

__global__ void __launch_bounds__(256) k_rows_ckv(const bf16* __restrict__ CKVR, const float* __restrict__ SSKV, const float* __restrict__ kvnorm, float* __restrict__ out) {
    const int lane = threadIdx.x & 63, m = blockIdx.x * 4 + (threadIdx.x >> 6);
    const float4 p = *(const float4*)(SSKV + (size_t)m * 4);
    const float r = rsqrtf(((p.x + p.y) + (p.z + p.w)) * (1.f / KVL) + EPS);
    const ushort4 v = *(const ushort4*)(CKVR + (size_t)m * KVL + 4 * lane); const float4 g = *(const float4*)(kvnorm + 4 * lane);
    float* o = m < MP ? out + O_CKVP + (size_t)m * KVL : out + O_CKVS + (size_t)(m - MP) * KVL;
    *(float4*)(o + 4 * lane) = make_float4(bf2f(v.x) * r * g.x, bf2f(v.y) * r * g.y, bf2f(v.z) * r * g.z, bf2f(v.w) * r * g.w);
}
__global__ void __launch_bounds__(256) k_qlat(const bf16* __restrict__ Q96, const float* __restrict__ w_uk, float* __restrict__ QLAT) {
    __shared__ float qs[MH * NOPE];
    const int ms = blockIdx.x, c = threadIdx.x;
    for (int e = threadIdx.x; e < MH * NOPE; e += 256) qs[e] = bf2f(Q96[(size_t)(MP + ms) * (MH * QHD) + (e >> 6) * QHD + (e & 63)]);
    __syncthreads();
    for (int h = 0; h < MH; ++h) { float acc = 0.f;
        for (int n = 0; n < NOPE; ++n) acc += qs[h * NOPE + n] * w_uk[(size_t)c * (MH * NOPE) + h * NOPE + n];
        QLAT[((size_t)ms * MH + h) * KVL + c] = acc; }
}

__global__ void __launch_bounds__(256) k_attn_prompt_naive(const bf16* __restrict__ Q96, const bf16* __restrict__ KVB, const bf16* __restrict__ KRB, const float* __restrict__ ropet, float* __restrict__ OMLA) {
    const int qb = (int)gridDim.x - 1 - (int)blockIdx.x, b = blockIdx.y / MH, h = blockIdx.y % MH;
    const int t = qb * 256 + threadIdx.x, m = b * SP + t;
    float q[QHD], acc[VD];
#pragma unroll
    for (int j = 0; j < QHD; ++j) q[j] = bf2f(Q96[(size_t)m * (MH * QHD) + h * QHD + j]);
#pragma unroll
    for (int j = 0; j < VD; ++j) acc[j] = 0.f;
#pragma unroll
    for (int j = 0; j < 16; ++j) { const float cs = ropet[t * 32 + j], sn = ropet[t * 32 + 16 + j], x1 = q[NOPE + j], x2 = q[NOPE + 16 + j]; q[NOPE + j] = x1 * cs - x2 * sn; q[NOPE + 16 + j] = x2 * cs + x1 * sn; }
    float mx = -INFINITY, l = 0.f;
    const int jend = qb * 256 + 256;
    for (int j = 0; j < jend; ++j) {
        const bf16* kn = KVB + (size_t)(b * SP + j) * 1024 + h * NOPE; const bf16* kr = KRB + (size_t)(b * SP + j) * ROPE; const bf16* vv = KVB + (size_t)(b * SP + j) * 1024 + 512 + h * VD;
        float s = 0.f;
#pragma unroll
        for (int d = 0; d < NOPE; ++d) s += q[d] * bf2f(kn[d]);
#pragma unroll
        for (int d = 0; d < ROPE; ++d) s += q[NOPE + d] * bf2f(kr[d]);
        if (j <= t) {
            const float mn = fmaxf(mx, s), al = exp2f(mx - mn), p = exp2f(s - mn);
            l = l * al + p; mx = mn;
#pragma unroll
            for (int d = 0; d < VD; ++d) acc[d] = acc[d] * al + p * bf2f(vv[d]);
        }
    }
    const float il = 1.f / l;
#pragma unroll
    for (int d = 0; d < VD; ++d) OMLA[(size_t)m * 512 + h * VD + d] = acc[d] * il;
}

__global__ void __launch_bounds__(256) k_attn_sample_naive(const float* __restrict__ QLAT, const bf16* __restrict__ Q96, const float* __restrict__ cache_ckv, const float* __restrict__ cache_kr,
                                                           const int* __restrict__ page_table, const float* __restrict__ ckv_new  , const bf16* __restrict__ KRB, const float* __restrict__ ropet, float* __restrict__ OLAT) {
    __shared__ float s_m[4][DS], s_l[4][DS], s_acc[4][DS][KVL];
    const int b = blockIdx.x / MH, h = blockIdx.x % MH, lane = threadIdx.x & 63, w = threadIdx.x >> 6;
    float ql[DS][4], qr[DS], acc[DS][4], mx[DS], l[DS];
#pragma unroll
    for (int i = 0; i < DS; ++i) {
#pragma unroll
        for (int j = 0; j < 4; ++j) { ql[i][j] = QLAT[((size_t)(b * DS + i) * MH + h) * KVL + lane + 64 * j]; acc[i][j] = 0.f; }
        { const float x = lane < ROPE ? bf2f(Q96[(size_t)(MP + b * DS + i) * (MH * QHD) + h * QHD + NOPE + lane]) : 0.f, o = __shfl_xor(x, 16);
          const float cs = ropet[(PAST + i) * 32 + (lane & 15)], sn = ropet[(PAST + i) * 32 + 16 + (lane & 15)];
          qr[i] = lane < 16 ? x * cs - o * sn : (lane < 32 ? x * cs + o * sn : 0.f); }
        mx[i] = -INFINITY; l[i] = 0.f;
    }
    for (int key = w; key < PAST + DS; key += 4) {
        const float* kc; const float* kr = nullptr; const bf16* krn = nullptr;
        if (key < PAST) { const int pg = page_table[b * NPAGES + (key >> 7)]; kc = cache_ckv + ((size_t)pg * PAGE + (key & 127)) * KVL; kr = cache_kr + ((size_t)pg * PAGE + (key & 127)) * ROPE; }
        else { kc = ckv_new + (size_t)(b * DS + key - PAST) * KVL; krn = KRB + (size_t)(MP + b * DS + key - PAST) * ROPE; }
        float kv[4];
#pragma unroll
        for (int j = 0; j < 4; ++j) kv[j] = kc[lane + 64 * j];
        const float krv = lane < ROPE ? (kr ? kr[lane] : bf2f(krn[lane])) : 0.f;
#pragma unroll
        for (int i = 0; i < DS; ++i) {
            float s = ql[i][0] * kv[0] + ql[i][1] * kv[1] + ql[i][2] * kv[2] + ql[i][3] * kv[3] + qr[i] * krv;
            s = wave_sum(s);
            if (key < PAST + i + 1) {
                const float mn = fmaxf(mx[i], s), al = exp2f(mx[i] - mn), p = exp2f(s - mn);
                l[i] = l[i] * al + p; mx[i] = mn;
#pragma unroll
                for (int j = 0; j < 4; ++j) acc[i][j] = acc[i][j] * al + p * kv[j];
            }
        }
    }
#pragma unroll
    for (int i = 0; i < DS; ++i) { if (lane == 0) { s_m[w][i] = mx[i]; s_l[w][i] = l[i]; }
#pragma unroll
        for (int j = 0; j < 4; ++j) s_acc[w][i][lane + 64 * j] = acc[i][j]; }
    __syncthreads();
    for (int e = threadIdx.x; e < DS * KVL; e += 256) { const int i = e >> 8, c = e & 255;
        const float mm = fmaxf(fmaxf(s_m[0][i], s_m[1][i]), fmaxf(s_m[2][i], s_m[3][i]));
        float num = 0.f, den = 0.f;
#pragma unroll
        for (int ww = 0; ww < 4; ++ww) { const float f = exp2f(s_m[ww][i] - mm); num += f * s_acc[ww][i][c]; den += f * s_l[ww][i]; }
        OLAT[((size_t)(b * DS + i) * MH + h) * KVL + c] = num / den; }
}
__global__ void __launch_bounds__(512) k_olat_uv(const float* __restrict__ OLAT, const float* __restrict__ w_uv, float* __restrict__ OMLA) {
    __shared__ float os[MH * KVL];
    const int ms = blockIdx.x, tid = threadIdx.x, h = tid >> 6;
    for (int e = tid; e < MH * KVL; e += 512) os[e] = OLAT[(size_t)ms * MH * KVL + e];
    __syncthreads();
    float acc = 0.f;
    for (int c = 0; c < KVL; ++c) acc += os[h * KVL + c] * w_uv[(size_t)c * 512 + tid];
    OMLA[(size_t)(MP + ms) * 512 + tid] = acc;
}

__global__ void __launch_bounds__(256) k_ml_a(const bf16* __restrict__ ZB, const float* __restrict__ GATES, const float* __restrict__ b_i, const float* __restrict__ b_f, float* __restrict__ G, float* __restrict__ U, float* __restrict__ DC, float* __restrict__ DN) {
    __shared__ float s_w[LC], s_F[LC], s_ig[LC], s_red[2];
    const int bh = blockIdx.x / NCH, c = blockIdx.x % NCH, b = bh / LH, h = bh % LH, tid = threadIdx.x;
    const size_t row0 = (size_t)b * SP + (size_t)c * LC;
    if (tid < LC) { const float* z = GATES + (row0 + tid) * 8; s_ig[tid] = z[h] + b_i[h]; s_F[tid] = logsigmoidf_(z[4 + h] + b_f[h]); }
    __syncthreads();
    if (tid == 0) { float f = 0.f; for (int s = 0; s < LC; ++s) { f += s_F[s]; s_F[s] = f; } const float g = f; float u = -INFINITY;
        for (int s = 0; s < LC; ++s) u = fmaxf(u, g - s_F[s] + s_ig[s]); s_red[0] = g; s_red[1] = u; }
    __syncthreads();
    const float g = s_red[0], u = s_red[1];
    if (tid < LC) s_w[tid] = __expf(g - s_F[tid] + s_ig[tid] - u);
    __syncthreads();
    const int dk = tid >> 1, dv0 = (tid & 1) * 64;
    float acc[64]; float an = 0.f;
#pragma unroll
    for (int j = 0; j < 64; ++j) acc[j] = 0.f;
    for (int s = 0; s < LC; ++s) { const bf16* z = ZB + (row0 + s) * 3072; const float kw = bf2f(z[ZK + h * DK + dk]) * s_w[s]; an += kw;
#pragma unroll
        for (int j = 0; j < 64; ++j) acc[j] += kw * bf2f(z[ZV + h * DV + dv0 + j]); }
    float* dc = DC + ((size_t)blockIdx.x * DK + dk) * DV + dv0;
#pragma unroll
    for (int j = 0; j < 64; ++j) dc[j] = acc[j];
    if ((tid & 1) == 0) DN[(size_t)blockIdx.x * DK + dk] = an;
    if (tid == 0) { G[blockIdx.x] = g; U[blockIdx.x] = u; }
}
__global__ void __launch_bounds__(256) k_ml_b(const float* __restrict__ G, const float* __restrict__ U, const float* __restrict__ DC, const float* __restrict__ DN,
                                              float* __restrict__ CS, float* __restrict__ NS, float* __restrict__ MSs, float* __restrict__ out) {
    const int gid = blockIdx.x * 256 + threadIdx.x, bh = gid / (DK * DV + DK), e = gid % (DK * DV + DK);
    float m = -INFINITY, x = 0.f;
    for (int c = 0; c < NCH; ++c) {
        const int ci = bh * NCH + c;
        if (e < DK * DV) CS[(size_t)ci * DK * DV + e] = x; else NS[(size_t)ci * DK + (e - DK * DV)] = x;
        if (e == 0) MSs[ci] = m;
        const float g = G[ci], u = U[ci], mn = fmaxf(g + m, u), al = __expf(g + m - mn), be = __expf(u - mn);
        const float d = e < DK * DV ? DC[(size_t)ci * DK * DV + e] : DN[(size_t)ci * DK + (e - DK * DV)];
        x = al * x + be * d; m = mn;
    }
    if (e < DK * DV) out[O_CP + (size_t)bh * DK * DV + e] = x; else out[O_NP + (size_t)bh * DK + (e - DK * DV)] = x;
    if (e == 0) out[O_MPR + bh] = m;
}
__global__ void __launch_bounds__(256) k_ml_c(const bf16* __restrict__ ZB, const float* __restrict__ GATES, const float* __restrict__ b_i, const float* __restrict__ b_f, const float* __restrict__ CS, const float* __restrict__ NS, const float* __restrict__ MSs, float* __restrict__ HML) {
    __shared__ float s_F[LC], s_ig[LC];
    const int bh = blockIdx.x / NCH, c = blockIdx.x % NCH, b = bh / LH, h = bh % LH, tid = threadIdx.x;
    const size_t row0 = (size_t)b * SP + (size_t)c * LC;
    if (tid < LC) { const float* z = GATES + (row0 + tid) * 8; s_ig[tid] = z[h] + b_i[h]; s_F[tid] = logsigmoidf_(z[4 + h] + b_f[h]); }
    __syncthreads();
    if (tid == 0) { float f = 0.f; for (int s = 0; s < LC; ++s) { f += s_F[s]; s_F[s] = f; } }
    __syncthreads();
    const int t = tid >> 1, dv0 = (tid & 1) * 64;
    const float mprev = MSs[blockIdx.x], Ft = s_F[t];
    float mt = Ft + mprev;
    for (int s = 0; s <= t; ++s) mt = fmaxf(mt, Ft - s_F[s] + s_ig[s]);
    const float a = __expf(Ft + mprev - mt);
    const bf16* zq = ZB + (row0 + t) * 3072 + ZQ + h * DK;
    float acc[64]; float den = 0.f;
#pragma unroll
    for (int j = 0; j < 64; ++j) acc[j] = 0.f;
    for (int s = 0; s <= t; ++s) {
        const bf16* z = ZB + (row0 + s) * 3072; float dot = 0.f;
        for (int d = 0; d < DK; ++d) dot += bf2f(zq[d]) * bf2f(z[ZK + h * DK + d]);
        const float sq = dot * __expf(Ft - s_F[s] + s_ig[s] - mt); den += sq;
#pragma unroll
        for (int j = 0; j < 64; ++j) acc[j] += sq * bf2f(z[ZV + h * DV + dv0 + j]);
    }
    const float* cs = CS + (size_t)blockIdx.x * DK * DV; const float* ns = NS + (size_t)blockIdx.x * DK;
    float qn = 0.f;
    for (int d = 0; d < DK; ++d) { const float qa = bf2f(zq[d]) * a; qn += qa * ns[d];
#pragma unroll
        for (int j = 0; j < 64; ++j) acc[j] += qa * cs[(size_t)d * DV + dv0 + j]; }
    den += qn;
    const float inv = 1.f / fmaxf(fabsf(den), __expf(-mt));
    float* o = HML + (row0 + t) * 512 + h * DV + dv0;
#pragma unroll
    for (int j = 0; j < 64; ++j) o[j] = acc[j] * inv;
}
__global__ void __launch_bounds__(256) k_ml_sample(const bf16* __restrict__ ZB, const float* __restrict__ GATES, const float* __restrict__ b_i, const float* __restrict__ b_f, const float* __restrict__ C0, const float* __restrict__ n0, const float* __restrict__ m0,
                                                   float* __restrict__ HML, float* __restrict__ out) {
    __shared__ float s_q[DS][DK], s_k[DS][DK], s_v[DS][DV], s_F[DS], s_ig[DS], s_mt[DS], s_a[DS], s_S[DS][DS], s_den[DS], s_qc[2][DS][DV], s_wl[DS];
    const int b = blockIdx.x / LH, h = blockIdx.x % LH, tid = threadIdx.x;
    const size_t row0 = (size_t)MP + (size_t)b * DS;
    for (int e = tid; e < DS * DK; e += 256) { const int t = e >> 7, d = e & 127; const bf16* z = ZB + (row0 + t) * 3072;
        s_q[t][d] = bf2f(z[ZQ + h * DK + d]); s_k[t][d] = bf2f(z[ZK + h * DK + d]); s_v[t][d] = bf2f(z[ZV + h * DV + d]); }
    if (tid < DS) { const float* z = GATES + (row0 + tid) * 8; s_ig[tid] = z[h] + b_i[h]; s_F[tid] = logsigmoidf_(z[4 + h] + b_f[h]); }
    __syncthreads();
    const float mprev = m0[b * LH + h];
    if (tid == 0) { float f = 0.f; for (int s = 0; s < DS; ++s) { f += s_F[s]; s_F[s] = f; }
        for (int t = 0; t < DS; ++t) { float mt = s_F[t] + mprev; for (int s = 0; s <= t; ++s) mt = fmaxf(mt, s_F[t] - s_F[s] + s_ig[s]); s_mt[t] = mt; s_a[t] = __expf(s_F[t] + mprev - mt); }
        for (int s = 0; s < DS; ++s) s_wl[s] = __expf(s_F[DS - 1] - s_F[s] + s_ig[s] - s_mt[DS - 1]); }
    __syncthreads();
    if (tid < DS * DS) { const int t = tid >> 3, s = tid & 7; float v = 0.f;
        if (s <= t) { float dot = 0.f; for (int d = 0; d < DK; ++d) dot += s_q[t][d] * s_k[s][d]; v = dot * __expf(s_F[t] - s_F[s] + s_ig[s] - s_mt[t]); }
        s_S[t][s] = v; }
    __syncthreads();
    const int dv = tid & 127, hf = tid >> 7;
    const float* c0 = C0 + (size_t)blockIdx.x * DK * DV; float* cn = out + O_CS + (size_t)blockIdx.x * DK * DV;
    const float al = s_a[DS - 1];
    float qc[DS];
#pragma unroll
    for (int t = 0; t < DS; ++t) qc[t] = 0.f;
    for (int d = hf * 64; d < hf * 64 + 64; ++d) {
        const float cv = c0[(size_t)d * DV + dv]; float nv = al * cv;
#pragma unroll
        for (int t = 0; t < DS; ++t) { qc[t] += s_q[t][d] * cv; nv += s_wl[t] * s_k[t][d] * s_v[t][dv]; }
        cn[(size_t)d * DV + dv] = nv;
    }
#pragma unroll
    for (int t = 0; t < DS; ++t) s_qc[hf][t][dv] = qc[t];
    if (tid < DS) { const int t = tid; float dn = 0.f; for (int s = 0; s <= t; ++s) dn += s_S[t][s]; float qn = 0.f; const float* nn = n0 + (size_t)blockIdx.x * DK;
        for (int d = 0; d < DK; ++d) qn += s_q[t][d] * nn[d]; s_den[t] = dn + s_a[t] * qn; }
    if (tid >= 128 && tid < 128 + DK) { const int d = tid - 128; float nv = al * n0[(size_t)blockIdx.x * DK + d];
        for (int s = 0; s < DS; ++s) nv += s_wl[s] * s_k[s][d]; out[O_NS + (size_t)blockIdx.x * DK + d] = nv; }
    if (tid == 0) out[O_MS + blockIdx.x] = s_mt[DS - 1];
    __syncthreads();
    for (int e = tid; e < DS * DV; e += 256) { const int t = e >> 7, d = e & 127; float num = s_a[t] * (s_qc[0][t][d] + s_qc[1][t][d]);
        for (int s = 0; s <= t; ++s) num += s_S[t][s] * s_v[s][d];
        HML[(row0 + t) * 512 + h * DV + d] = num / fmaxf(fabsf(s_den[t]), __expf(-s_mt[t])); }
}

__global__ void __launch_bounds__(256) k_back_rows(const bf16* __restrict__ ZB, const float* __restrict__ HML, const float* __restrict__ OMLA, const float* __restrict__ gn, bf16* __restrict__ YCAT) {
    const int lane = threadIdx.x & 63, m = blockIdx.x * 4 + (threadIdx.x >> 6);
    const bf16* z = ZB + (size_t)m * 3072;
#pragma unroll
    for (int h = 0; h < LH; ++h) {
        const int c0 = h * DV + lane, c1 = c0 + 64;
        const float a0 = HML[(size_t)m * 512 + c0] * sigmoidf_(bf2f(z[ZO + c0])), a1 = HML[(size_t)m * 512 + c1] * sigmoidf_(bf2f(z[ZO + c1]));
        const float mu = wave_sum(a0 + a1) * (1.f / DV), d0 = a0 - mu, d1 = a1 - mu, var = wave_sum(d0 * d0 + d1 * d1) * (1.f / DV), r = rsqrtf(var + EPS);
        YCAT[(size_t)m * D + c0] = f2bf(d0 * r * gn[c0] * siluf_(bf2f(z[ZZ + c0]))); YCAT[(size_t)m * D + c1] = f2bf(d1 * r * gn[c1] * siluf_(bf2f(z[ZZ + c1])));
    }
#pragma unroll
    for (int i = 0; i < 8; ++i) if (m >= MP) { const int c = lane + 64 * i; YCAT[(size_t)m * D + 512 + c] = f2bf(OMLA[(size_t)m * 512 + c] * siluf_(bf2f(z[ZAZ + c]))); }
}
__global__ void __launch_bounds__(256) k_final_ln(const float* __restrict__ xp, const float* __restrict__ xs, const float* __restrict__ mod, const float* __restrict__ OUT, const float* __restrict__ lg, const float* __restrict__ lb, float* __restrict__ out) {
    const int lane = threadIdx.x & 63, m = blockIdx.x * 4 + (threadIdx.x >> 6);
    const float* x = m < MP ? xp + (size_t)m * D : xs + (size_t)(m - MP) * D;
    const float* gate = mod + (size_t)row_modrow(m) * 3072 + 2048;
    float* y = m < MP ? out + O_YP + (size_t)m * D : out + O_YS + (size_t)(m - MP) * D;
    f32x4v v[4]; float s = 0.f;
#pragma unroll
    for (int j = 0; j < 4; ++j) { const int c = 4 * lane + 256 * j; const f32x4v xv = *(const f32x4v*)(x + c), gv = *(const f32x4v*)(gate + c), ov = *(const f32x4v*)(OUT + (size_t)m * D + c);
        v[j] = xv * ALPHA + gv * ov; s += (v[j].x + v[j].y) + (v[j].z + v[j].w); }
    const float mu = wave_sum(s) * (1.f / D); float s2 = 0.f;
#pragma unroll
    for (int j = 0; j < 4; ++j) { v[j] = v[j] - mu; s2 += (v[j].x * v[j].x + v[j].y * v[j].y) + (v[j].z * v[j].z + v[j].w * v[j].w); }
    const float r = rsqrtf(wave_sum(s2) * (1.f / D) + EPS);
#pragma unroll
    for (int j = 0; j < 4; ++j) { const int c = 4 * lane + 256 * j; const f32x4v g = *(const f32x4v*)(lg + c), bb = *(const f32x4v*)(lb + c); *(f32x4v*)(y + c) = v[j] * r * g + bb; }
}
namespace pa {
typedef short bf16x8 __attribute__((ext_vector_type(8)));
typedef short s16x4 __attribute__((ext_vector_type(4)));
typedef float f32x16 __attribute__((ext_vector_type(16)));
typedef unsigned u32x4 __attribute__((ext_vector_type(4)));
typedef unsigned u32x2 __attribute__((ext_vector_type(2)));
typedef float f32x2_t __attribute__((ext_vector_type(2))); typedef __bf16 bf16x2_t __attribute__((ext_vector_type(2)));
constexpr int KP = 208, VP = 128, KBUF = 64 * KP, VBUF = 64 * VP, L_K = 0, L_V = 2 * KBUF, LDS_BYTES = 2 * KBUF + 2 * VBUF;
__device__ __forceinline__ unsigned cvtpk(float lo, float hi) { f32x2_t v = {lo, hi}; bf16x2_t b = __builtin_convertvector(v, bf16x2_t); return __builtin_bit_cast(unsigned, b); }
__device__ __forceinline__ bf16x8 pack8(const f32x16& p, int s) { u32x4 w; w.x = cvtpk(p[8 * s], p[8 * s + 1]); w.y = cvtpk(p[8 * s + 2], p[8 * s + 3]); w.z = cvtpk(p[8 * s + 4], p[8 * s + 5]); w.w = cvtpk(p[8 * s + 6], p[8 * s + 7]); return __builtin_bit_cast(bf16x8, w); }
__device__ __forceinline__ s16x4 vtr(const LAS unsigned char* p) { return __builtin_bit_cast(s16x4, __builtin_amdgcn_ds_read_tr16_b64_v4i16((LAS s16x4*)p)); }
__device__ __forceinline__ int crow(int r, int hf) { return (r & 3) + 8 * (r >> 2) + 4 * hf; }
#define PA_MFMA(a, b, c) __builtin_amdgcn_mfma_f32_32x32x16_bf16((a), (b), (c), 0, 0, 0)

struct Tensors { const bf16* Q96; const bf16* KVB; const bf16* KRB; const bf16* ZB; const float* ropet; bf16* YCAT; };

__device__ __forceinline__ void unit(LAS unsigned char* lds, const Tensors& T, int b, int h, int qb) {
    const int tid = threadIdx.x, lane = tid & 63, w = __builtin_amdgcn_readfirstlane(tid >> 6), q32 = lane & 31, hf = lane >> 5;
    const int Q0 = qb * 256, NT = (Q0 + 256) / 64;
    const size_t rowb = (size_t)b * SP;
    const int rv = tid >> 3, cv = tid & 7;
    const bf16* gV = T.KVB + (rowb + rv) * 1024 + 512 + h * 64 + cv * 8;
    const bf16* gK = T.KVB + (rowb + rv) * 1024 + h * 64 + cv * 8;
    const bf16* gR = T.KRB + (rowb + (tid >> 2)) * 32 + (tid & 3) * 8;
    const int dV = L_V + rv * VP + ((cv ^ (((rv >> 1) & 1) << 2)) * 16), dK = L_K + rv * KP + cv * 16, dR = L_K + (tid >> 2) * KP + 128 + (tid & 3) * 16;
    u32x4 sV, sK, sR = {0u, 0u, 0u, 0u};
    sV = *(const u32x4*)gV; sK = *(const u32x4*)gK; if (tid < 256) sR = *(const u32x4*)gR;
    const int qg = Q0 + 32 * w + q32;
    const bf16* qrow = T.Q96 + (rowb + qg) * 768 + h * 96 + 8 * hf;
    bf16x8 qf[6];
#pragma unroll
    for (int ks = 0; ks < 6; ++ks) qf[ks] = *(const bf16x8*)(qrow + 16 * ks);
    {   const float* tb = T.ropet + (size_t)qg * 32 + 8 * hf;
        u32x4 y1, y2;
#pragma unroll
        for (int e = 0; e < 8; e += 2) {
            const float c0 = tb[e], c1 = tb[e + 1], s0 = tb[16 + e], s1 = tb[16 + e + 1];
            const float a0 = bf2f((unsigned short)qf[4][e]), a1 = bf2f((unsigned short)qf[4][e + 1]), b0 = bf2f((unsigned short)qf[5][e]), b1 = bf2f((unsigned short)qf[5][e + 1]);
            y1[e >> 1] = cvtpk(a0 * c0 - b0 * s0, a1 * c1 - b1 * s1); y2[e >> 1] = cvtpk(b0 * c0 + a0 * s0, b1 * c1 + a1 * s1);
        }
        qf[4] = __builtin_bit_cast(bf16x8, y1); qf[5] = __builtin_bit_cast(bf16x8, y2); }
    __syncthreads();
    *(LAS u32x4*)(lds + dV) = sV; *(LAS u32x4*)(lds + dK) = sK; if (tid < 256) *(LAS u32x4*)(lds + dR) = sR;
    __syncthreads();
    f32x16 o0, o1;
#pragma unroll
    for (int i = 0; i < 16; ++i) { o0[i] = 0.f; o1[i] = 0.f; }
    float mref = 0.f, l = 0.f;
    const int i16 = lane & 15, q4 = i16 >> 2, p4 = i16 & 3, blk = (lane >> 4) & 1;
    const int vo0 = q4 * VP + (((0 + 2 * blk + (p4 >> 1)) ^ (((q4 >> 1) & 1) << 2)) * 16) + (p4 & 1) * 8 + 4 * hf * VP;
    const int vo1 = q4 * VP + (((4 + 2 * blk + (p4 >> 1)) ^ (((q4 >> 1) & 1) << 2)) * 16) + (p4 & 1) * 8 + 4 * hf * VP;
    for (int t = 0; t < NT; ++t) {
        const int buf = t & 1;
        if (t + 1 < NT) { const size_t adv = (size_t)(t + 1) * 64; sV = *(const u32x4*)(gV + adv * 1024); sK = *(const u32x4*)(gK + adv * 1024); if (tid < 256) sR = *(const u32x4*)(gR + adv * 32); }
        const int kv0 = 64 * t;
        if (kv0 <= Q0 + 32 * w + 31) {
            f32x16 p0, p1;
#pragma unroll
            for (int i = 0; i < 16; ++i) { p0[i] = 0.f; p1[i] = 0.f; }
            const LAS unsigned char* kb = lds + L_K + buf * KBUF + q32 * KP + hf * 16;
#pragma unroll
            for (int ks = 0; ks < 6; ++ks) {
                const bf16x8 a0 = *(const LAS bf16x8*)(kb + ks * 32), a1 = *(const LAS bf16x8*)(kb + 32 * KP + ks * 32);
                p0 = PA_MFMA(a0, qf[ks], p0); p1 = PA_MFMA(a1, qf[ks], p1);
            }
            if (kv0 + 63 > Q0 + 32 * w) {
#pragma unroll
                for (int i = 0; i < 16; ++i) { const int kvg = kv0 + crow(i, hf); if (kvg > qg) p0[i] = -INFINITY; if (kvg + 32 > qg) p1[i] = -INFINITY; }
            }
            float rm = fmaxf(p0[0], p1[0]);
#pragma unroll
            for (int i = 1; i < 16; ++i) rm = fmaxf(rm, fmaxf(p0[i], p1[i]));
            rm = fmaxf(rm, __shfl_xor(rm, 32));
            if (t == 0) mref = rm == -INFINITY ? 0.f : rm;
            else if (__any(rm > mref + 8.f)) { const float mn = fmaxf(mref, rm), al = __builtin_amdgcn_exp2f(mref - mn); l *= al; mref = mn;
#pragma unroll
                for (int i = 0; i < 16; ++i) { o0[i] *= al; o1[i] *= al; } }
            float ls = 0.f;
#pragma unroll
            for (int i = 0; i < 16; ++i) { p0[i] = __builtin_amdgcn_exp2f(p0[i] - mref); p1[i] = __builtin_amdgcn_exp2f(p1[i] - mref); ls += p0[i] + p1[i]; }
            l += ls;
            const bf16x8 pb0 = pack8(p0, 0), pb1 = pack8(p0, 1), pb2 = pack8(p1, 0), pb3 = pack8(p1, 1);
            const LAS unsigned char* vb = lds + L_V + buf * VBUF;
#define PA_PV(PB, RB) do { const s16x4 l0 = vtr(vb + (RB) * VP + vo0), h0 = vtr(vb + ((RB) + 8) * VP + vo0), l1 = vtr(vb + (RB) * VP + vo1), h1 = vtr(vb + ((RB) + 8) * VP + vo1); \
                const bf16x8 a0 = __builtin_shufflevector(l0, h0, 0, 1, 2, 3, 4, 5, 6, 7), a1 = __builtin_shufflevector(l1, h1, 0, 1, 2, 3, 4, 5, 6, 7); \
                o0 = PA_MFMA(a0, PB, o0); o1 = PA_MFMA(a1, PB, o1); } while (0)
            PA_PV(pb0, 0); PA_PV(pb1, 16); PA_PV(pb2, 32); PA_PV(pb3, 48);
#undef PA_PV
        }
        if (t + 1 < NT) { const int nb = (buf ^ 1); *(LAS u32x4*)(lds + nb * VBUF + dV) = sV; *(LAS u32x4*)(lds + nb * KBUF + dK) = sK; if (tid < 256) *(LAS u32x4*)(lds + nb * KBUF + dR) = sR; }
        __syncthreads();
    }
    l += __shfl_xor(l, 32);
    const float il = 1.f / l;
    const size_t row = rowb + qg;
    const bf16* az = T.ZB + row * 3072 + ZAZ + h * 64 + 4 * hf; bf16* yo = T.YCAT + row * 1024 + 512 + h * 64 + 4 * hf;
#pragma unroll
    for (int d = 0; d < 2; ++d)
#pragma unroll
        for (int g = 0; g < 4; ++g) { const u32x2 a = *(const u32x2*)(az + 32 * d + 8 * g);
            const float z0 = bf2f((unsigned short)(a.x & 0xffff)), z1 = bf2f((unsigned short)(a.x >> 16)), z2 = bf2f((unsigned short)(a.y & 0xffff)), z3 = bf2f((unsigned short)(a.y >> 16));
            const f32x16& o = d == 0 ? o0 : o1;
            u32x2 r; r.x = cvtpk(o[4 * g] * il * siluf_(z0), o[4 * g + 1] * il * siluf_(z1)); r.y = cvtpk(o[4 * g + 2] * il * siluf_(z2), o[4 * g + 3] * il * siluf_(z3));
            *(u32x2*)(yo + 32 * d + 8 * g) = r; }
}
__device__ __forceinline__ void phase(LAS unsigned char* lds, const Tensors& T, int vcu, int G) {
    for (int v = vcu; v < 256; v += G) { const int bh = v >> 4, s = v & 15;
        unit(lds, T, bh >> 3, bh & 7, 31 - s); unit(lds, T, bh >> 3, bh & 7, s); }
}
}
struct PAArgs { pa::Tensors T; };
__global__ void __launch_bounds__(512, 2) k_attn_prompt(PAArgs a) {
    extern __shared__ __attribute__((aligned(16))) unsigned char lds[];
    pa::phase((LAS unsigned char*)lds, a.T, (int)blockIdx.x, (int)gridDim.x);
}

static void launch_gemm(const bf16* A, const bf16* Bt, float* C, int M, int N, int K, int ldc, hipStream_t stream) {
    GemmArgs a{}; a.A = A; a.Bt = Bt; a.C = C; a.M = M; a.N = N; a.K = K; a.ldc = ldc;
    hipLaunchKernelGGL(k_gemm_f32, dim3(256), dim3(512), pg8::STAGE_BYTES, stream, a);
}
extern "C" void kernel_launch(void* const* d_in, const int* in_sizes, int n_in, void* d_out, int out_size, void* d_ws, size_t ws_size, hipStream_t stream) {
    static int ready = 0;
    if (ready == 0) {
        if (n_in != 24 || out_size != (int)O_END || ws_size < WS_END) { fprintf(stderr, "kernel_launch: unexpected shapes: n_in %d out %d ws %zu\n", n_in, out_size, ws_size); ready = -1; return; }
        const void* gk[4] = {(const void*)k_gemm_f32, (const void*)k_gemm_inproj, (const void*)k_gemm_q, (const void*)k_gemm_kv};
        for (int i = 0; i < 4; ++i) if (hipFuncSetAttribute(gk[i], hipFuncAttributeMaxDynamicSharedMemorySize, pg8::STAGE_BYTES) != hipSuccess) { fprintf(stderr, "kernel_launch: hipFuncSetAttribute failed\n"); ready = -1; return; }
        ready = 1;
    }
    if (ready < 0) return;
    const float* xp = (const float*)d_in[0]; const float* xs = (const float*)d_in[1]; const float* cp = (const float*)d_in[2]; const float* cs = (const float*)d_in[3];
    const float* cache_ckv = (const float*)d_in[4]; const float* cache_kr = (const float*)d_in[5]; const float* st_C = (const float*)d_in[6]; const float* st_n = (const float*)d_in[7]; const float* st_m = (const float*)d_in[8];
    const int* page_table = (const int*)d_in[9];
    const float* w_ada = (const float*)d_in[10]; const float* b_ada = (const float*)d_in[11]; const float* w_in = (const float*)d_in[12]; const float* b_i = (const float*)d_in[13]; const float* b_f = (const float*)d_in[14];
    const float* ml_gn = (const float*)d_in[15]; const float* qnorm = (const float*)d_in[16]; const float* kvnorm = (const float*)d_in[17]; const float* w_uq = (const float*)d_in[18]; const float* w_uk = (const float*)d_in[19];
    const float* w_uv = (const float*)d_in[20]; const float* w_out = (const float*)d_in[21]; const float* ln_g = (const float*)d_in[22]; const float* ln_b = (const float*)d_in[23];
    float* out = (float*)d_out; unsigned char* ws = (unsigned char*)d_ws;
    float* MOD = (float*)(ws + WS_MOD); float* ROPET = (float*)(ws + WS_ROPET); bf16* WIN = (bf16*)(ws + WS_WIN); bf16* WUQ = (bf16*)(ws + WS_WUQ); bf16* WKV = (bf16*)(ws + WS_WKV); bf16* WOUT = (bf16*)(ws + WS_WOUT);
    bf16* H = (bf16*)(ws + WS_H); bf16* ZB = (bf16*)(ws + WS_ZB); float* GATES = (float*)(ws + WS_GATES); bf16* CKVR = (bf16*)(ws + WS_CKVR); bf16* CQR = (bf16*)(ws + WS_CQR);
    float* SSKV = (float*)(ws + WS_SSKV); float* SSQ = (float*)(ws + WS_SSQ); bf16* KRB = (bf16*)(ws + WS_KRB); bf16* Q96 = (bf16*)(ws + WS_Q96); bf16* KVB = (bf16*)(ws + WS_KVB);
    float* QLAT = (float*)(ws + WS_QLAT); float* OLAT = (float*)(ws + WS_OLAT); float* OMLA = (float*)(ws + WS_OMLA);
    float* HML = (float*)(ws + WS_HML); float* MLG = (float*)(ws + WS_MLG); float* MLU = (float*)(ws + WS_MLU); float* MLDC = (float*)(ws + WS_MLDC); float* MLDN = (float*)(ws + WS_MLDN);
    float* MLCS = (float*)(ws + WS_MLCS); float* MLNS = (float*)(ws + WS_MLNS); float* MLMS = (float*)(ws + WS_MLMS); bf16* YCAT = (bf16*)(ws + WS_YCAT); float* OUT = (float*)(ws + WS_OUT);

    hipLaunchKernelGGL(k_mod, dim3(12, 10), dim3(256), 0, stream, cp, cs, w_ada, b_ada, MOD);
    hipLaunchKernelGGL(k_ropetab, dim3(((PAST + DS) * 16 + 255) / 256), dim3(256), 0, stream, ROPET);
    hipLaunchKernelGGL(k_wt, dim3(D / 32, NINP / 32), dim3(32, 8), 0, stream, w_in, NIN, D, WIN, 1, (const float*)nullptr);
    hipLaunchKernelGGL(k_wt, dim3(QL / 32, (MH * QHD) / 32), dim3(32, 8), 0, stream, w_uq, MH * QHD, QL, WUQ, 0, qnorm);
    hipLaunchKernelGGL(k_wt, dim3(KVL / 32, 512 / 32), dim3(32, 8), 0, stream, w_uk, 512, KVL, WKV, 0, kvnorm);
    hipLaunchKernelGGL(k_wt, dim3(KVL / 32, 512 / 32), dim3(32, 8), 0, stream, w_uv, 512, KVL, WKV + (size_t)512 * KVL, 0, kvnorm);
    hipLaunchKernelGGL(k_wt, dim3(D / 32, D / 32), dim3(32, 8), 0, stream, w_out, D, D, WOUT, 0, (const float*)nullptr);
    hipLaunchKernelGGL(k_hprep, dim3(MT), dim3(256), 0, stream, xp, xs, MOD, H);
    { InProjArgs a{}; a.A = H; a.Bt = WIN; a.E.ZB = ZB; a.E.CKVR = CKVR; a.E.CQR = CQR; a.E.SSKV = SSKV; a.E.SSQ = SSQ; a.E.GATES = GATES; a.E.KRB = KRB; a.E.out_krp = out + O_KRP; a.E.out_krs = out + O_KRS; a.E.ropet = ROPET;
      hipLaunchKernelGGL(k_gemm_inproj, dim3(256), dim3(512), pg8::STAGE_BYTES, stream, a); }
    { QArgs a{}; a.A = CQR; a.Bt = WUQ; a.E.Q96 = Q96; a.E.SSQ = SSQ; a.E.qscale = MLA_SCALE * LOG2E;
      hipLaunchKernelGGL(k_gemm_q, dim3(256), dim3(512), pg8::STAGE_BYTES, stream, a); }
    { KVArgs a{}; a.A = CKVR; a.Bt = WKV; a.E.KVB = KVB; a.E.SSKV = SSKV;
      hipLaunchKernelGGL(k_gemm_kv, dim3(256), dim3(512), pg8::STAGE_BYTES, stream, a); }
    hipLaunchKernelGGL(k_rows_ckv, dim3(MT / 4), dim3(256), 0, stream, CKVR, SSKV, kvnorm, out);
    hipLaunchKernelGGL(k_qlat, dim3(MS), dim3(256), 0, stream, Q96, w_uk, QLAT);
    { PAArgs a{}; a.T.Q96 = Q96; a.T.KVB = KVB; a.T.KRB = KRB; a.T.ZB = ZB; a.T.ropet = ROPET; a.T.YCAT = YCAT;
      hipLaunchKernelGGL(k_attn_prompt, dim3(256), dim3(512), pa::LDS_BYTES, stream, a); }
    hipLaunchKernelGGL(k_attn_sample_naive, dim3(DB * MH), dim3(256), 0, stream, QLAT, Q96, cache_ckv, cache_kr, page_table, out + O_CKVS, KRB, ROPET, OLAT);
    hipLaunchKernelGGL(k_olat_uv, dim3(MS), dim3(512), 0, stream, OLAT, w_uv, OMLA);
    hipLaunchKernelGGL(k_ml_a, dim3(BP * LH * NCH), dim3(256), 0, stream, ZB, GATES, b_i, b_f, MLG, MLU, MLDC, MLDN);
    hipLaunchKernelGGL(k_ml_b, dim3(BP * LH * (DK * DV + DK) / 256), dim3(256), 0, stream, MLG, MLU, MLDC, MLDN, MLCS, MLNS, MLMS, out);
    hipLaunchKernelGGL(k_ml_c, dim3(BP * LH * NCH), dim3(256), 0, stream, ZB, GATES, b_i, b_f, MLCS, MLNS, MLMS, HML);
    hipLaunchKernelGGL(k_ml_sample, dim3(DB * LH), dim3(256), 0, stream, ZB, GATES, b_i, b_f, st_C, st_n, st_m, HML, out);
    hipLaunchKernelGGL(k_back_rows, dim3(MT / 4), dim3(256), 0, stream, ZB, HML, OMLA, ml_gn, YCAT);
    launch_gemm(YCAT, WOUT, OUT, MT, D, D, D, stream);
    hipLaunchKernelGGL(k_final_ln, dim3(MT / 4), dim3(256), 0, stream, xp, xs, MOD, OUT, ln_g, ln_b, out);
}
```

```cpp
#include <hip/hip_runtime.h>
#include <cstdio>
#include <cstdint>
#include <cmath>

constexpr int D = 1024, BP = 2, SP = 8192, MP = BP * SP, DB = 128, DS = 8, MS = DB * DS, MT = MP + MS;
constexpr int NIN = 3752, NINP = 3840;
constexpr int QL = 384, KVL = 256, ROPE = 32, NOPE = 64, MH = 8, VD = 64, QHD = NOPE + ROPE;
constexpr int LH = 4, DK = 128, DV = 128, LC = 128, NCH = SP / LC;
constexpr int PAGE = 128, NPAGES = 64, PAST = 8192;
constexpr float EPS = 1e-6f, ALPHA = 1.189207115002721f, MLA_SCALE = 0.10206207261596575f  , KSCALE = 0.08838834764831845f  ;
constexpr int ZQ = 0, ZK = 512, ZV = 1024, ZO = 1536, ZZ = 2048, ZAZ = 2560, ZCKV = 3072, ZCQ = 3328, ZKR = 3712, ZMI = 3744, ZMF = 3748;
constexpr size_t O_YP = 0, O_YS = 16777216, O_CKVP = 17825792, O_KRP = 22020096, O_CP = 22544384, O_NP = 22675456, O_MPR = 22676480,
                 O_CKVS = 22676488, O_KRS = 22938632, O_CS = 22971400, O_NS = 31360008, O_MS = 31425544, O_END = 31426056;
constexpr size_t MiB = 1u << 20;
constexpr size_t WS_CTL = 0, WS_MOD = 1 * MiB, WS_ROPET = 260 * MiB, WS_WIN = 4 * MiB, WS_WUQ = 12 * MiB, WS_WKV = 13 * MiB, WS_WOUT = 14 * MiB, WS_H = 16 * MiB,
                 WS_ZB = 64 * MiB  , WS_GATES = 168 * MiB, WS_CKVR = 170 * MiB  , WS_CQR = 180 * MiB  , WS_SSKV = 194 * MiB, WS_SSQ = 195 * MiB,
                 WS_KRB = 196 * MiB  , WS_Q96 = 198 * MiB  , WS_KVB = 224 * MiB  , WS_QLAT = 484 * MiB,
                 WS_OLAT = 492 * MiB, WS_OMLA = 500 * MiB, WS_HML = 536 * MiB, WS_MLG = 572 * MiB, WS_MLU = 573 * MiB, WS_MLDC = 576 * MiB, WS_MLDN = 608 * MiB,
                 WS_MLCS = 612 * MiB, WS_MLNS = 644 * MiB, WS_MLMS = 646 * MiB, WS_YCAT = 648 * MiB, WS_OUT = 684 * MiB, WS_PARTO = 760 * MiB, WS_PARTML = 780 * MiB, WS_WUKB = 262 * MiB, WS_END = 784 * MiB;
constexpr float LOG2E = 1.4426950408889634f;

__host__ __device__ __forceinline__ int zsrc(int j) {
    if (j < 1536) return j;
    if (j < 2560) return j + 8;
    if (j < 3072) return 3240 + (j - 2560);
    if (j < 3328) return 2952 + (j - 3072);
    if (j < 3712) return 2568 + (j - 3328);
    if (j < 3744) return 3208 + (j - 3712);
    if (j < 3752) return 1536 + (j - 3744);
    return -1;
}
__device__ __forceinline__ unsigned short f2bf(float f) { unsigned u = __builtin_bit_cast(unsigned, f); return (unsigned short)((u + 0x7fffu + ((u >> 16) & 1u)) >> 16); }
__device__ __forceinline__ float bf2f(unsigned short h) { return __builtin_bit_cast(float, (unsigned)h << 16); }
__device__ __forceinline__ float wave_sum(float v) {
#pragma unroll
    for (int o = 1; o < 64; o <<= 1) v += __shfl_xor(v, o);
    return v;
}
__device__ __forceinline__ float wave_max(float v) {
#pragma unroll
    for (int o = 1; o < 64; o <<= 1) v = fmaxf(v, __shfl_xor(v, o));
    return v;
}
__device__ __forceinline__ float sigmoidf_(float x) { return 1.f / (1.f + __expf(-x)); }
__device__ __forceinline__ float siluf_(float x) { return x / (1.f + __expf(-x)); }
__device__ __forceinline__ float logsigmoidf_(float x) { return x >= 0.f ? -log1pf(expf(-x)) : x - log1pf(expf(x)); }
__device__ __forceinline__ int row_pos(int m) { return m < MP ? (m & (SP - 1)) : PAST + ((m - MP) & (DS - 1)); }
__device__ __forceinline__ int row_modrow(int m) { return m < MP ? (m >> 13) : 2 + ((m - MP) >> 3); }
namespace pg8 {
#define PG8_LAS __attribute__((address_space(3)))
typedef unsigned short bf16_t;
typedef short bf16x8 __attribute__((ext_vector_type(8)));
typedef float f32x4 __attribute__((ext_vector_type(4)));
typedef unsigned u32x4 __attribute__((ext_vector_type(4)));
constexpr int BM = 256, BK = 64, HALF = 128, HTB = HALF * BK * 2  , STAGE_BYTES = 8 * HTB, NXCD = 8, WGM = 8;

__host__ __device__ __forceinline__ int lds_byte(int r, int c) { const int st = (r >> 4) * 2 + (c >> 5), rr = r & 15, cc = c & 31, ob = rr * 64 + cc * 2; return st * 1024 + (ob ^ (((ob >> 9) & 1) << 5)); }
__host__ __device__ __forceinline__ void stage_rc(int b, int& R, int& C) { const int st = b / 1024, sb = b % 1024, swz = sb ^ (((sb >> 9) & 1) << 5); R = (st >> 1) * 16 + swz / 64; C = (st & 1) * 32 + (swz % 64) / 2; }
__host__ __device__ __forceinline__ int perm32(int rho) { const int n = rho >> 4, i = rho & 15; return 8 * (i >> 2) + 4 * n + (i & 3); }

struct Unit { int pm, pn; };
struct Gemm { const bf16_t* A; const bf16_t* Bt; int M, N, K; };

struct StaticOrder {
    int nM, nN, nwg, G, c;
    __host__ __device__ void init(int M, int N, int G_, int c_) { nM = M / BM; nN = N / BM; nwg = nM * nN; G = G_; c = c_; }
    __host__ __device__ bool next(int i, Unit& u) const {
        const long L = (long)i * G + c; if (L >= nwg) return false;
        int wgid = (int)L; { const int q = nwg / NXCD, r = nwg % NXCD, xcd = wgid % NXCD, off = wgid / NXCD; wgid = (xcd < r ? xcd * (q + 1) : r * (q + 1) + (xcd - r) * q) + off; }
        const int nig = WGM * nN, gid = wgid / nig, fm = gid * WGM, gsz = (nM - fm) < WGM ? (nM - fm) : WGM;
        u.pm = fm + ((wgid % nig) % gsz); u.pn = (wgid % nig) / gsz; return true;
    }
    __device__ __forceinline__ void a_ready(const Unit&) const {}
    __device__ __forceinline__ void done(const Unit&) const {}
};

__device__ __forceinline__ unsigned cvt_pk_bf16(float lo, float hi) { unsigned r; asm volatile("v_cvt_pk_bf16_f32 %0, %1, %2" : "=v"(r) : "v"(lo), "v"(hi)); return r; }
__device__ __forceinline__ u32x4 pack8(const f32x4& v0, const f32x4& v1) { u32x4 w; w.x = cvt_pk_bf16(v0[0], v0[1]); w.y = cvt_pk_bf16(v0[2], v0[3]); w.z = cvt_pk_bf16(v1[0], v1[1]); w.w = cvt_pk_bf16(v1[2], v1[3]); return w; }
__device__ __forceinline__ float sq8(const f32x4& a, const f32x4& b) { return (a[0] * a[0] + a[1] * a[1]) + (a[2] * a[2] + a[3] * a[3]) + (b[0] * b[0] + b[1] * b[1]) + (b[2] * b[2] + b[3] * b[3]); }
__device__ __forceinline__ int epi_row_pos(int m) { return m < 16384 ? (m & 8191) : 8192 + ((m - 16384) & 7); }
__device__ __forceinline__ void rope8(f32x4& v0, f32x4& v1, const float* tab, int fq) {
    const int j0 = 8 * (fq & 1);
    const f32x4 c0 = *(const f32x4*)(tab + j0), c1 = *(const f32x4*)(tab + j0 + 4), s0 = *(const f32x4*)(tab + 16 + j0), s1 = *(const f32x4*)(tab + 16 + j0 + 4);
    f32x4 o0, o1;
#pragma unroll
    for (int i = 0; i < 4; ++i) { o0[i] = __shfl_xor(v0[i], 32); o1[i] = __shfl_xor(v1[i], 32); }
    if (fq < 2) { v0 = v0 * c0 - o0 * s0; v1 = v1 * c1 - o1 * s1; } else { v0 = v0 * c0 + o0 * s0; v1 = v1 * c1 + o1 * s1; }
}
struct EpiInProj {
    static constexpr bool PERM = true, AFTER_DRAIN = false;
    bf16_t* ZB; bf16_t* CKVR; bf16_t* CQR; float* SSKV; float* SSQ; float* GATES; bf16_t* KRB; float* out_krp; float* out_krs; const float* ropet;
    __device__ __forceinline__ void operator()(const f32x4 (&acc)[2][2][4][2], const Unit& u, int wr, int wc, int fr, int fq) const {
        const int row0 = u.pm * BM + wr * 64 + fr, cw = wc * 32 + 8 * fq;
        if (u.pn < 12) {
#pragma unroll
            for (int ai = 0; ai < 2; ++ai)
#pragma unroll
                for (int m = 0; m < 4; ++m) { bf16_t* rowp = ZB + (size_t)(row0 + ai * HALF + m * 16) * 3072 + u.pn * BM + cw;
#pragma unroll
                    for (int bj = 0; bj < 2; ++bj) *(u32x4*)(rowp + bj * HALF) = pack8(acc[ai][bj][m][0], acc[ai][bj][m][1]); }
        } else if (u.pn < 14) {
            bf16_t* dst = u.pn == 12 ? CKVR : CQR; const int ld = u.pn == 12 ? 256 : 384; float* ss = u.pn == 12 ? SSKV : SSQ; const int ssl = u.pn == 12 ? 4 : 8;
#pragma unroll
            for (int ai = 0; ai < 2; ++ai)
#pragma unroll
                for (int m = 0; m < 4; ++m) { const int row = row0 + ai * HALF + m * 16; bf16_t* rowp = dst + (size_t)row * ld + cw;
                    float s = 0.f;
#pragma unroll
                    for (int bj = 0; bj < 2; ++bj) { *(u32x4*)(rowp + bj * HALF) = pack8(acc[ai][bj][m][0], acc[ai][bj][m][1]); s += sq8(acc[ai][bj][m][0], acc[ai][bj][m][1]); }
                    s += __shfl_xor(s, 16); s += __shfl_xor(s, 32);
                    if (fq == 0) ss[(size_t)row * ssl + wc] = s; }
        } else {
#pragma unroll
            for (int ai = 0; ai < 2; ++ai)
#pragma unroll
                for (int m = 0; m < 4; ++m) { const int row = row0 + ai * HALF + m * 16;
                    *(u32x4*)(CQR + (size_t)row * 384 + 256 + cw) = pack8(acc[ai][0][m][0], acc[ai][0][m][1]);
                    float s = sq8(acc[ai][0][m][0], acc[ai][0][m][1]);
                    s += __shfl_xor(s, 16); s += __shfl_xor(s, 32);
                    if (fq == 0) SSQ[(size_t)row * 8 + 4 + wc] = s;
                    if (wc == 0) {
                        f32x4 v0 = acc[ai][1][m][0], v1 = acc[ai][1][m][1];
                        rope8(v0, v1, ropet + (size_t)epi_row_pos(row) * 32, fq);
                        float* o = row < 16384 ? out_krp + (size_t)row * 32 : out_krs + (size_t)(row - 16384) * 32;
                        *(f32x4*)(o + 8 * fq) = v0; *(f32x4*)(o + 8 * fq + 4) = v1;
                        *(u32x4*)(KRB + (size_t)row * 32 + 8 * fq) = pack8(v0, v1);
                    } else if (wc == 1 && fq == 0) {
                        *(f32x4*)(GATES + (size_t)row * 8) = acc[ai][1][m][0]; *(f32x4*)(GATES + (size_t)row * 8 + 4) = acc[ai][1][m][1];
                    } }
        }
    }
    __device__ __forceinline__ void fused(f32x4 (&)[2][2][4][2], const Unit&, int, int, int, int, PG8_LAS unsigned char*, int, int) const {}
};
struct EpiQ {
    static constexpr bool PERM = true, AFTER_DRAIN = false;
    bf16_t* Q96; const float* SSQ; float qscale;
    __device__ __forceinline__ void operator()(const f32x4 (&acc)[2][2][4][2], const Unit& u, int wr, int wc, int fr, int fq) const {
        const int row0 = u.pm * BM + wr * 64 + fr, cw = wc * 32 + 8 * fq;
#pragma unroll
        for (int ai = 0; ai < 2; ++ai)
#pragma unroll
            for (int m = 0; m < 4; ++m) { const int row = row0 + ai * HALF + m * 16;
                const f32x4 p0 = *(const f32x4*)(SSQ + (size_t)row * 8), p1 = *(const f32x4*)(SSQ + (size_t)row * 8 + 4);
                const float ssum = ((p0[0] + p0[1]) + (p0[2] + p0[3])) + ((p1[0] + p1[1]) + (p1[2] + p1[3]));
                const float rs = __builtin_amdgcn_rsqf(ssum * (1.0f / 384.0f) + 1e-6f) * qscale;
#pragma unroll
                for (int bj = 0; bj < 2; ++bj) *(u32x4*)(Q96 + (size_t)row * 768 + u.pn * BM + bj * HALF + cw) = pack8(acc[ai][bj][m][0] * rs, acc[ai][bj][m][1] * rs); }
    }
    __device__ __forceinline__ void fused(f32x4 (&)[2][2][4][2], const Unit&, int, int, int, int, PG8_LAS unsigned char*, int, int) const {}
};
struct EpiKV {
    static constexpr bool PERM = true, AFTER_DRAIN = false;
    bf16_t* KVB; const float* SSKV;
    __device__ __forceinline__ void operator()(const f32x4 (&acc)[2][2][4][2], const Unit& u, int wr, int wc, int fr, int fq) const {
        const int row0 = u.pm * BM + wr * 64 + fr, cw = wc * 32 + 8 * fq;
#pragma unroll
        for (int ai = 0; ai < 2; ++ai)
#pragma unroll
            for (int m = 0; m < 4; ++m) { const int row = row0 + ai * HALF + m * 16;
                const f32x4 p0 = *(const f32x4*)(SSKV + (size_t)row * 4);
                const float rs = __builtin_amdgcn_rsqf(((p0[0] + p0[1]) + (p0[2] + p0[3])) * (1.0f / 256.0f) + 1e-6f);
#pragma unroll
                for (int bj = 0; bj < 2; ++bj) *(u32x4*)(KVB + (size_t)row * 1024 + u.pn * BM + bj * HALF + cw) = pack8(acc[ai][bj][m][0] * rs, acc[ai][bj][m][1] * rs); }
    }
    __device__ __forceinline__ void fused(f32x4 (&)[2][2][4][2], const Unit&, int, int, int, int, PG8_LAS unsigned char*, int, int) const {}
};
struct EpiF32 {
    static constexpr bool PERM = false, AFTER_DRAIN = false;
    float* C; int ldc;
    __device__ __forceinline__ void operator()(const f32x4 (&acc)[2][2][4][2], const Unit& u, int wr, int wc, int fr, int fq) const {
        const int row0 = u.pm * BM + wr * 64 + fr, col0 = u.pn * BM + wc * 32 + 4 * fq;
#pragma unroll
        for (int ai = 0; ai < 2; ++ai)
#pragma unroll
            for (int m = 0; m < 4; ++m) { float* rowp = C + (size_t)(row0 + ai * HALF + m * 16) * ldc + col0;
#pragma unroll
                for (int bj = 0; bj < 2; ++bj)
#pragma unroll
                    for (int n = 0; n < 2; ++n) *(f32x4*)(rowp + bj * HALF + n * 16) = acc[ai][bj][m][n]; }
    }
    __device__ __forceinline__ void fused(f32x4 (&)[2][2][4][2], const Unit&, int, int, int, int, PG8_LAS unsigned char*, int, int) const {}
};
template <class Epi, class Sched, bool ALIGN_EPI = false, bool SP2 = false>
__device__ __forceinline__ void gemm_phase(PG8_LAS unsigned char* lds, const Gemm g, const Sched& S, const Epi& E) {
    const int tid = threadIdx.x, wid = __builtin_amdgcn_readfirstlane(tid >> 6), lane = tid & 63, wr = wid >> 2, wc = wid & 3, fr = lane & 15, fq = lane >> 4;
    const int K = g.K, nt = K / BK;
    unsigned voffA[2], voffB[2];
#pragma unroll
    for (int i = 0; i < 2; ++i) { int R, C; stage_rc(tid * 16 + i * 8192, R, C); const int Rb = Epi::PERM ? ((R & ~31) + perm32(R & 31)) : R;
        voffA[i] = (unsigned)(R * K + C) * 2u; voffB[i] = (unsigned)(Rb * K + C) * 2u; }
    const size_t kstep = (size_t)(BK * 2);
    const size_t hstep = (size_t)HALF * K * 2;
    const size_t tstep = 2 * hstep;
    const unsigned ldsw = (unsigned)wid * 1024u;
    const int aoff = lds_byte(wr * 64 + fr, fq * 8), boff = lds_byte(wc * 32 + fr, fq * 8);
#define PG8_SA(b, h) (((b) * 2 + (h)) * HTB)
#define PG8_SB(b, h) ((4 + (b) * 2 + (h)) * HTB)
#define PG8_STAGE(bufoff, gbase, voff) do { _Pragma("unroll") for (int _i = 0; _i < 2; ++_i) \
        __builtin_amdgcn_global_load_lds((const unsigned*)((const char*)(gbase) + (voff)[_i]), (PG8_LAS unsigned*)(lds + (bufoff) + ldsw + _i * 8192), 16, 0, 0); } while (0)
#define PG8_LDA(dst, b, h) do { _Pragma("unroll") for (int m = 0; m < 4; ++m) _Pragma("unroll") for (int k = 0; k < 2; ++k) dst[m][k] = *(const PG8_LAS bf16x8*)(lds + PG8_SA(b, h) + aoff + m * 2048 + k * 1024); } while (0)
#define PG8_LDB(dst, b, h) do { _Pragma("unroll") for (int n = 0; n < 2; ++n) _Pragma("unroll") for (int k = 0; k < 2; ++k) dst[n][k] = *(const PG8_LAS bf16x8*)(lds + PG8_SB(b, h) + boff + n * 2048 + k * 1024); } while (0)
#define PG8_MMA(ai, bj, At, Bt) do { __builtin_amdgcn_s_setprio(1); _Pragma("unroll") for (int m = 0; m < 4; ++m) _Pragma("unroll") for (int n = 0; n < 2; ++n) _Pragma("unroll") for (int k = 0; k < 2; ++k) \
        acc[ai][bj][m][n] = __builtin_amdgcn_mfma_f32_16x16x32_bf16(Bt[n][k], At[m][k], acc[ai][bj][m][n], 0, 0, 0); __builtin_amdgcn_s_setprio(0); } while (0)
#define PG8_WAIT_V(n) asm volatile("s_waitcnt vmcnt(" #n ")" ::: "memory")
#define PG8_WAIT_L(n) asm volatile("s_waitcnt lgkmcnt(" #n ")" ::: "memory")
#define PG8_BAR __builtin_amdgcn_s_barrier()
#define PG8_SCHED __builtin_amdgcn_sched_barrier(0)
    Unit cur, nxt; int ui = 0;
    if (!S.next(0, cur)) return;
    f32x4 acc[2][2][4][2];
#pragma unroll
    for (int a = 0; a < 2; ++a)
#pragma unroll
        for (int b = 0; b < 2; ++b)
#pragma unroll
            for (int m = 0; m < 4; ++m)
#pragma unroll
                for (int n = 0; n < 2; ++n) acc[a][b][m][n] = (f32x4){0.f, 0.f, 0.f, 0.f};
    bf16x8 At[4][2], B0[2][2], B1[2][2];
    const char* cA = (const char*)g.A + (size_t)cur.pm * tstep; const char* cB = (const char*)g.Bt + (size_t)cur.pn * tstep;
    S.a_ready(cur);
    if constexpr (SP2) {
        PG8_STAGE(PG8_SB(0, 0), cB, voffB); PG8_STAGE(PG8_SB(0, 1), cB + hstep, voffB); PG8_STAGE(PG8_SA(0, 0), cA, voffA); PG8_STAGE(PG8_SA(0, 1), cA + hstep, voffA);
        if (wr == 1) PG8_BAR;
        PG8_WAIT_V(2); PG8_BAR;
        PG8_STAGE(PG8_SB(1, 0), cB + kstep, voffB); PG8_STAGE(PG8_SA(1, 0), cA + kstep, voffA); PG8_STAGE(PG8_SB(1, 1), cB + hstep + kstep, voffB);
        PG8_WAIT_V(6); PG8_BAR;
    } else {
        PG8_STAGE(PG8_SB(0, 0), cB, voffB); PG8_STAGE(PG8_SA(0, 0), cA, voffA); PG8_STAGE(PG8_SB(0, 1), cB + hstep, voffB); PG8_STAGE(PG8_SA(0, 1), cA + hstep, voffA);
        if (wr == 1) PG8_BAR;
        PG8_WAIT_V(4); PG8_BAR;
        PG8_STAGE(PG8_SB(1, 0), cB + kstep, voffB); PG8_STAGE(PG8_SA(1, 0), cA + kstep, voffA); PG8_STAGE(PG8_SB(1, 1), cB + hstep + kstep, voffB);
        PG8_WAIT_V(6); PG8_BAR;
    }
    for (;;) {
        const bool has_next = S.next(ui + 1, nxt);
        const char* nA = has_next ? (const char*)g.A + (size_t)nxt.pm * tstep : cA; const char* nB = has_next ? (const char*)g.Bt + (size_t)nxt.pn * tstep : cB;
        for (int t = 0; t < nt; t += 2) {
            const bool last = (t == nt - 2);
            const char* a1 = cA + (size_t)(t + 1) * kstep;
            const char* a2 = last ? nA : cA + (size_t)(t + 2) * kstep; const char* b2 = last ? nB : cB + (size_t)(t + 2) * kstep;
            const char* a3 = a2 + kstep; const char* b3 = b2 + kstep;
            if (last && has_next) S.a_ready(nxt);
            if constexpr (SP2) {
            PG8_LDB(B0, 0, 0); PG8_LDB(B1, 0, 1); PG8_SCHED; PG8_LDA(At, 0, 0); PG8_STAGE(PG8_SA(1, 1), a1 + hstep, voffA);
            PG8_WAIT_V(8); PG8_WAIT_L(0); PG8_BAR; PG8_MMA(0, 0, At, B0); PG8_MMA(0, 1, At, B1); PG8_BAR; PG8_SCHED;
            PG8_LDA(At, 0, 1); PG8_STAGE(PG8_SB(0, 0), b2, voffB); PG8_STAGE(PG8_SB(0, 1), b2 + hstep, voffB); PG8_STAGE(PG8_SA(0, 0), a2, voffA);
            PG8_WAIT_V(8); PG8_WAIT_L(0); PG8_BAR; PG8_MMA(1, 0, At, B0); PG8_MMA(1, 1, At, B1); PG8_BAR; PG8_SCHED;
            PG8_LDB(B0, 1, 0); PG8_LDB(B1, 1, 1); PG8_SCHED; PG8_LDA(At, 1, 0); PG8_STAGE(PG8_SA(0, 1), a2 + hstep, voffA);
            PG8_WAIT_V(8); PG8_WAIT_L(0); PG8_BAR; PG8_MMA(0, 0, At, B0); PG8_MMA(0, 1, At, B1); PG8_BAR; PG8_SCHED;
            PG8_LDA(At, 1, 1); PG8_STAGE(PG8_SB(1, 0), b3, voffB); PG8_STAGE(PG8_SB(1, 1), b3 + hstep, voffB); PG8_STAGE(PG8_SA(1, 0), a3, voffA);
            PG8_WAIT_V(8); PG8_WAIT_L(0); PG8_BAR; PG8_MMA(1, 0, At, B0); PG8_MMA(1, 1, At, B1); PG8_BAR; PG8_SCHED;
            } else {
            PG8_LDB(B0, 0, 0); PG8_SCHED; PG8_LDA(At, 0, 0); PG8_STAGE(PG8_SA(1, 1), a1 + hstep, voffA);
            PG8_WAIT_L(8); PG8_BAR; PG8_WAIT_L(0); PG8_MMA(0, 0, At, B0); PG8_BAR; PG8_SCHED;
            PG8_LDB(B1, 0, 1); PG8_STAGE(PG8_SB(0, 0), b2, voffB);
            PG8_BAR; PG8_WAIT_L(0); PG8_MMA(0, 1, At, B1); PG8_BAR;
            PG8_LDA(At, 0, 1); PG8_STAGE(PG8_SA(0, 0), a2, voffA);
            PG8_BAR; PG8_WAIT_L(0); PG8_MMA(1, 0, At, B0); PG8_BAR; PG8_SCHED;
            PG8_STAGE(PG8_SB(0, 1), b2 + hstep, voffB);
            PG8_WAIT_V(6); PG8_BAR; PG8_MMA(1, 1, At, B1); PG8_BAR;
            PG8_LDB(B0, 1, 0); PG8_SCHED; PG8_LDA(At, 1, 0); PG8_STAGE(PG8_SA(0, 1), a2 + hstep, voffA);
            PG8_WAIT_L(8); PG8_BAR; PG8_WAIT_L(0); PG8_MMA(0, 0, At, B0); PG8_BAR; PG8_SCHED;
            PG8_LDB(B1, 1, 1); PG8_STAGE(PG8_SB(1, 0), b3, voffB);
            PG8_BAR; PG8_WAIT_L(0); PG8_MMA(0, 1, At, B1); PG8_BAR;
            PG8_LDA(At, 1, 1); PG8_STAGE(PG8_SA(1, 0), a3, voffA);
            PG8_BAR; PG8_WAIT_L(0); PG8_MMA(1, 0, At, B0); PG8_BAR; PG8_SCHED;
            PG8_STAGE(PG8_SB(1, 1), b3 + hstep, voffB);
            PG8_WAIT_V(6); PG8_BAR; PG8_MMA(1, 1, At, B1); PG8_BAR;
            }
        }
        if constexpr (ALIGN_EPI) { if (wr == 0) PG8_BAR; }
        if constexpr (!Epi::AFTER_DRAIN) { E(acc, cur, wr, wc, fr, fq); S.done(cur); }
        if (!has_next) break;
#pragma unroll
        for (int a = 0; a < 2; ++a)
#pragma unroll
            for (int b = 0; b < 2; ++b)
#pragma unroll
                for (int m = 0; m < 4; ++m)
#pragma unroll
                    for (int n = 0; n < 2; ++n) acc[a][b][m][n] = (f32x4){0.f, 0.f, 0.f, 0.f};
        cur = nxt; cA = nA; cB = nB; ++ui;
        if constexpr (ALIGN_EPI) { if (wr == 1) PG8_BAR; }
    }
    PG8_WAIT_V(0);
    if constexpr (!ALIGN_EPI) { if (wr == 0) PG8_BAR; }
    PG8_BAR;
    if constexpr (Epi::AFTER_DRAIN) { E.fused(acc, cur, wr, wc, fr, fq, lds, wid, lane); S.done(cur); }
#undef PG8_SA
#undef PG8_SB
#undef PG8_STAGE
#undef PG8_LDA
#undef PG8_LDB
#undef PG8_MMA
#undef PG8_WAIT_V
#undef PG8_WAIT_L
#undef PG8_BAR
#undef PG8_SCHED
}
}
typedef unsigned short bf16;
typedef float f32x4v __attribute__((ext_vector_type(4)));
#define LAS __attribute__((address_space(3)))

struct GemmArgs { const bf16* A; const bf16* Bt; float* C; int M, N, K, ldc; };
__global__ void __launch_bounds__(512, 2) k_gemm_f32(GemmArgs a) {
    extern __shared__ __attribute__((aligned(16))) unsigned char lds[];
    pg8::Gemm g{a.A, a.Bt, a.M, a.N, a.K}; pg8::StaticOrder S; S.init(a.M, a.N, (int)gridDim.x, (int)blockIdx.x);
    pg8::EpiF32 E{a.C, a.ldc};
    pg8::gemm_phase<pg8::EpiF32, pg8::StaticOrder, true, true>((LAS unsigned char*)lds, g, S, E);
}
struct InProjArgs { const bf16* A; const bf16* Bt; pg8::EpiInProj E; };
__global__ void __launch_bounds__(512, 2) k_gemm_inproj(InProjArgs a) {
    extern __shared__ __attribute__((aligned(16))) unsigned char lds[];
    pg8::Gemm g{a.A, a.Bt, MT, NINP, D}; pg8::StaticOrder S; S.init(MT, NINP, (int)gridDim.x, (int)blockIdx.x);
    pg8::gemm_phase<pg8::EpiInProj, pg8::StaticOrder, true, true>((LAS unsigned char*)lds, g, S, a.E);
}
struct QArgs { const bf16* A; const bf16* Bt; pg8::EpiQ E; };
__global__ void __launch_bounds__(512, 2) k_gemm_q(QArgs a) {
    extern __shared__ __attribute__((aligned(16))) unsigned char lds[];
    pg8::Gemm g{a.A, a.Bt, MT, MH * QHD, QL}; pg8::StaticOrder S; S.init(MT, MH * QHD, (int)gridDim.x, (int)blockIdx.x);
    pg8::gemm_phase<pg8::EpiQ, pg8::StaticOrder, true, true>((LAS unsigned char*)lds, g, S, a.E);
}
struct KVArgs { const bf16* A; const bf16* Bt; pg8::EpiKV E; };
__global__ void __launch_bounds__(512, 2) k_gemm_kv(KVArgs a) {
    extern __shared__ __attribute__((aligned(16))) unsigned char lds[];
    pg8::Gemm g{a.A, a.Bt, MP, 1024, KVL}; pg8::StaticOrder S; S.init(MP, 1024, (int)gridDim.x, (int)blockIdx.x);
    pg8::gemm_phase<pg8::EpiKV, pg8::StaticOrder, true, true>((LAS unsigned char*)lds, g, S, a.E);
}

__global__ void __launch_bounds__(256) k_mod(const float* __restrict__ c_p, const float* __restrict__ c_s, const float* __restrict__ w_ada, const float* __restrict__ b_ada, float* __restrict__ mod) {
    const int n = blockIdx.x * 256 + threadIdx.x, r0 = blockIdx.y * 13;
    float acc[13];
#pragma unroll
    for (int i = 0; i < 13; ++i) acc[i] = 0.f;
    for (int k = 0; k < D; ++k) {
        const float w = w_ada[(size_t)k * 3072 + n];
#pragma unroll
        for (int i = 0; i < 13; ++i) { const int r = r0 + i; const float cv = r < 2 ? c_p[r * D + k] : c_s[(r - 2) * D + k]; acc[i] += cv * w; }
    }
    const float bb = b_ada[n];
#pragma unroll
    for (int i = 0; i < 13; ++i) mod[(size_t)(r0 + i) * 3072 + n] = acc[i] + bb;
}
__global__ void __launch_bounds__(256) k_wt(const float* __restrict__ W, int ldw, int K, bf16* __restrict__ WT, int mode, const float* __restrict__ gain) {
    __shared__ float tile[32][33];
    const int k0 = blockIdx.x * 32, n0 = blockIdx.y * 32, tx = threadIdx.x, ty = threadIdx.y;
    const int n = n0 + tx, src = mode ? zsrc(n) : n;
    const float cs = (mode && n >= ZK && n < ZV) ? KSCALE : 1.f;
    for (int i = ty; i < 32; i += 8) tile[i][tx] = src >= 0 ? W[(size_t)(k0 + i) * ldw + src] * cs * (gain ? gain[k0 + i] : 1.f) : 0.f;
    __syncthreads();
    for (int i = ty; i < 32; i += 8) WT[(size_t)(n0 + i) * K + k0 + tx] = f2bf(tile[tx][i]);
}
__global__ void __launch_bounds__(256) k_cvt(const float* __restrict__ src, bf16* __restrict__ dst, int n4) {
    const int i = blockIdx.x * 256 + threadIdx.x; if (i >= n4) return;
    const f32x4v v = *(const f32x4v*)(src + 4 * (size_t)i); ushort4 o; o.x = f2bf(v.x); o.y = f2bf(v.y); o.z = f2bf(v.z); o.w = f2bf(v.w); *(ushort4*)(dst + 4 * (size_t)i) = o;
}
__global__ void __launch_bounds__(256) k_ropetab(float* __restrict__ T) {
    const int i = blockIdx.x * 256 + threadIdx.x; if (i >= (PAST + DS) * 16) return;
    const int pos = i >> 4, j = i & 15; const float inv = powf(10000.f, -(float)j / 16.f), ang = (float)pos * inv; float sn, cs; sincosf(ang, &sn, &cs);
    T[pos * 32 + j] = cs; T[pos * 32 + 16 + j] = sn;
}
__global__ void __launch_bounds__(256) k_hprep(const float* __restrict__ xp, const float* __restrict__ xs, const float* __restrict__ mod, bf16* __restrict__ H) {
    const size_t i4 = (size_t)blockIdx.x * 256 + threadIdx.x;
    const int m = (int)(i4 >> 8), c = (int)(i4 & 255) * 4;
    const float* x = m < MP ? xp + (size_t)m * D : xs + (size_t)(m - MP) * D;
    const float* mr = mod + (size_t)row_modrow(m) * 3072;
    const f32x4v xv = *(const f32x4v*)(x + c), sh = *(const f32x4v*)(mr + c), sc = *(const f32x4v*)(mr + 1024 + c);
    ushort4 o; o.x = f2bf(xv.x * (1.f + sc.x) + sh.x); o.y = f2bf(xv.y * (1.f + sc.y) + sh.y); o.z = f2bf(xv.z * (1.f + sc.z) + sh.z); o.w = f2bf(xv.w * (1.f + sc.w) + sh.w);
    *(ushort4*)(H + (size_t)m * D + c) = o;
}

__global__ void __launch_bounds__(256) k_rows_ckv(const bf16* __restrict__ CKVR, const float* __restrict__ SSKV, const float* __restrict__ kvnorm, float* __restrict__ out) {
    const int lane = threadIdx.x & 63, m = blockIdx.x * 4 + (threadIdx.x >> 6);
    const float4 p = *(const float4*)(SSKV + (size_t)m * 4);
    const float r = rsqrtf(((p.x + p.y) + (p.z + p.w)) * (1.f / KVL) + EPS);
    const ushort4 v = *(const ushort4*)(CKVR + (size_t)m * KVL + 4 * lane); const float4 g = *(const float4*)(kvnorm + 4 * lane);
    float* o = m < MP ? out + O_CKVP + (size_t)m * KVL : out + O_CKVS + (size_t)(m - MP) * KVL;
    *(float4*)(o + 4 * lane) = make_float4(bf2f(v.x) * r * g.x, bf2f(v.y) * r * g.y, bf2f(v.z) * r * g.z, bf2f(v.w) * r * g.w);
}
__global__ void __launch_bounds__(256) k_qlat(const bf16* __restrict__ Q96, const float* __restrict__ w_uk, float* __restrict__ QLAT) {
    __shared__ float qs[MH * NOPE];
    const int ms = blockIdx.x, c = threadIdx.x;
    for (int e = threadIdx.x; e < MH * NOPE; e += 256) qs[e] = bf2f(Q96[(size_t)(MP + ms) * (MH * QHD) + (e >> 6) * QHD + (e & 63)]);
    __syncthreads();
    for (int h = 0; h < MH; ++h) { float acc = 0.f;
        for (int n = 0; n < NOPE; ++n) acc += qs[h * NOPE + n] * w_uk[(size_t)c * (MH * NOPE) + h * NOPE + n];
        QLAT[((size_t)ms * MH + h) * KVL + c] = acc; }
}

__global__ void __launch_bounds__(256) k_attn_prompt_naive(const bf16* __restrict__ Q96, const bf16* __restrict__ KVB, const bf16* __restrict__ KRB, const float* __restrict__ ropet, float* __restrict__ OMLA) {
    const int qb = (int)gridDim.x - 1 - (int)blockIdx.x, b = blockIdx.y / MH, h = blockIdx.y % MH;
    const int t = qb * 256 + threadIdx.x, m = b * SP + t;
    float q[QHD], acc[VD];
#pragma unroll
    for (int j = 0; j < QHD; ++j) q[j] = bf2f(Q96[(size_t)m * (MH * QHD) + h * QHD + j]);
#pragma unroll
    for (int j = 0; j < VD; ++j) acc[j] = 0.f;
#pragma unroll
    for (int j = 0; j < 16; ++j) { const float cs = ropet[t * 32 + j], sn = ropet[t * 32 + 16 + j], x1 = q[NOPE + j], x2 = q[NOPE + 16 + j]; q[NOPE + j] = x1 * cs - x2 * sn; q[NOPE + 16 + j] = x2 * cs + x1 * sn; }
    float mx = -INFINITY, l = 0.f;
    const int jend = qb * 256 + 256;
    for (int j = 0; j < jend; ++j) {
        const bf16* kn = KVB + (size_t)(b * SP + j) * 1024 + h * NOPE; const bf16* kr = KRB + (size_t)(b * SP + j) * ROPE; const bf16* vv = KVB + (size_t)(b * SP + j) * 1024 + 512 + h * VD;
        float s = 0.f;
#pragma unroll
        for (int d = 0; d < NOPE; ++d) s += q[d] * bf2f(kn[d]);
#pragma unroll
        for (int d = 0; d < ROPE; ++d) s += q[NOPE + d] * bf2f(kr[d]);
        if (j <= t) {
            const float mn = fmaxf(mx, s), al = exp2f(mx - mn), p = exp2f(s - mn);
            l = l * al + p; mx = mn;
#pragma unroll
            for (int d = 0; d < VD; ++d) acc[d] = acc[d] * al + p * bf2f(vv[d]);
        }
    }
    const float il = 1.f / l;
#pragma unroll
    for (int d = 0; d < VD; ++d) OMLA[(size_t)m * 512 + h * VD + d] = acc[d] * il;
}

__global__ void __launch_bounds__(256) k_attn_sample_naive(const float* __restrict__ QLAT, const bf16* __restrict__ Q96, const float* __restrict__ cache_ckv, const float* __restrict__ cache_kr,
                                                           const int* __restrict__ page_table, const float* __restrict__ ckv_new  , const bf16* __restrict__ KRB, const float* __restrict__ ropet, float* __restrict__ OLAT) {
    __shared__ float s_m[4][DS], s_l[4][DS], s_acc[4][DS][KVL];
    const int b = blockIdx.x / MH, h = blockIdx.x % MH, lane = threadIdx.x & 63, w = threadIdx.x >> 6;
    float ql[DS][4], qr[DS], acc[DS][4], mx[DS], l[DS];
#pragma unroll
    for (int i = 0; i < DS; ++i) {
#pragma unroll
        for (int j = 0; j < 4; ++j) { ql[i][j] = QLAT[((size_t)(b * DS + i) * MH + h) * KVL + lane + 64 * j]; acc[i][j] = 0.f; }
        { const float x = lane < ROPE ? bf2f(Q96[(size_t)(MP + b * DS + i) * (MH * QHD) + h * QHD + NOPE + lane]) : 0.f, o = __shfl_xor(x, 16);
          const float cs = ropet[(PAST + i) * 32 + (lane & 15)], sn = ropet[(PAST + i) * 32 + 16 + (lane & 15)];
          qr[i] = lane < 16 ? x * cs - o * sn : (lane < 32 ? x * cs + o * sn : 0.f); }
        mx[i] = -INFINITY; l[i] = 0.f;
    }
    for (int key = w; key < PAST + DS; key += 4) {
        const float* kc; const float* kr = nullptr; const bf16* krn = nullptr;
        if (key < PAST) { const int pg = page_table[b * NPAGES + (key >> 7)]; kc = cache_ckv + ((size_t)pg * PAGE + (key & 127)) * KVL; kr = cache_kr + ((size_t)pg * PAGE + (key & 127)) * ROPE; }
        else { kc = ckv_new + (size_t)(b * DS + key - PAST) * KVL; krn = KRB + (size_t)(MP + b * DS + key - PAST) * ROPE; }
        float kv[4];
#pragma unroll
        for (int j = 0; j < 4; ++j) kv[j] = kc[lane + 64 * j];
        const float krv = lane < ROPE ? (kr ? kr[lane] : bf2f(krn[lane])) : 0.f;
#pragma unroll
        for (int i = 0; i < DS; ++i) {
            float s = ql[i][0] * kv[0] + ql[i][1] * kv[1] + ql[i][2] * kv[2] + ql[i][3] * kv[3] + qr[i] * krv;
            s = wave_sum(s);
            if (key < PAST + i + 1) {
                const float mn = fmaxf(mx[i], s), al = exp2f(mx[i] - mn), p = exp2f(s - mn);
                l[i] = l[i] * al + p; mx[i] = mn;
#pragma unroll
                for (int j = 0; j < 4; ++j) acc[i][j] = acc[i][j] * al + p * kv[j];
            }
        }
    }
#pragma unroll
    for (int i = 0; i < DS; ++i) { if (lane == 0) { s_m[w][i] = mx[i]; s_l[w][i] = l[i]; }
#pragma unroll
        for (int j = 0; j < 4; ++j) s_acc[w][i][lane + 64 * j] = acc[i][j]; }
    __syncthreads();
    for (int e = threadIdx.x; e < DS * KVL; e += 256) { const int i = e >> 8, c = e & 255;
        const float mm = fmaxf(fmaxf(s_m[0][i], s_m[1][i]), fmaxf(s_m[2][i], s_m[3][i]));
        float num = 0.f, den = 0.f;
#pragma unroll
        for (int ww = 0; ww < 4; ++ww) { const float f = exp2f(s_m[ww][i] - mm); num += f * s_acc[ww][i][c]; den += f * s_l[ww][i]; }
        OLAT[((size_t)(b * DS + i) * MH + h) * KVL + c] = num / den; }
}
__global__ void __launch_bounds__(512) k_olat_uv(const float* __restrict__ OLAT, const float* __restrict__ w_uv, float* __restrict__ OMLA) {
    __shared__ float os[MH * KVL];
    const int ms = blockIdx.x, tid = threadIdx.x, h = tid >> 6;
    for (int e = tid; e < MH * KVL; e += 512) os[e] = OLAT[(size_t)ms * MH * KVL + e];
    __syncthreads();
    float acc = 0.f;
    for (int c = 0; c < KVL; ++c) acc += os[h * KVL + c] * w_uv[(size_t)c * 512 + tid];
    OMLA[(size_t)(MP + ms) * 512 + tid] = acc;
}

__global__ void __launch_bounds__(256) k_ml_a(const bf16* __restrict__ ZB, const float* __restrict__ GATES, const float* __restrict__ b_i, const float* __restrict__ b_f, float* __restrict__ G, float* __restrict__ U, float* __restrict__ DC, float* __restrict__ DN) {
    __shared__ float s_w[LC], s_F[LC], s_ig[LC], s_red[2];
    const int bh = blockIdx.x / NCH, c = blockIdx.x % NCH, b = bh / LH, h = bh % LH, tid = threadIdx.x;
    const size_t row0 = (size_t)b * SP + (size_t)c * LC;
    if (tid < LC) { const float* z = GATES + (row0 + tid) * 8; s_ig[tid] = z[h] + b_i[h]; s_F[tid] = logsigmoidf_(z[4 + h] + b_f[h]); }
    __syncthreads();
    if (tid == 0) { float f = 0.f; for (int s = 0; s < LC; ++s) { f += s_F[s]; s_F[s] = f; } const float g = f; float u = -INFINITY;
        for (int s = 0; s < LC; ++s) u = fmaxf(u, g - s_F[s] + s_ig[s]); s_red[0] = g; s_red[1] = u; }
    __syncthreads();
    const float g = s_red[0], u = s_red[1];
    if (tid < LC) s_w[tid] = __expf(g - s_F[tid] + s_ig[tid] - u);
    __syncthreads();
    const int dk = tid >> 1, dv0 = (tid & 1) * 64;
    float acc[64]; float an = 0.f;
#pragma unroll
    for (int j = 0; j < 64; ++j) acc[j] = 0.f;
    for (int s = 0; s < LC; ++s) { const bf16* z = ZB + (row0 + s) * 3072; const float kw = bf2f(z[ZK + h * DK + dk]) * s_w[s]; an += kw;
#pragma unroll
        for (int j = 0; j < 64; ++j) acc[j] += kw * bf2f(z[ZV + h * DV + dv0 + j]); }
    float* dc = DC + ((size_t)blockIdx.x * DK + dk) * DV + dv0;
#pragma unroll
    for (int j = 0; j < 64; ++j) dc[j] = acc[j];
    if ((tid & 1) == 0) DN[(size_t)blockIdx.x * DK + dk] = an;
    if (tid == 0) { G[blockIdx.x] = g; U[blockIdx.x] = u; }
}
__global__ void __launch_bounds__(256) k_ml_b(const float* __restrict__ G, const float* __restrict__ U, const float* __restrict__ DC, const float* __restrict__ DN,
                                              float* __restrict__ CS, float* __restrict__ NS, float* __restrict__ MSs, float* __restrict__ out) {
    const int gid = blockIdx.x * 256 + threadIdx.x, bh = gid / (DK * DV + DK), e = gid % (DK * DV + DK);
    float m = -INFINITY, x = 0.f;
    for (int c = 0; c < NCH; ++c) {
        const int ci = bh * NCH + c;
        if (e < DK * DV) CS[(size_t)ci * DK * DV + e] = x; else NS[(size_t)ci * DK + (e - DK * DV)] = x;
        if (e == 0) MSs[ci] = m;
        const float g = G[ci], u = U[ci], mn = fmaxf(g + m, u), al = __expf(g + m - mn), be = __expf(u - mn);
        const float d = e < DK * DV ? DC[(size_t)ci * DK * DV + e] : DN[(size_t)ci * DK + (e - DK * DV)];
        x = al * x + be * d; m = mn;
    }
    if (e < DK * DV) out[O_CP + (size_t)bh * DK * DV + e] = x; else out[O_NP + (size_t)bh * DK + (e - DK * DV)] = x;
    if (e == 0) out[O_MPR + bh] = m;
}
__global__ void __launch_bounds__(256) k_ml_c(const bf16* __restrict__ ZB, const float* __restrict__ GATES, const float* __restrict__ b_i, const float* __restrict__ b_f, const float* __restrict__ CS, const float* __restrict__ NS, const float* __restrict__ MSs, float* __restrict__ HML) {
    __shared__ float s_F[LC], s_ig[LC];
    const int bh = blockIdx.x / NCH, c = blockIdx.x % NCH, b = bh / LH, h = bh % LH, tid = threadIdx.x;
    const size_t row0 = (size_t)b * SP + (size_t)c * LC;
    if (tid < LC) { const float* z = GATES + (row0 + tid) * 8; s_ig[tid] = z[h] + b_i[h]; s_F[tid] = logsigmoidf_(z[4 + h] + b_f[h]); }
    __syncthreads();
    if (tid == 0) { float f = 0.f; for (int s = 0; s < LC; ++s) { f += s_F[s]; s_F[s] = f; } }
    __syncthreads();
    const int t = tid >> 1, dv0 = (tid & 1) * 64;
    const float mprev = MSs[blockIdx.x], Ft = s_F[t];
    float mt = Ft + mprev;
    for (int s = 0; s <= t; ++s) mt = fmaxf(mt, Ft - s_F[s] + s_ig[s]);
    const float a = __expf(Ft + mprev - mt);
    const bf16* zq = ZB + (row0 + t) * 3072 + ZQ + h * DK;
    float acc[64]; float den = 0.f;
#pragma unroll
    for (int j = 0; j < 64; ++j) acc[j] = 0.f;
    for (int s = 0; s <= t; ++s) {
        const bf16* z = ZB + (row0 + s) * 3072; float dot = 0.f;
        for (int d = 0; d < DK; ++d) dot += bf2f(zq[d]) * bf2f(z[ZK + h * DK + d]);
        const float sq = dot * __expf(Ft - s_F[s] + s_ig[s] - mt); den += sq;
#pragma unroll
        for (int j = 0; j < 64; ++j) acc[j] += sq * bf2f(z[ZV + h * DV + dv0 + j]);
    }
    const float* cs = CS + (size_t)blockIdx.x * DK * DV; const float* ns = NS + (size_t)blockIdx.x * DK;
    float qn = 0.f;
    for (int d = 0; d < DK; ++d) { const float qa = bf2f(zq[d]) * a; qn += qa * ns[d];
#pragma unroll
        for (int j = 0; j < 64; ++j) acc[j] += qa * cs[(size_t)d * DV + dv0 + j]; }
    den += qn;
    const float inv = 1.f / fmaxf(fabsf(den), __expf(-mt));
    float* o = HML + (row0 + t) * 512 + h * DV + dv0;
#pragma unroll
    for (int j = 0; j < 64; ++j) o[j] = acc[j] * inv;
}
__global__ void __launch_bounds__(256) k_ml_sample(const bf16* __restrict__ ZB, const float* __restrict__ GATES, const float* __restrict__ b_i, const float* __restrict__ b_f, const float* __restrict__ C0, const float* __restrict__ n0, const float* __restrict__ m0,
                                                   float* __restrict__ HML, float* __restrict__ out) {
    __shared__ float s_q[DS][DK], s_k[DS][DK], s_v[DS][DV], s_F[DS], s_ig[DS], s_mt[DS], s_a[DS], s_S[DS][DS], s_den[DS], s_qc[2][DS][DV], s_wl[DS];
    const int b = blockIdx.x / LH, h = blockIdx.x % LH, tid = threadIdx.x;
    const size_t row0 = (size_t)MP + (size_t)b * DS;
    for (int e = tid; e < DS * DK; e += 256) { const int t = e >> 7, d = e & 127; const bf16* z = ZB + (row0 + t) * 3072;
        s_q[t][d] = bf2f(z[ZQ + h * DK + d]); s_k[t][d] = bf2f(z[ZK + h * DK + d]); s_v[t][d] = bf2f(z[ZV + h * DV + d]); }
    if (tid < DS) { const float* z = GATES + (row0 + tid) * 8; s_ig[tid] = z[h] + b_i[h]; s_F[tid] = logsigmoidf_(z[4 + h] + b_f[h]); }
    __syncthreads();
    const float mprev = m0[b * LH + h];
    if (tid == 0) { float f = 0.f; for (int s = 0; s < DS; ++s) { f += s_F[s]; s_F[s] = f; }
        for (int t = 0; t < DS; ++t) { float mt = s_F[t] + mprev; for (int s = 0; s <= t; ++s) mt = fmaxf(mt, s_F[t] - s_F[s] + s_ig[s]); s_mt[t] = mt; s_a[t] = __expf(s_F[t] + mprev - mt); }
        for (int s = 0; s < DS; ++s) s_wl[s] = __expf(s_F[DS - 1] - s_F[s] + s_ig[s] - s_mt[DS - 1]); }
    __syncthreads();
    if (tid < DS * DS) { const int t = tid >> 3, s = tid & 7; float v = 0.f;
        if (s <= t) { float dot = 0.f; for (int d = 0; d < DK; ++d) dot += s_q[t][d] * s_k[s][d]; v = dot * __expf(s_F[t] - s_F[s] + s_ig[s] - s_mt[t]); }
        s_S[t][s] = v; }
    __syncthreads();
    const int dv = tid & 127, hf = tid >> 7;
    const float* c0 = C0 + (size_t)blockIdx.x * DK * DV; float* cn = out + O_CS + (size_t)blockIdx.x * DK * DV;
    const float al = s_a[DS - 1];
    float qc[DS];
#pragma unroll
    for (int t = 0; t < DS; ++t) qc[t] = 0.f;
    for (int d = hf * 64; d < hf * 64 + 64; ++d) {
        const float cv = c0[(size_t)d * DV + dv]; float nv = al * cv;
#pragma unroll
        for (int t = 0; t < DS; ++t) { qc[t] += s_q[t][d] * cv; nv += s_wl[t] * s_k[t][d] * s_v[t][dv]; }
        cn[(size_t)d * DV + dv] = nv;
    }
#pragma unroll
    for (int t = 0; t < DS; ++t) s_qc[hf][t][dv] = qc[t];
    if (tid < DS) { const int t = tid; float dn = 0.f; for (int s = 0; s <= t; ++s) dn += s_S[t][s]; float qn = 0.f; const float* nn = n0 + (size_t)blockIdx.x * DK;
        for (int d = 0; d < DK; ++d) qn += s_q[t][d] * nn[d]; s_den[t] = dn + s_a[t] * qn; }
    if (tid >= 128 && tid < 128 + DK) { const int d = tid - 128; float nv = al * n0[(size_t)blockIdx.x * DK + d];
        for (int s = 0; s < DS; ++s) nv += s_wl[s] * s_k[s][d]; out[O_NS + (size_t)blockIdx.x * DK + d] = nv; }
    if (tid == 0) out[O_MS + blockIdx.x] = s_mt[DS - 1];
    __syncthreads();
    for (int e = tid; e < DS * DV; e += 256) { const int t = e >> 7, d = e & 127; float num = s_a[t] * (s_qc[0][t][d] + s_qc[1][t][d]);
        for (int s = 0; s <= t; ++s) num += s_S[t][s] * s_v[s][d];
        HML[(row0 + t) * 512 + h * DV + d] = num / fmaxf(fabsf(s_den[t]), __expf(-s_mt[t])); }
}

__global__ void __launch_bounds__(256) k_back_rows(const bf16* __restrict__ ZB, const float* __restrict__ HML, const float* __restrict__ OMLA, const float* __restrict__ gn, bf16* __restrict__ YCAT) {
    const int lane = threadIdx.x & 63, m = blockIdx.x * 4 + (threadIdx.x >> 6);
    const bf16* z = ZB + (size_t)m * 3072;
#pragma unroll
    for (int h = 0; h < LH; ++h) {
        const int c0 = h * DV + lane, c1 = c0 + 64;
        const float a0 = HML[(size_t)m * 512 + c0] * sigmoidf_(bf2f(z[ZO + c0])), a1 = HML[(size_t)m * 512 + c1] * sigmoidf_(bf2f(z[ZO + c1]));
        const float mu = wave_sum(a0 + a1) * (1.f / DV), d0 = a0 - mu, d1 = a1 - mu, var = wave_sum(d0 * d0 + d1 * d1) * (1.f / DV), r = rsqrtf(var + EPS);
        YCAT[(size_t)m * D + c0] = f2bf(d0 * r * gn[c0] * siluf_(bf2f(z[ZZ + c0]))); YCAT[(size_t)m * D + c1] = f2bf(d1 * r * gn[c1] * siluf_(bf2f(z[ZZ + c1])));
    }
#pragma unroll
    for (int i = 0; i < 8; ++i) if (m >= MP) { const int c = lane + 64 * i; YCAT[(size_t)m * D + 512 + c] = f2bf(OMLA[(size_t)m * 512 + c] * siluf_(bf2f(z[ZAZ + c]))); }
}
__global__ void __launch_bounds__(256) k_final_ln(const float* __restrict__ xp, const float* __restrict__ xs, const float* __restrict__ mod, const float* __restrict__ OUT, const float* __restrict__ lg, const float* __restrict__ lb, float* __restrict__ out) {
    const int lane = threadIdx.x & 63, m = blockIdx.x * 4 + (threadIdx.x >> 6);
    const float* x = m < MP ? xp + (size_t)m * D : xs + (size_t)(m - MP) * D;
    const float* gate = mod + (size_t)row_modrow(m) * 3072 + 2048;
    float* y = m < MP ? out + O_YP + (size_t)m * D : out + O_YS + (size_t)(m - MP) * D;
    f32x4v v[4]; float s = 0.f;
#pragma unroll
    for (int j = 0; j < 4; ++j) { const int c = 4 * lane + 256 * j; const f32x4v xv = *(const f32x4v*)(x + c), gv = *(const f32x4v*)(gate + c), ov = *(const f32x4v*)(OUT + (size_t)m * D + c);
        v[j] = xv * ALPHA + gv * ov; s += (v[j].x + v[j].y) + (v[j].z + v[j].w); }
    const float mu = wave_sum(s) * (1.f / D); float s2 = 0.f;
#pragma unroll
    for (int j = 0; j < 4; ++j) { v[j] = v[j] - mu; s2 += (v[j].x * v[j].x + v[j].y * v[j].y) + (v[j].z * v[j].z + v[j].w * v[j].w); }
    const float r = rsqrtf(wave_sum(s2) * (1.f / D) + EPS);
#pragma unroll
    for (int j = 0; j < 4; ++j) { const int c = 4 * lane + 256 * j; const f32x4v g = *(const f32x4v*)(lg + c), bb = *(const f32x4v*)(lb + c); *(f32x4v*)(y + c) = v[j] * r * g + bb; }
}
namespace pa {
typedef short bf16x8 __attribute__((ext_vector_type(8)));
typedef short s16x4 __attribute__((ext_vector_type(4)));
typedef float f32x16 __attribute__((ext_vector_type(16)));
typedef unsigned u32x4 __attribute__((ext_vector_type(4)));
typedef unsigned u32x2 __attribute__((ext_vector_type(2)));
typedef float f32x2_t __attribute__((ext_vector_type(2))); typedef __bf16 bf16x2_t __attribute__((ext_vector_type(2)));
constexpr int KP = 208, VP = 128, KBUF = 64 * KP, VBUF = 64 * VP, L_K = 0, L_V = 2 * KBUF, LDS_BYTES = 2 * KBUF + 2 * VBUF;
__device__ __forceinline__ unsigned cvtpk(float lo, float hi) { f32x2_t v = {lo, hi}; bf16x2_t b = __builtin_convertvector(v, bf16x2_t); return __builtin_bit_cast(unsigned, b); }
__device__ __forceinline__ bf16x8 pack8(const f32x16& p, int s) { u32x4 w; w.x = cvtpk(p[8 * s], p[8 * s + 1]); w.y = cvtpk(p[8 * s + 2], p[8 * s + 3]); w.z = cvtpk(p[8 * s + 4], p[8 * s + 5]); w.w = cvtpk(p[8 * s + 6], p[8 * s + 7]); return __builtin_bit_cast(bf16x8, w); }
__device__ __forceinline__ s16x4 vtr(const LAS unsigned char* p) { return __builtin_bit_cast(s16x4, __builtin_amdgcn_ds_read_tr16_b64_v4i16((LAS s16x4*)p)); }
__device__ __forceinline__ int crow(int r, int hf) { return (r & 3) + 8 * (r >> 2) + 4 * hf; }
#define PA_MFMA(a, b, c) __builtin_amdgcn_mfma_f32_32x32x16_bf16((a), (b), (c), 0, 0, 0)

struct Tensors { const bf16* Q96; const bf16* KVB; const bf16* KRB; const bf16* ZB; const float* ropet; bf16* YCAT; };

__device__ __forceinline__ void unit(LAS unsigned char* lds, const Tensors& T, int b, int h, int qb) {
    const int tid = threadIdx.x, lane = tid & 63, w = __builtin_amdgcn_readfirstlane(tid >> 6), q32 = lane & 31, hf = lane >> 5;
    const int Q0 = qb * 256, NT = (Q0 + 256) / 64;
    const size_t rowb = (size_t)b * SP;
    const int rv = tid >> 3, cv = tid & 7;
    const bf16* gV = T.KVB + (rowb + rv) * 1024 + 512 + h * 64 + cv * 8;
    const bf16* gK = T.KVB + (rowb + rv) * 1024 + h * 64 + cv * 8;
    const bf16* gR = T.KRB + (rowb + (tid >> 2)) * 32 + (tid & 3) * 8;
    const int dV = L_V + rv * VP + ((cv ^ (((rv >> 1) & 1) << 2)) * 16), dK = L_K + rv * KP + cv * 16, dR = L_K + (tid >> 2) * KP + 128 + (tid & 3) * 16;
    u32x4 sV, sK, sR = {0u, 0u, 0u, 0u};
    sV = *(const u32x4*)gV; sK = *(const u32x4*)gK; if (tid < 256) sR = *(const u32x4*)gR;
    const int qg = Q0 + 32 * w + q32;
    const bf16* qrow = T.Q96 + (rowb + qg) * 768 + h * 96 + 8 * hf;
    bf16x8 qf[6];
#pragma unroll
    for (int ks = 0; ks < 6; ++ks) qf[ks] = *(const bf16x8*)(qrow + 16 * ks);
    {   const float* tb = T.ropet + (size_t)qg * 32 + 8 * hf;
        u32x4 y1, y2;
#pragma unroll
        for (int e = 0; e < 8; e += 2) {
            const float c0 = tb[e], c1 = tb[e + 1], s0 = tb[16 + e], s1 = tb[16 + e + 1];
            const float a0 = bf2f((unsigned short)qf[4][e]), a1 = bf2f((unsigned short)qf[4][e + 1]), b0 = bf2f((unsigned short)qf[5][e]), b1 = bf2f((unsigned short)qf[5][e + 1]);
            y1[e >> 1] = cvtpk(a0 * c0 - b0 * s0, a1 * c1 - b1 * s1); y2[e >> 1] = cvtpk(b0 * c0 + a0 * s0, b1 * c1 + a1 * s1);
        }
        qf[4] = __builtin_bit_cast(bf16x8, y1); qf[5] = __builtin_bit_cast(bf16x8, y2); }
    __syncthreads();
    *(LAS u32x4*)(lds + dV) = sV; *(LAS u32x4*)(lds + dK) = sK; if (tid < 256) *(LAS u32x4*)(lds + dR) = sR;
    __syncthreads();
    f32x16 o0, o1;
#pragma unroll
    for (int i = 0; i < 16; ++i) { o0[i] = 0.f; o1[i] = 0.f; }
    float mref = 0.f, l = 0.f;
    const int i16 = lane & 15, q4 = i16 >> 2, p4 = i16 & 3, blk = (lane >> 4) & 1;
    const int vo0 = q4 * VP + (((0 + 2 * blk + (p4 >> 1)) ^ (((q4 >> 1) & 1) << 2)) * 16) + (p4 & 1) * 8 + 4 * hf * VP;
    const int vo1 = q4 * VP + (((4 + 2 * blk + (p4 >> 1)) ^ (((q4 >> 1) & 1) << 2)) * 16) + (p4 & 1) * 8 + 4 * hf * VP;
    for (int t = 0; t < NT; ++t) {
        const int buf = t & 1;
        if (t + 1 < NT) { const size_t adv = (size_t)(t + 1) * 64; sV = *(const u32x4*)(gV + adv * 1024); sK = *(const u32x4*)(gK + adv * 1024); if (tid < 256) sR = *(const u32x4*)(gR + adv * 32); }
        const int kv0 = 64 * t;
        if (kv0 <= Q0 + 32 * w + 31) {
            f32x16 p0, p1;
#pragma unroll
            for (int i = 0; i < 16; ++i) { p0[i] = 0.f; p1[i] = 0.f; }
            const LAS unsigned char* kb = lds + L_K + buf * KBUF + q32 * KP + hf * 16;
#pragma unroll
            for (int ks = 0; ks < 6; ++ks) {
                const bf16x8 a0 = *(const LAS bf16x8*)(kb + ks * 32), a1 = *(const LAS bf16x8*)(kb + 32 * KP + ks * 32);
                p0 = PA_MFMA(a0, qf[ks], p0); p1 = PA_MFMA(a1, qf[ks], p1);
            }
            if (kv0 + 63 > Q0 + 32 * w) {
#pragma unroll
                for (int i = 0; i < 16; ++i) { const int kvg = kv0 + crow(i, hf); if (kvg > qg) p0[i] = -INFINITY; if (kvg + 32 > qg) p1[i] = -INFINITY; }
            }
            float rm = fmaxf(p0[0], p1[0]);
#pragma unroll
            for (int i = 1; i < 16; ++i) rm = fmaxf(rm, fmaxf(p0[i], p1[i]));
            rm = fmaxf(rm, __shfl_xor(rm, 32));
            if (t == 0) mref = rm == -INFINITY ? 0.f : rm;
            else if (__any(rm > mref + 8.f)) { const float mn = fmaxf(mref, rm), al = __builtin_amdgcn_exp2f(mref - mn); l *= al; mref = mn;
#pragma unroll
                for (int i = 0; i < 16; ++i) { o0[i] *= al; o1[i] *= al; } }
            float ls = 0.f;
#pragma unroll
            for (int i = 0; i < 16; ++i) { p0[i] = __builtin_amdgcn_exp2f(p0[i] - mref); p1[i] = __builtin_amdgcn_exp2f(p1[i] - mref); ls += p0[i] + p1[i]; }
            l += ls;
            const bf16x8 pb0 = pack8(p0, 0), pb1 = pack8(p0, 1), pb2 = pack8(p1, 0), pb3 = pack8(p1, 1);
            const LAS unsigned char* vb = lds + L_V + buf * VBUF;
#define PA_PV(PB, RB) do { const s16x4 l0 = vtr(vb + (RB) * VP + vo0), h0 = vtr(vb + ((RB) + 8) * VP + vo0), l1 = vtr(vb + (RB) * VP + vo1), h1 = vtr(vb + ((RB) + 8) * VP + vo1); \
                const bf16x8 a0 = __builtin_shufflevector(l0, h0, 0, 1, 2, 3, 4, 5, 6, 7), a1 = __builtin_shufflevector(l1, h1, 0, 1, 2, 3, 4, 5, 6, 7); \
                o0 = PA_MFMA(a0, PB, o0); o1 = PA_MFMA(a1, PB, o1); } while (0)
            PA_PV(pb0, 0); PA_PV(pb1, 16); PA_PV(pb2, 32); PA_PV(pb3, 48);
#undef PA_PV
        }
        if (t + 1 < NT) { const int nb = (buf ^ 1); *(LAS u32x4*)(lds + nb * VBUF + dV) = sV; *(LAS u32x4*)(lds + nb * KBUF + dK) = sK; if (tid < 256) *(LAS u32x4*)(lds + nb * KBUF + dR) = sR; }
        __syncthreads();
    }
    l += __shfl_xor(l, 32);
    const float il = 1.f / l;
    const size_t row = rowb + qg;
    const bf16* az = T.ZB + row * 3072 + ZAZ + h * 64 + 4 * hf; bf16* yo = T.YCAT + row * 1024 + 512 + h * 64 + 4 * hf;
#pragma unroll
    for (int d = 0; d < 2; ++d)
#pragma unroll
        for (int g = 0; g < 4; ++g) { const u32x2 a = *(const u32x2*)(az + 32 * d + 8 * g);
            const float z0 = bf2f((unsigned short)(a.x & 0xffff)), z1 = bf2f((unsigned short)(a.x >> 16)), z2 = bf2f((unsigned short)(a.y & 0xffff)), z3 = bf2f((unsigned short)(a.y >> 16));
            const f32x16& o = d == 0 ? o0 : o1;
            u32x2 r; r.x = cvtpk(o[4 * g] * il * siluf_(z0), o[4 * g + 1] * il * siluf_(z1)); r.y = cvtpk(o[4 * g + 2] * il * siluf_(z2), o[4 * g + 3] * il * siluf_(z3));
            *(u32x2*)(yo + 32 * d + 8 * g) = r; }
}
__device__ __forceinline__ void phase(LAS unsigned char* lds, const Tensors& T, int vcu, int G) {
    for (int v = vcu; v < 256; v += G) { const int bh = v >> 4, s = v & 15;
        unit(lds, T, bh >> 3, bh & 7, 31 - s); unit(lds, T, bh >> 3, bh & 7, s); }
}
}
struct PAArgs { pa::Tensors T; };
__global__ void __launch_bounds__(512, 2) k_attn_prompt(PAArgs a) {
    extern __shared__ __attribute__((aligned(16))) unsigned char lds[];
    pa::phase((LAS unsigned char*)lds, a.T, (int)blockIdx.x, (int)gridDim.x);
}
namespace sa {
typedef short bf16x8 __attribute__((ext_vector_type(8)));
typedef short s16x4 __attribute__((ext_vector_type(4)));
typedef float f32x16 __attribute__((ext_vector_type(16)));
typedef float f32x4 __attribute__((ext_vector_type(4)));
typedef unsigned u32x4 __attribute__((ext_vector_type(4)));
typedef unsigned u32x2 __attribute__((ext_vector_type(2)));
constexpr int NSPLIT = 2, PPS = NPAGES / NSPLIT;
constexpr int KP = 592, PP = 272;
constexpr int L_KT = 0, L_Q = 128 * KP, L_P = L_Q + 64 * KP, L_SMAX = L_P + 64 * PP, L_SSUM = L_SMAX + 4 * 64 * 4, LDS_BYTES = L_SSUM + 4 * 64 * 4;
using pa::cvtpk; using pa::vtr; using pa::crow;
#define SA_MFMA(a, b, c) __builtin_amdgcn_mfma_f32_32x32x16_bf16((a), (b), (c), 0, 0, 0)
struct Tensors { const bf16* Q96; const bf16* WUKB; const float* cache_ckv; const float* cache_kr; const int* page_table; const float* ckv_new; const bf16* KRB; const float* ropet;
                 float* PARTO; float* PARTML; };

__device__ __forceinline__ void unit(LAS unsigned char* lds, const Tensors& T, int b, int sp) {
    const int tid = threadIdx.x, lane = tid & 63, w = __builtin_amdgcn_readfirstlane(tid >> 6), q32 = lane & 31, hf = lane >> 5;
    __syncthreads();
    {   const int h = w;
        bf16x8 qb[4];
#pragma unroll
        for (int ks = 0; ks < 4; ++ks) { bf16x8 z = {0, 0, 0, 0, 0, 0, 0, 0}; qb[ks] = q32 < DS ? *(const bf16x8*)(T.Q96 + (size_t)(MP + b * DS + q32) * 768 + h * 96 + 16 * ks + 8 * hf) : z; }
#pragma unroll
        for (int cb = 0; cb < 8; ++cb) {
            f32x16 acc;
#pragma unroll
            for (int i = 0; i < 16; ++i) acc[i] = 0.f;
#pragma unroll
            for (int ks = 0; ks < 4; ++ks) { const bf16x8 a = *(const bf16x8*)(T.WUKB + (size_t)(32 * cb + q32) * 512 + h * 64 + 16 * ks + 8 * hf); acc = SA_MFMA(a, qb[ks], acc); }
            if (q32 < DS) {
#pragma unroll
                for (int g = 0; g < 4; ++g) { u32x2 r; r.x = cvtpk(acc[4 * g], acc[4 * g + 1]); r.y = cvtpk(acc[4 * g + 2], acc[4 * g + 3]);
                    *(LAS u32x2*)(lds + L_Q + (h * 8 + q32) * KP + (32 * cb + 8 * g + 4 * hf) * 2) = r; }
            }
        }
#pragma unroll
        for (int e = 0; e < 2; ++e) { const int id = tid + 512 * e, r = id >> 4, j = id & 15, hh = r >> 3, t = r & 7;
            const bf16* qs = T.Q96 + (size_t)(MP + b * DS + t) * 768 + hh * 96 + 64; const float* tb = T.ropet + (size_t)(PAST + t) * 32;
            const float x1 = bf2f(qs[j]), x2 = bf2f(qs[16 + j]), cs = tb[j], sn = tb[16 + j];
            *(LAS unsigned short*)(lds + L_Q + r * KP + (256 + j) * 2) = f2bf(x1 * cs - x2 * sn); *(LAS unsigned short*)(lds + L_Q + r * KP + (272 + j) * 2) = f2bf(x2 * cs + x1 * sn); }
    }
    f32x4 st[18];
    const int pg0 = sp * PPS;
    auto issue = [&](int page) {
        const int phys = T.page_table[b * NPAGES + page];
        const float* gc = T.cache_ckv + (size_t)phys * (PAGE * KVL) + tid * 4; const float* gr = T.cache_kr + (size_t)phys * (PAGE * ROPE) + tid * 4;
#pragma unroll
        for (int j = 0; j < 16; ++j) st[j] = __builtin_nontemporal_load((const f32x4*)(gc + j * 2048));
#pragma unroll
        for (int j = 0; j < 2; ++j) st[16 + j] = __builtin_nontemporal_load((const f32x4*)(gr + j * 2048));
    };
    issue(pg0);
    f32x16 o0, o1;
#pragma unroll
    for (int i = 0; i < 16; ++i) { o0[i] = 0.f; o1[i] = 0.f; }
    float mrun0 = -INFINITY, mrun1 = -INFINITY, lrun0 = 0.f, lrun1 = 0.f;
    const int kvb = w >> 1, qbk = w & 1;
    const int i16 = lane & 15, q4 = i16 >> 2, p4 = i16 & 3, blk = (lane >> 4) & 1;
    const int vo = (8 * hf + q4) * KP + 64 * w + 32 * blk + 8 * p4;
    const bool has_tail = (sp == NSPLIT - 1);
    const int niter = PPS + (has_tail ? 1 : 0);
    for (int it = 0; it < niter; ++it) {
        const bool tail = (it == PPS);
        const int nblk = tail ? 1 : 4;
        __syncthreads();
        if (!tail) {
#pragma unroll
            for (int j = 0; j < 16; ++j) { const int id = tid + 512 * j, r = id >> 6, c = (id & 63) * 4; u32x2 v; v.x = cvtpk(st[j][0], st[j][1]); v.y = cvtpk(st[j][2], st[j][3]);
                *(LAS u32x2*)(lds + L_KT + r * KP + c * 2) = v; }
#pragma unroll
            for (int j = 0; j < 2; ++j) { const int id = tid + 512 * j, r = id >> 3, c = 256 + (id & 7) * 4; u32x2 v; v.x = cvtpk(st[16 + j][0], st[16 + j][1]); v.y = cvtpk(st[16 + j][2], st[16 + j][3]);
                *(LAS u32x2*)(lds + L_KT + r * KP + c * 2) = v; }
        } else {
            for (int id = tid; id < 32 * 72; id += 512) { const int r = id / 72, c4 = (id % 72) * 4; u32x2 v = {0u, 0u};
                if (r < DS) { if (c4 < KVL) { const f32x4 x = *(const f32x4*)(T.ckv_new + (size_t)(b * DS + r) * KVL + c4); v.x = cvtpk(x[0], x[1]); v.y = cvtpk(x[2], x[3]); }
                              else v = *(const u32x2*)(T.KRB + (size_t)(MP + b * DS + r) * ROPE + (c4 - KVL)); }
                *(LAS u32x2*)(lds + L_KT + r * KP + c4 * 2) = v; }
        }
        __syncthreads();
        if (it + 1 < PPS) issue(pg0 + it + 1);
        f32x16 s;
        float lmax = -INFINITY;
        if (kvb < nblk) {
#pragma unroll
            for (int i = 0; i < 16; ++i) s[i] = 0.f;
            const LAS unsigned char* ka = lds + L_KT + (32 * kvb + q32) * KP + hf * 16; const LAS unsigned char* qa = lds + L_Q + (32 * qbk + q32) * KP + hf * 16;
#pragma unroll
            for (int ks = 0; ks < 18; ++ks) s = SA_MFMA(*(const LAS bf16x8*)(ka + ks * 32), *(const LAS bf16x8*)(qa + ks * 32), s);
            if (tail) {
#pragma unroll
                for (int i = 0; i < 16; ++i) if (crow(i, hf) > (q32 & 7)) s[i] = -INFINITY;
            }
#pragma unroll
            for (int i = 0; i < 16; ++i) lmax = fmaxf(lmax, s[i]);
            lmax = fmaxf(lmax, __shfl_xor(lmax, 32));
        }
        if (hf == 0) *(LAS float*)(lds + L_SMAX + (kvb * 64 + 32 * qbk + q32) * 4) = lmax;
        __syncthreads();
        float tm0 = -INFINITY, tm1 = -INFINITY;
#pragma unroll
        for (int k = 0; k < 4; ++k) { tm0 = fmaxf(tm0, *(const LAS float*)(lds + L_SMAX + (k * 64 + q32) * 4)); tm1 = fmaxf(tm1, *(const LAS float*)(lds + L_SMAX + (k * 64 + 32 + q32) * 4)); }
        const float mn0 = fmaxf(mrun0, tm0), mn1 = fmaxf(mrun1, tm1);
        const float al0 = __builtin_amdgcn_exp2f(mrun0 - mn0), al1 = __builtin_amdgcn_exp2f(mrun1 - mn1);
        mrun0 = mn0; mrun1 = mn1;
        float lsum = 0.f;
        if (kvb < nblk) {
            const float mn = qbk ? mn1 : mn0;
#pragma unroll
            for (int i = 0; i < 16; ++i) { s[i] = __builtin_amdgcn_exp2f(s[i] - mn); lsum += s[i]; }
            lsum += __shfl_xor(lsum, 32);
#pragma unroll
            for (int g = 0; g < 4; ++g) { u32x2 r; r.x = cvtpk(s[4 * g], s[4 * g + 1]); r.y = cvtpk(s[4 * g + 2], s[4 * g + 3]);
                *(LAS u32x2*)(lds + L_P + (32 * qbk + q32) * PP + (32 * kvb + 8 * g + 4 * hf) * 2) = r; }
        }
        if (hf == 0) *(LAS float*)(lds + L_SSUM + (kvb * 64 + 32 * qbk + q32) * 4) = lsum;
        __syncthreads();
        float ts0 = 0.f, ts1 = 0.f;
#pragma unroll
        for (int k = 0; k < 4; ++k) { ts0 += *(const LAS float*)(lds + L_SSUM + (k * 64 + q32) * 4); ts1 += *(const LAS float*)(lds + L_SSUM + (k * 64 + 32 + q32) * 4); }
        lrun0 = lrun0 * al0 + ts0; lrun1 = lrun1 * al1 + ts1;
#pragma unroll
        for (int i = 0; i < 16; ++i) { o0[i] *= al0; o1[i] *= al1; }
        const LAS unsigned char* vb = lds + L_KT + vo; const LAS unsigned char* pb = lds + L_P + q32 * PP + hf * 16;
        const int nks = 2 * nblk;
#pragma unroll 2
        for (int ks = 0; ks < nks; ++ks) {
            const s16x4 lo = vtr(vb + (16 * ks) * KP), hi = vtr(vb + (16 * ks + 4) * KP);
            const bf16x8 a = __builtin_shufflevector(lo, hi, 0, 1, 2, 3, 4, 5, 6, 7);
            o0 = SA_MFMA(a, *(const LAS bf16x8*)(pb + ks * 32), o0); o1 = SA_MFMA(a, *(const LAS bf16x8*)(pb + 32 * PP + ks * 32), o1);
        }
    }
    float* po = T.PARTO + (size_t)(b * NSPLIT + sp) * 64 * KVL;
#pragma unroll
    for (int g = 0; g < 4; ++g) {
        *(f32x4*)(po + (size_t)q32 * KVL + 32 * w + 8 * g + 4 * hf) = (f32x4){o0[4 * g], o0[4 * g + 1], o0[4 * g + 2], o0[4 * g + 3]};
        *(f32x4*)(po + (size_t)(32 + q32) * KVL + 32 * w + 8 * g + 4 * hf) = (f32x4){o1[4 * g], o1[4 * g + 1], o1[4 * g + 2], o1[4 * g + 3]};
    }
    if (w == 0 && hf == 0) { float* pm = T.PARTML + (size_t)(b * NSPLIT + sp) * 128; pm[q32] = mrun0; pm[32 + q32] = mrun1; pm[64 + q32] = lrun0; pm[96 + q32] = lrun1; }
}
__device__ __forceinline__ void phase(LAS unsigned char* lds, const Tensors& T, int vcu, int G) {
    for (int v = vcu; v < DB * NSPLIT; v += G) unit(lds, T, v / NSPLIT, v % NSPLIT);
}
}
struct SAArgs { sa::Tensors T; };
__global__ void __launch_bounds__(512, 2) k_attn_sample(SAArgs a) {
    extern __shared__ __attribute__((aligned(16))) unsigned char lds[];
    sa::phase((LAS unsigned char*)lds, a.T, (int)blockIdx.x, (int)gridDim.x);
}
__global__ void __launch_bounds__(512) k_scomb(const float* __restrict__ PARTO, const float* __restrict__ PARTML, const float* __restrict__ w_uv, float* __restrict__ OMLA) {
    __shared__ float os[MH * KVL];
    const int ms = blockIdx.x, b = ms >> 3, t = ms & 7, tid = threadIdx.x, h = tid >> 6;
    for (int e = tid; e < MH * KVL; e += 512) { const int hh = e >> 8, c = e & 255, q = hh * 8 + t;
        float mm = -INFINITY;
        for (int sp = 0; sp < sa::NSPLIT; ++sp) mm = fmaxf(mm, PARTML[(size_t)(b * sa::NSPLIT + sp) * 128 + q]);
        float num = 0.f, den = 0.f;
        for (int sp = 0; sp < sa::NSPLIT; ++sp) { const float* pm = PARTML + (size_t)(b * sa::NSPLIT + sp) * 128; const float f = exp2f(pm[q] - mm);
            num += f * PARTO[((size_t)(b * sa::NSPLIT + sp) * 64 + q) * KVL + c]; den += f * pm[64 + q]; }
        os[e] = num / den; }
    __syncthreads();
    float acc = 0.f;
    for (int c = 0; c < KVL; ++c) acc += os[h * KVL + c] * w_uv[(size_t)c * 512 + tid];
    OMLA[(size_t)(MP + ms) * 512 + tid] = acc;
}

static void launch_gemm(const bf16* A, const bf16* Bt, float* C, int M, int N, int K, int ldc, hipStream_t stream) {
    GemmArgs a{}; a.A = A; a.Bt = Bt; a.C = C; a.M = M; a.N = N; a.K = K; a.ldc = ldc;
    hipLaunchKernelGGL(k_gemm_f32, dim3(256), dim3(512), pg8::STAGE_BYTES, stream, a);
}
extern "C" void kernel_launch(void* const* d_in, const int* in_sizes, int n_in, void* d_out, int out_size, void* d_ws, size_t ws_size, hipStream_t stream) {
    static int ready = 0;
    if (ready == 0) {
        if (n_in != 24 || out_size != (int)O_END || ws_size < WS_END) { fprintf(stderr, "kernel_launch: unexpected shapes: n_in %d out %d ws %zu\n", n_in, out_size, ws_size); ready = -1; return; }
        const void* gk[4] = {(const void*)k_gemm_f32, (const void*)k_gemm_inproj, (const void*)k_gemm_q, (const void*)k_gemm_kv};
        if (hipFuncSetAttribute((const void*)k_attn_sample, hipFuncAttributeMaxDynamicSharedMemorySize, sa::LDS_BYTES) != hipSuccess) { fprintf(stderr, "kernel_launch: hipFuncSetAttribute failed\n"); ready = -1; return; }
        for (int i = 0; i < 4; ++i) if (hipFuncSetAttribute(gk[i], hipFuncAttributeMaxDynamicSharedMemorySize, pg8::STAGE_BYTES) != hipSuccess) { fprintf(stderr, "kernel_launch: hipFuncSetAttribute failed\n"); ready = -1; return; }
        ready = 1;
    }
    if (ready < 0) return;
    const float* xp = (const float*)d_in[0]; const float* xs = (const float*)d_in[1]; const float* cp = (const float*)d_in[2]; const float* cs = (const float*)d_in[3];
    const float* cache_ckv = (const float*)d_in[4]; const float* cache_kr = (const float*)d_in[5]; const float* st_C = (const float*)d_in[6]; const float* st_n = (const float*)d_in[7]; const float* st_m = (const float*)d_in[8];
    const int* page_table = (const int*)d_in[9];
    const float* w_ada = (const float*)d_in[10]; const float* b_ada = (const float*)d_in[11]; const float* w_in = (const float*)d_in[12]; const float* b_i = (const float*)d_in[13]; const float* b_f = (const float*)d_in[14];
    const float* ml_gn = (const float*)d_in[15]; const float* qnorm = (const float*)d_in[16]; const float* kvnorm = (const float*)d_in[17]; const float* w_uq = (const float*)d_in[18]; const float* w_uk = (const float*)d_in[19];
    const float* w_uv = (const float*)d_in[20]; const float* w_out = (const float*)d_in[21]; const float* ln_g = (const float*)d_in[22]; const float* ln_b = (const float*)d_in[23];
    float* out = (float*)d_out; unsigned char* ws = (unsigned char*)d_ws;
    float* MOD = (float*)(ws + WS_MOD); float* ROPET = (float*)(ws + WS_ROPET); bf16* WIN = (bf16*)(ws + WS_WIN); bf16* WUQ = (bf16*)(ws + WS_WUQ); bf16* WKV = (bf16*)(ws + WS_WKV); bf16* WOUT = (bf16*)(ws + WS_WOUT);
    bf16* H = (bf16*)(ws + WS_H); bf16* ZB = (bf16*)(ws + WS_ZB); float* GATES = (float*)(ws + WS_GATES); bf16* CKVR = (bf16*)(ws + WS_CKVR); bf16* CQR = (bf16*)(ws + WS_CQR);
    float* SSKV = (float*)(ws + WS_SSKV); float* SSQ = (float*)(ws + WS_SSQ); bf16* KRB = (bf16*)(ws + WS_KRB); bf16* Q96 = (bf16*)(ws + WS_Q96); bf16* KVB = (bf16*)(ws + WS_KVB);
    float* PARTO = (float*)(ws + WS_PARTO); float* PARTML = (float*)(ws + WS_PARTML); bf16* WUKB = (bf16*)(ws + WS_WUKB);
    float* QLAT = (float*)(ws + WS_QLAT); float* OLAT = (float*)(ws + WS_OLAT); float* OMLA = (float*)(ws + WS_OMLA);
    float* HML = (float*)(ws + WS_HML); float* MLG = (float*)(ws + WS_MLG); float* MLU = (float*)(ws + WS_MLU); float* MLDC = (float*)(ws + WS_MLDC); float* MLDN = (float*)(ws + WS_MLDN);
    float* MLCS = (float*)(ws + WS_MLCS); float* MLNS = (float*)(ws + WS_MLNS); float* MLMS = (float*)(ws + WS_MLMS); bf16* YCAT = (bf16*)(ws + WS_YCAT); float* OUT = (float*)(ws + WS_OUT);

    hipLaunchKernelGGL(k_mod, dim3(12, 10), dim3(256), 0, stream, cp, cs, w_ada, b_ada, MOD);
    hipLaunchKernelGGL(k_ropetab, dim3(((PAST + DS) * 16 + 255) / 256), dim3(256), 0, stream, ROPET);
    hipLaunchKernelGGL(k_wt, dim3(D / 32, NINP / 32), dim3(32, 8), 0, stream, w_in, NIN, D, WIN, 1, (const float*)nullptr);
    hipLaunchKernelGGL(k_wt, dim3(QL / 32, (MH * QHD) / 32), dim3(32, 8), 0, stream, w_uq, MH * QHD, QL, WUQ, 0, qnorm);
    hipLaunchKernelGGL(k_wt, dim3(KVL / 32, 512 / 32), dim3(32, 8), 0, stream, w_uk, 512, KVL, WKV, 0, kvnorm);
    hipLaunchKernelGGL(k_wt, dim3(KVL / 32, 512 / 32), dim3(32, 8), 0, stream, w_uv, 512, KVL, WKV + (size_t)512 * KVL, 0, kvnorm);
    hipLaunchKernelGGL(k_wt, dim3(D / 32, D / 32), dim3(32, 8), 0, stream, w_out, D, D, WOUT, 0, (const float*)nullptr);
    hipLaunchKernelGGL(k_cvt, dim3(KVL * 512 / 4 / 256), dim3(256), 0, stream, w_uk, WUKB, KVL * 512 / 4);
    hipLaunchKernelGGL(k_hprep, dim3(MT), dim3(256), 0, stream, xp, xs, MOD, H);
    { InProjArgs a{}; a.A = H; a.Bt = WIN; a.E.ZB = ZB; a.E.CKVR = CKVR; a.E.CQR = CQR; a.E.SSKV = SSKV; a.E.SSQ = SSQ; a.E.GATES = GATES; a.E.KRB = KRB; a.E.out_krp = out + O_KRP; a.E.out_krs = out + O_KRS; a.E.ropet = ROPET;
      hipLaunchKernelGGL(k_gemm_inproj, dim3(256), dim3(512), pg8::STAGE_BYTES, stream, a); }
    { QArgs a{}; a.A = CQR; a.Bt = WUQ; a.E.Q96 = Q96; a.E.SSQ = SSQ; a.E.qscale = MLA_SCALE * LOG2E;
      hipLaunchKernelGGL(k_gemm_q, dim3(256), dim3(512), pg8::STAGE_BYTES, stream, a); }
    { KVArgs a{}; a.A = CKVR; a.Bt = WKV; a.E.KVB = KVB; a.E.SSKV = SSKV;
      hipLaunchKernelGGL(k_gemm_kv, dim3(256), dim3(512), pg8::STAGE_BYTES, stream, a); }
    hipLaunchKernelGGL(k_rows_ckv, dim3(MT / 4), dim3(256), 0, stream, CKVR, SSKV, kvnorm, out);
    { PAArgs a{}; a.T.Q96 = Q96; a.T.KVB = KVB; a.T.KRB = KRB; a.T.ZB = ZB; a.T.ropet = ROPET; a.T.YCAT = YCAT;
      hipLaunchKernelGGL(k_attn_prompt, dim3(256), dim3(512), pa::LDS_BYTES, stream, a); }
    { SAArgs a{}; a.T.Q96 = Q96; a.T.WUKB = WUKB; a.T.cache_ckv = cache_ckv; a.T.cache_kr = cache_kr; a.T.page_table = page_table; a.T.ckv_new = out + O_CKVS; a.T.KRB = KRB; a.T.ropet = ROPET;
      a.T.PARTO = PARTO; a.T.PARTML = PARTML;
      hipLaunchKernelGGL(k_attn_sample, dim3(256), dim3(512), sa::LDS_BYTES, stream, a); }
    hipLaunchKernelGGL(k_scomb, dim3(MS), dim3(512), 0, stream, PARTO, PARTML, w_uv, OMLA);
    hipLaunchKernelGGL(k_ml_a, dim3(BP * LH * NCH), dim3(256), 0, stream, ZB, GATES, b_i, b_f, MLG, MLU, MLDC, MLDN);
    hipLaunchKernelGGL(k_ml_b, dim3(BP * LH * (DK * DV + DK) / 256), dim3(256), 0, stream, MLG, MLU, MLDC, MLDN, MLCS, MLNS, MLMS, out);
    hipLaunchKernelGGL(k_ml_c, dim3(BP * LH * NCH), dim3(256), 0, stream, ZB, GATES, b_i, b_f, MLCS, MLNS, MLMS, HML);
    hipLaunchKernelGGL(k_ml_sample, dim3(DB * LH), dim3(256), 0, stream, ZB, GATES, b_i, b_f, st_C, st_n, st_m, HML, out);
    hipLaunchKernelGGL(k_back_rows, dim3(MT / 4), dim3(256), 0, stream, ZB, HML, OMLA, ml_gn, YCAT);
    launch_gemm(YCAT, WOUT, OUT, MT, D, D, D, stream);
    hipLaunchKernelGGL(k_final_ln, dim3(MT / 4), dim3(256), 0, stream, xp, xs, MOD, OUT, ln_g, ln_b, out);
}
```

```cpp
#include <hip/hip_runtime.h>
#include <cstdio>
#include <cstdint>
#include <cmath>

constexpr int D = 1024, BP = 2, SP = 8192, MP = BP * SP, DB = 128, DS = 8, MS = DB * DS, MT = MP + MS;
constexpr int NIN = 3752, NINP = 3840;
constexpr int QL = 384, KVL = 256, ROPE = 32, NOPE = 64, MH = 8, VD = 64, QHD = NOPE + ROPE;
constexpr int LH = 4, DK = 128, DV = 128, LC = 128, NCH = SP / LC;
constexpr int PAGE = 128, NPAGES = 64, PAST = 8192;
constexpr float EPS = 1e-6f, ALPHA = 1.189207115002721f, MLA_SCALE = 0.10206207261596575f  , KSCALE = 0.08838834764831845f  ;
constexpr int ZQ = 0, ZK = 512, ZV = 1024, ZO = 1536, ZZ = 2048, ZAZ = 2560, ZCKV = 3072, ZCQ = 3328, ZKR = 3712, ZMI = 3744, ZMF = 3748;
constexpr size_t O_YP = 0, O_YS = 16777216, O_CKVP = 17825792, O_KRP = 22020096, O_CP = 22544384, O_NP = 22675456, O_MPR = 22676480,
                 O_CKVS = 22676488, O_KRS = 22938632, O_CS = 22971400, O_NS = 31360008, O_MS = 31425544, O_END = 31426056;
constexpr size_t MiB = 1u << 20;
constexpr size_t WS_CTL = 0, WS_MOD = 1 * MiB, WS_ROPET = 260 * MiB, WS_WIN = 4 * MiB, WS_WUQ = 12 * MiB, WS_WKV = 13 * MiB, WS_WOUT = 14 * MiB, WS_H = 16 * MiB,
                 WS_ZB = 64 * MiB  , WS_GATES = 168 * MiB, WS_CKVR = 170 * MiB  , WS_CQR = 180 * MiB  , WS_SSKV = 194 * MiB, WS_SSQ = 195 * MiB,
                 WS_KRB = 196 * MiB  , WS_Q96 = 198 * MiB  , WS_KVB = 224 * MiB  , WS_QLAT = 484 * MiB,
                 WS_OLAT = 492 * MiB, WS_OMLA = 500 * MiB, WS_HML = 536 * MiB, WS_MLG = 572 * MiB, WS_MLU = 573 * MiB, WS_MLDC = 576 * MiB, WS_MLDN = 608 * MiB,
                 WS_MLCS = 612 * MiB, WS_MLNS = 644 * MiB, WS_MLMS = 646 * MiB, WS_YCAT = 648 * MiB, WS_OUT = 684 * MiB, WS_PARTO = 760 * MiB, WS_PARTML = 780 * MiB, WS_WUKB = 262 * MiB, WS_END = 784 * MiB;
constexpr float LOG2E = 1.4426950408889634f;

__host__ __device__ __forceinline__ int zsrc(int j) {
    if (j < 1536) return j;
    if (j < 2560) return j + 8;
    if (j < 3072) return 3240 + (j - 2560);
    if (j < 3328) return 2952 + (j - 3072);
    if (j < 3712) return 2568 + (j - 3328);
    if (j < 3744) return 3208 + (j - 3712);
    if (j < 3752) return 1536 + (j - 3744);
    return -1;
}
__device__ __forceinline__ unsigned short f2bf(float f) { unsigned u = __builtin_bit_cast(unsigned, f); return (unsigned short)((u + 0x7fffu + ((u >> 16) & 1u)) >> 16); }
__device__ __forceinline__ float bf2f(unsigned short h) { return __builtin_bit_cast(float, (unsigned)h << 16); }
__device__ __forceinline__ float wave_sum(float v) {
#pragma unroll
    for (int o = 1; o < 64; o <<= 1) v += __shfl_xor(v, o);
    return v;
}
__device__ __forceinline__ float wave_max(float v) {
#pragma unroll
    for (int o = 1; o < 64; o <<= 1) v = fmaxf(v, __shfl_xor(v, o));
    return v;
}
__device__ __forceinline__ float sigmoidf_(float x) { return 1.f / (1.f + __expf(-x)); }
__device__ __forceinline__ float siluf_(float x) { return x / (1.f + __expf(-x)); }
__device__ __forceinline__ float logsigmoidf_(float x) { return x >= 0.f ? -log1pf(expf(-x)) : x - log1pf(expf(x)); }
__device__ __forceinline__ int row_pos(int m) { return m < MP ? (m & (SP - 1)) : PAST + ((m - MP) & (DS - 1)); }
__device__ __forceinline__ int row_modrow(int m) { return m < MP ? (m >> 13) : 2 + ((m - MP) >> 3); }
namespace pg8 {
#define PG8_LAS __attribute__((address_space(3)))
typedef unsigned short bf16_t;
typedef short bf16x8 __attribute__((ext_vector_type(8)));
typedef float f32x4 __attribute__((ext_vector_type(4)));
typedef unsigned u32x4 __attribute__((ext_vector_type(4)));
constexpr int BM = 256, BK = 64, HALF = 128, HTB = HALF * BK * 2  , STAGE_BYTES = 8 * HTB, NXCD = 8, WGM = 8;

__host__ __device__ __forceinline__ int lds_byte(int r, int c) { const int st = (r >> 4) * 2 + (c >> 5), rr = r & 15, cc = c & 31, ob = rr * 64 + cc * 2; return st * 1024 + (ob ^ (((ob >> 9) & 1) << 5)); }
__host__ __device__ __forceinline__ void stage_rc(int b, int& R, int& C) { const int st = b / 1024, sb = b % 1024, swz = sb ^ (((sb >> 9) & 1) << 5); R = (st >> 1) * 16 + swz / 64; C = (st & 1) * 32 + (swz % 64) / 2; }
__host__ __device__ __forceinline__ int perm32(int rho) { const int n = rho >> 4, i = rho & 15; return 8 * (i >> 2) + 4 * n + (i & 3); }

struct Unit { int pm, pn; };
struct Gemm { const bf16_t* A; const bf16_t* Bt; int M, N, K; };

struct StaticOrder {
    int nM, nN, nwg, G, c;
    __host__ __device__ void init(int M, int N, int G_, int c_) { nM = M / BM; nN = N / BM; nwg = nM * nN; G = G_; c = c_; }
    __host__ __device__ bool next(int i, Unit& u) const {
        const long L = (long)i * G + c; if (L >= nwg) return false;
        int wgid = (int)L; { const int q = nwg / NXCD, r = nwg % NXCD, xcd = wgid % NXCD, off = wgid / NXCD; wgid = (xcd < r ? xcd * (q + 1) : r * (q + 1) + (xcd - r) * q) + off; }
        const int nig = WGM * nN, gid = wgid / nig, fm = gid * WGM, gsz = (nM - fm) < WGM ? (nM - fm) : WGM;
        u.pm = fm + ((wgid % nig) % gsz); u.pn = (wgid % nig) / gsz; return true;
    }
    __device__ __forceinline__ void a_ready(const Unit&) const {}
    __device__ __forceinline__ void done(const Unit&) const {}
};

__device__ __forceinline__ unsigned cvt_pk_bf16(float lo, float hi) { unsigned r; asm volatile("v_cvt_pk_bf16_f32 %0, %1, %2" : "=v"(r) : "v"(lo), "v"(hi)); return r; }
__device__ __forceinline__ u32x4 pack8(const f32x4& v0, const f32x4& v1) { u32x4 w; w.x = cvt_pk_bf16(v0[0], v0[1]); w.y = cvt_pk_bf16(v0[2], v0[3]); w.z = cvt_pk_bf16(v1[0], v1[1]); w.w = cvt_pk_bf16(v1[2], v1[3]); return w; }
__device__ __forceinline__ float sq8(const f32x4& a, const f32x4& b) { return (a[0] * a[0] + a[1] * a[1]) + (a[2] * a[2] + a[3] * a[3]) + (b[0] * b[0] + b[1] * b[1]) + (b[2] * b[2] + b[3] * b[3]); }
__device__ __forceinline__ int epi_row_pos(int m) { return m < 16384 ? (m & 8191) : 8192 + ((m - 16384) & 7); }
__device__ __forceinline__ void rope8(f32x4& v0, f32x4& v1, const float* tab, int fq) {
    const int j0 = 8 * (fq & 1);
    const f32x4 c0 = *(const f32x4*)(tab + j0), c1 = *(const f32x4*)(tab + j0 + 4), s0 = *(const f32x4*)(tab + 16 + j0), s1 = *(const f32x4*)(tab + 16 + j0 + 4);
    f32x4 o0, o1;
#pragma unroll
    for (int i = 0; i < 4; ++i) { o0[i] = __shfl_xor(v0[i], 32); o1[i] = __shfl_xor(v1[i], 32); }
    if (fq < 2) { v0 = v0 * c0 - o0 * s0; v1 = v1 * c1 - o1 * s1; } else { v0 = v0 * c0 + o0 * s0; v1 = v1 * c1 + o1 * s1; }
}
struct EpiInProj {
    static constexpr bool PERM = true, AFTER_DRAIN = false;
    bf16_t* ZB; bf16_t* CKVR; bf16_t* CQR; float* SSKV; float* SSQ; float* GATES; bf16_t* KRB; float* out_krp; float* out_krs; const float* ropet;
    __device__ __forceinline__ void operator()(const f32x4 (&acc)[2][2][4][2], const Unit& u, int wr, int wc, int fr, int fq) const {
        const int row0 = u.pm * BM + wr * 64 + fr, cw = wc * 32 + 8 * fq;
        if (u.pn < 12) {
#pragma unroll
            for (int ai = 0; ai < 2; ++ai)
#pragma unroll
                for (int m = 0; m < 4; ++m) { bf16_t* rowp = ZB + (size_t)(row0 + ai * HALF + m * 16) * 3072 + u.pn * BM + cw;
#pragma unroll
                    for (int bj = 0; bj < 2; ++bj) *(u32x4*)(rowp + bj * HALF) = pack8(acc[ai][bj][m][0], acc[ai][bj][m][1]); }
        } else if (u.pn < 14) {
            bf16_t* dst = u.pn == 12 ? CKVR : CQR; const int ld = u.pn == 12 ? 256 : 384; float* ss = u.pn == 12 ? SSKV : SSQ; const int ssl = u.pn == 12 ? 4 : 8;
#pragma unroll
            for (int ai = 0; ai < 2; ++ai)
#pragma unroll
                for (int m = 0; m < 4; ++m) { const int row = row0 + ai * HALF + m * 16; bf16_t* rowp = dst + (size_t)row * ld + cw;
                    float s = 0.f;
#pragma unroll
                    for (int bj = 0; bj < 2; ++bj) { *(u32x4*)(rowp + bj * HALF) = pack8(acc[ai][bj][m][0], acc[ai][bj][m][1]); s += sq8(acc[ai][bj][m][0], acc[ai][bj][m][1]); }
                    s += __shfl_xor(s, 16); s += __shfl_xor(s, 32);
                    if (fq == 0) ss[(size_t)row * ssl + wc] = s; }
        } else {
#pragma unroll
            for (int ai = 0; ai < 2; ++ai)
#pragma unroll
                for (int m = 0; m < 4; ++m) { const int row = row0 + ai * HALF + m * 16;
                    *(u32x4*)(CQR + (size_t)row * 384 + 256 + cw) = pack8(acc[ai][0][m][0], acc[ai][0][m][1]);
                    float s = sq8(acc[ai][0][m][0], acc[ai][0][m][1]);
                    s += __shfl_xor(s, 16); s += __shfl_xor(s, 32);
                    if (fq == 0) SSQ[(size_t)row * 8 + 4 + wc] = s;
                    if (wc == 0) {
                        f32x4 v0 = acc[ai][1][m][0], v1 = acc[ai][1][m][1];
                        rope8(v0, v1, ropet + (size_t)epi_row_pos(row) * 32, fq);
                        float* o = row < 16384 ? out_krp + (size_t)row * 32 : out_krs + (size_t)(row - 16384) * 32;
                        *(f32x4*)(o + 8 * fq) = v0; *(f32x4*)(o + 8 * fq + 4) = v1;
                        *(u32x4*)(KRB + (size_t)row * 32 + 8 * fq) = pack8(v0, v1);
                    } else if (wc == 1 && fq == 0) {
                        *(f32x4*)(GATES + (size_t)row * 8) = acc[ai][1][m][0]; *(f32x4*)(GATES + (size_t)row * 8 + 4) = acc[ai][1][m][1];
                    } }
        }
    }
    __device__ __forceinline__ void fused(f32x4 (&)[2][2][4][2], const Unit&, int, int, int, int, PG8_LAS unsigned char*, int, int) const {}
};
struct EpiQ {
    static constexpr bool PERM = true, AFTER_DRAIN = false;
    bf16_t* Q96; const float* SSQ; float qscale;
    __device__ __forceinline__ void operator()(const f32x4 (&acc)[2][2][4][2], const Unit& u, int wr, int wc, int fr, int fq) const {
        const int row0 = u.pm * BM + wr * 64 + fr, cw = wc * 32 + 8 * fq;
#pragma unroll
        for (int ai = 0; ai < 2; ++ai)
#pragma unroll
            for (int m = 0; m < 4; ++m) { const int row = row0 + ai * HALF + m * 16;
                const f32x4 p0 = *(const f32x4*)(SSQ + (size_t)row * 8), p1 = *(const f32x4*)(SSQ + (size_t)row * 8 + 4);
                const float ssum = ((p0[0] + p0[1]) + (p0[2] + p0[3])) + ((p1[0] + p1[1]) + (p1[2] + p1[3]));
                const float rs = __builtin_amdgcn_rsqf(ssum * (1.0f / 384.0f) + 1e-6f) * qscale;
#pragma unroll
                for (int bj = 0; bj < 2; ++bj) *(u32x4*)(Q96 + (size_t)row * 768 + u.pn * BM + bj * HALF + cw) = pack8(acc[ai][bj][m][0] * rs, acc[ai][bj][m][1] * rs); }
    }
    __device__ __forceinline__ void fused(f32x4 (&)[2][2][4][2], const Unit&, int, int, int, int, PG8_LAS unsigned char*, int, int) const {}
};
struct EpiKV {
    static constexpr bool PERM = true, AFTER_DRAIN = false;
    bf16_t* KVB; const float* SSKV;
    __device__ __forceinline__ void operator()(const f32x4 (&acc)[2][2][4][2], const Unit& u, int wr, int wc, int fr, int fq) const {
        const int row0 = u.pm * BM + wr * 64 + fr, cw = wc * 32 + 8 * fq;
#pragma unroll
        for (int ai = 0; ai < 2; ++ai)
#pragma unroll
            for (int m = 0; m < 4; ++m) { const int row = row0 + ai * HALF + m * 16;
                const f32x4 p0 = *(const f32x4*)(SSKV + (size_t)row * 4);
                const float rs = __builtin_amdgcn_rsqf(((p0[0] + p0[1]) + (p0[2] + p0[3])) * (1.0f / 256.0f) + 1e-6f);
#pragma unroll
                for (int bj = 0; bj < 2; ++bj) *(u32x4*)(KVB + (size_t)row * 1024 + u.pn * BM + bj * HALF + cw) = pack8(acc[ai][bj][m][0] * rs, acc[ai][bj][m][1] * rs); }
    }
    __device__ __forceinline__ void fused(f32x4 (&)[2][2][4][2], const Unit&, int, int, int, int, PG8_LAS unsigned char*, int, int) const {}
};
struct EpiF32 {
    static constexpr bool PERM = false, AFTER_DRAIN = false;
    float* C; int ldc;
    __device__ __forceinline__ void operator()(const f32x4 (&acc)[2][2][4][2], const Unit& u, int wr, int wc, int fr, int fq) const {
        const int row0 = u.pm * BM + wr * 64 + fr, col0 = u.pn * BM + wc * 32 + 4 * fq;
#pragma unroll
        for (int ai = 0; ai < 2; ++ai)
#pragma unroll
            for (int m = 0; m < 4; ++m) { float* rowp = C + (size_t)(row0 + ai * HALF + m * 16) * ldc + col0;
#pragma unroll
                for (int bj = 0; bj < 2; ++bj)
#pragma unroll
                    for (int n = 0; n < 2; ++n) *(f32x4*)(rowp + bj * HALF + n * 16) = acc[ai][bj][m][n]; }
    }
    __device__ __forceinline__ void fused(f32x4 (&)[2][2][4][2], const Unit&, int, int, int, int, PG8_LAS unsigned char*, int, int) const {}
};
template <class Epi, class Sched, bool ALIGN_EPI = false, bool SP2 = false>
__device__ __forceinline__ void gemm_phase(PG8_LAS unsigned char* lds, const Gemm g, const Sched& S, const Epi& E) {
    const int tid = threadIdx.x, wid = __builtin_amdgcn_readfirstlane(tid >> 6), lane = tid & 63, wr = wid >> 2, wc = wid & 3, fr = lane & 15, fq = lane >> 4;
    const int K = g.K, nt = K / BK;
    unsigned voffA[2], voffB[2];
#pragma unroll
    for (int i = 0; i < 2; ++i) { int R, C; stage_rc(tid * 16 + i * 8192, R, C); const int Rb = Epi::PERM ? ((R & ~31) + perm32(R & 31)) : R;
        voffA[i] = (unsigned)(R * K + C) * 2u; voffB[i] = (unsigned)(Rb * K + C) * 2u; }
    const size_t kstep = (size_t)(BK * 2);
    const size_t hstep = (size_t)HALF * K * 2;
    const size_t tstep = 2 * hstep;
    const unsigned ldsw = (unsigned)wid * 1024u;
    const int aoff = lds_byte(wr * 64 + fr, fq * 8), boff = lds_byte(wc * 32 + fr, fq * 8);
#define PG8_SA(b, h) (((b) * 2 + (h)) * HTB)
#define PG8_SB(b, h) ((4 + (b) * 2 + (h)) * HTB)
#define PG8_STAGE(bufoff, gbase, voff) do { _Pragma("unroll") for (int _i = 0; _i < 2; ++_i) \
        __builtin_amdgcn_global_load_lds((const unsigned*)((const char*)(gbase) + (voff)[_i]), (PG8_LAS unsigned*)(lds + (bufoff) + ldsw + _i * 8192), 16, 0, 0); } while (0)
#define PG8_LDA(dst, b, h) do { _Pragma("unroll") for (int m = 0; m < 4; ++m) _Pragma("unroll") for (int k = 0; k < 2; ++k) dst[m][k] = *(const PG8_LAS bf16x8*)(lds + PG8_SA(b, h) + aoff + m * 2048 + k * 1024); } while (0)
#define PG8_LDB(dst, b, h) do { _Pragma("unroll") for (int n = 0; n < 2; ++n) _Pragma("unroll") for (int k = 0; k < 2; ++k) dst[n][k] = *(const PG8_LAS bf16x8*)(lds + PG8_SB(b, h) + boff + n * 2048 + k * 1024); } while (0)
#define PG8_MMA(ai, bj, At, Bt) do { __builtin_amdgcn_s_setprio(1); _Pragma("unroll") for (int m = 0; m < 4; ++m) _Pragma("unroll") for (int n = 0; n < 2; ++n) _Pragma("unroll") for (int k = 0; k < 2; ++k) \
        acc[ai][bj][m][n] = __builtin_amdgcn_mfma_f32_16x16x32_bf16(Bt[n][k], At[m][k], acc[ai][bj][m][n], 0, 0, 0); __builtin_amdgcn_s_setprio(0); } while (0)
#define PG8_WAIT_V(n) asm volatile("s_waitcnt vmcnt(" #n ")" ::: "memory")
#define PG8_WAIT_L(n) asm volatile("s_waitcnt lgkmcnt(" #n ")" ::: "memory")
#define PG8_BAR __builtin_amdgcn_s_barrier()
#define PG8_SCHED __builtin_amdgcn_sched_barrier(0)
    Unit cur, nxt; int ui = 0;
    if (!S.next(0, cur)) return;
    f32x4 acc[2][2][4][2];
#pragma unroll
    for (int a = 0; a < 2; ++a)
#pragma unroll
        for (int b = 0; b < 2; ++b)
#pragma unroll
            for (int m = 0; m < 4; ++m)
#pragma unroll
                for (int n = 0; n < 2; ++n) acc[a][b][m][n] = (f32x4){0.f, 0.f, 0.f, 0.f};
    bf16x8 At[4][2], B0[2][2], B1[2][2];
    const char* cA = (const char*)g.A + (size_t)cur.pm * tstep; const char* cB = (const char*)g.Bt + (size_t)cur.pn * tstep;
    S.a_ready(cur);
    if constexpr (SP2) {
        PG8_STAGE(PG8_SB(0, 0), cB, voffB); PG8_STAGE(PG8_SB(0, 1), cB + hstep, voffB); PG8_STAGE(PG8_SA(0, 0), cA, voffA); PG8_STAGE(PG8_SA(0, 1), cA + hstep, voffA);
        if (wr == 1) PG8_BAR;
        PG8_WAIT_V(2); PG8_BAR;
        PG8_STAGE(PG8_SB(1, 0), cB + kstep, voffB); PG8_STAGE(PG8_SA(1, 0), cA + kstep, voffA); PG8_STAGE(PG8_SB(1, 1), cB + hstep + kstep, voffB);
        PG8_WAIT_V(6); PG8_BAR;
    } else {
        PG8_STAGE(PG8_SB(0, 0), cB, voffB); PG8_STAGE(PG8_SA(0, 0), cA, voffA); PG8_STAGE(PG8_SB(0, 1), cB + hstep, voffB); PG8_STAGE(PG8_SA(0, 1), cA + hstep, voffA);
        if (wr == 1) PG8_BAR;
        PG8_WAIT_V(4); PG8_BAR;
        PG8_STAGE(PG8_SB(1, 0), cB + kstep, voffB); PG8_STAGE(PG8_SA(1, 0), cA + kstep, voffA); PG8_STAGE(PG8_SB(1, 1), cB + hstep + kstep, voffB);
        PG8_WAIT_V(6); PG8_BAR;
    }
    for (;;) {
        const bool has_next = S.next(ui + 1, nxt);
        const char* nA = has_next ? (const char*)g.A + (size_t)nxt.pm * tstep : cA; const char* nB = has_next ? (const char*)g.Bt + (size_t)nxt.pn * tstep : cB;
        for (int t = 0; t < nt; t += 2) {
            const bool last = (t == nt - 2);
            const char* a1 = cA + (size_t)(t + 1) * kstep;
            const char* a2 = last ? nA : cA + (size_t)(t + 2) * kstep; const char* b2 = last ? nB : cB + (size_t)(t + 2) * kstep;
            const char* a3 = a2 + kstep; const char* b3 = b2 + kstep;
            if (last && has_next) S.a_ready(nxt);
            if constexpr (SP2) {
            PG8_LDB(B0, 0, 0); PG8_LDB(B1, 0, 1); PG8_SCHED; PG8_LDA(At, 0, 0); PG8_STAGE(PG8_SA(1, 1), a1 + hstep, voffA);
            PG8_WAIT_V(8); PG8_WAIT_L(0); PG8_BAR; PG8_MMA(0, 0, At, B0); PG8_MMA(0, 1, At, B1); PG8_BAR; PG8_SCHED;
            PG8_LDA(At, 0, 1); PG8_STAGE(PG8_SB(0, 0), b2, voffB); PG8_STAGE(PG8_SB(0, 1), b2 + hstep, voffB); PG8_STAGE(PG8_SA(0, 0), a2, voffA);
            PG8_WAIT_V(8); PG8_WAIT_L(0); PG8_BAR; PG8_MMA(1, 0, At, B0); PG8_MMA(1, 1, At, B1); PG8_BAR; PG8_SCHED;
            PG8_LDB(B0, 1, 0); PG8_LDB(B1, 1, 1); PG8_SCHED; PG8_LDA(At, 1, 0); PG8_STAGE(PG8_SA(0, 1), a2 + hstep, voffA);
            PG8_WAIT_V(8); PG8_WAIT_L(0); PG8_BAR; PG8_MMA(0, 0, At, B0); PG8_MMA(0, 1, At, B1); PG8_BAR; PG8_SCHED;
            PG8_LDA(At, 1, 1); PG8_STAGE(PG8_SB(1, 0), b3, voffB); PG8_STAGE(PG8_SB(1, 1), b3 + hstep, voffB); PG8_STAGE(PG8_SA(1, 0), a3, voffA);
            PG8_WAIT_V(8); PG8_WAIT_L(0); PG8_BAR; PG8_MMA(1, 0, At, B0); PG8_MMA(1, 1, At, B1); PG8_BAR; PG8_SCHED;
            } else {
            PG8_LDB(B0, 0, 0); PG8_SCHED; PG8_LDA(At, 0, 0); PG8_STAGE(PG8_SA(1, 1), a1 + hstep, voffA);
            PG8_WAIT_L(8); PG8_BAR; PG8_WAIT_L(0); PG8_MMA(0, 0, At, B0); PG8_BAR; PG8_SCHED;
            PG8_LDB(B1, 0, 1); PG8_STAGE(PG8_SB(0, 0), b2, voffB);
            PG8_BAR; PG8_WAIT_L(0); PG8_MMA(0, 1, At, B1); PG8_BAR;
            PG8_LDA(At, 0, 1); PG8_STAGE(PG8_SA(0, 0), a2, voffA);
            PG8_BAR; PG8_WAIT_L(0); PG8_MMA(1, 0, At, B0); PG8_BAR; PG8_SCHED;
            PG8_STAGE(PG8_SB(0, 1), b2 + hstep, voffB);
            PG8_WAIT_V(6); PG8_BAR; PG8_MMA(1, 1, At, B1); PG8_BAR;
            PG8_LDB(B0, 1, 0); PG8_SCHED; PG8_LDA(At, 1, 0); PG8_STAGE(PG8_SA(0, 1), a2 + hstep, voffA);
            PG8_WAIT_L(8); PG8_BAR; PG8_WAIT_L(0); PG8_MMA(0, 0, At, B0); PG8_BAR; PG8_SCHED;
            PG8_LDB(B1, 1, 1); PG8_STAGE(PG8_SB(1, 0), b3, voffB);
            PG8_BAR; PG8_WAIT_L(0); PG8_MMA(0, 1, At, B1); PG8_BAR;
            PG8_LDA(At, 1, 1); PG8_STAGE(PG8_SA(1, 0), a3, voffA);
            PG8_BAR; PG8_WAIT_L(0); PG8_MMA(1, 0, At, B0); PG8_BAR; PG8_SCHED;
            PG8_STAGE(PG8_SB(1, 1), b3 + hstep, voffB);
            PG8_WAIT_V(6); PG8_BAR; PG8_MMA(1, 1, At, B1); PG8_BAR;
            }
        }
        if constexpr (ALIGN_EPI) { if (wr == 0) PG8_BAR; }
        if constexpr (!Epi::AFTER_DRAIN) { E(acc, cur, wr, wc, fr, fq); S.done(cur); }
        if (!has_next) break;
#pragma unroll
        for (int a = 0; a < 2; ++a)
#pragma unroll
            for (int b = 0; b < 2; ++b)
#pragma unroll
                for (int m = 0; m < 4; ++m)
#pragma unroll
                    for (int n = 0; n < 2; ++n) acc[a][b][m][n] = (f32x4){0.f, 0.f, 0.f, 0.f};
        cur = nxt; cA = nA; cB = nB; ++ui;
        if constexpr (ALIGN_EPI) { if (wr == 1) PG8_BAR; }
    }
    PG8_WAIT_V(0);
    if constexpr (!ALIGN_EPI) { if (wr == 0) PG8_BAR; }
    PG8_BAR;
    if constexpr (Epi::AFTER_DRAIN) { E.fused(acc, cur, wr, wc, fr, fq, lds, wid, lane); S.done(cur); }
#undef PG8_SA
#undef PG8_SB
#undef PG8_STAGE
#undef PG8_LDA
#undef PG8_LDB
#undef PG8_MMA
#undef PG8_WAIT_V
#undef PG8_WAIT_L
#undef PG8_BAR
#undef PG8_SCHED
}
}
typedef unsigned short bf16;
typedef float f32x4v __attribute__((ext_vector_type(4)));
#define LAS __attribute__((address_space(3)))

struct GemmArgs { const bf16* A; const bf16* Bt; float* C; int M, N, K, ldc; };
__global__ void __launch_bounds__(512, 2) k_gemm_f32(GemmArgs a) {
    extern __shared__ __attribute__((aligned(16))) unsigned char lds[];
    pg8::Gemm g{a.A, a.Bt, a.M, a.N, a.K}; pg8::StaticOrder S; S.init(a.M, a.N, (int)gridDim.x, (int)blockIdx.x);
    pg8::EpiF32 E{a.C, a.ldc};
    pg8::gemm_phase<pg8::EpiF32, pg8::StaticOrder, true, true>((LAS unsigned char*)lds, g, S, E);
}
struct InProjArgs { const bf16* A; const bf16* Bt; pg8::EpiInProj E; };
__global__ void __launch_bounds__(512, 2) k_gemm_inproj(InProjArgs a) {
    extern __shared__ __attribute__((aligned(16))) unsigned char lds[];
    pg8::Gemm g{a.A, a.Bt, MT, NINP, D}; pg8::StaticOrder S; S.init(MT, NINP, (int)gridDim.x, (int)blockIdx.x);
    pg8::gemm_phase<pg8::EpiInProj, pg8::StaticOrder, true, true>((LAS unsigned char*)lds, g, S, a.E);
}
struct QArgs { const bf16* A; const bf16* Bt; pg8::EpiQ E; };
__global__ void __launch_bounds__(512, 2) k_gemm_q(QArgs a) {
    extern __shared__ __attribute__((aligned(16))) unsigned char lds[];
    pg8::Gemm g{a.A, a.Bt, MT, MH * QHD, QL}; pg8::StaticOrder S; S.init(MT, MH * QHD, (int)gridDim.x, (int)blockIdx.x);
    pg8::gemm_phase<pg8::EpiQ, pg8::StaticOrder, true, true>((LAS unsigned char*)lds, g, S, a.E);
}
struct KVArgs { const bf16* A; const bf16* Bt; pg8::EpiKV E; };
__global__ void __launch_bounds__(512, 2) k_gemm_kv(KVArgs a) {
    extern __shared__ __attribute__((aligned(16))) unsigned char lds[];
    pg8::Gemm g{a.A, a.Bt, MP, 1024, KVL}; pg8::StaticOrder S; S.init(MP, 1024, (int)gridDim.x, (int)blockIdx.x);
    pg8::gemm_phase<pg8::EpiKV, pg8::StaticOrder, true, true>((LAS unsigned char*)lds, g, S, a.E);
}

__global__ void __launch_bounds__(256) k_mod(const float* __restrict__ c_p, const float* __restrict__ c_s, const float* __restrict__ w_ada, const float* __restrict__ b_ada, float* __restrict__ mod) {
    const int n = blockIdx.x * 256 + threadIdx.x, r0 = blockIdx.y * 13;
    float acc[13];
#pragma unroll
    for (int i = 0; i < 13; ++i) acc[i] = 0.f;
    for (int k = 0; k < D; ++k) {
        const float w = w_ada[(size_t)k * 3072 + n];
#pragma unroll
        for (int i = 0; i < 13; ++i) { const int r = r0 + i; const float cv = r < 2 ? c_p[r * D + k] : c_s[(r - 2) * D + k]; acc[i] += cv * w; }
    }
    const float bb = b_ada[n];
#pragma unroll
    for (int i = 0; i < 13; ++i) mod[(size_t)(r0 + i) * 3072 + n] = acc[i] + bb;
}
__global__ void __launch_bounds__(256) k_wt(const float* __restrict__ W, int ldw, int K, bf16* __restrict__ WT, int mode, const float* __restrict__ gain) {
    __shared__ float tile[32][33];
    const int k0 = blockIdx.x * 32, n0 = blockIdx.y * 32, tx = threadIdx.x, ty = threadIdx.y;
    const int n = n0 + tx, src = mode ? zsrc(n) : n;
    const float cs = (mode && n >= ZK && n < ZV) ? KSCALE : 1.f;
    for (int i = ty; i < 32; i += 8) tile[i][tx] = src >= 0 ? W[(size_t)(k0 + i) * ldw + src] * cs * (gain ? gain[k0 + i] : 1.f) : 0.f;
    __syncthreads();
    for (int i = ty; i < 32; i += 8) WT[(size_t)(n0 + i) * K + k0 + tx] = f2bf(tile[tx][i]);
}
__global__ void __launch_bounds__(256) k_cvt(const float* __restrict__ src, bf16* __restrict__ dst, int n4) {
    const int i = blockIdx.x * 256 + threadIdx.x; if (i >= n4) return;
    const f32x4v v = *(const f32x4v*)(src + 4 * (size_t)i); ushort4 o; o.x = f2bf(v.x); o.y = f2bf(v.y); o.z = f2bf(v.z); o.w = f2bf(v.w); *(ushort4*)(dst + 4 * (size_t)i) = o;
}
__global__ void __launch_bounds__(256) k_ropetab(float* __restrict__ T) {
    const int i = blockIdx.x * 256 + threadIdx.x; if (i >= (PAST + DS) * 16) return;
    const int pos = i >> 4, j = i & 15; const float inv = powf(10000.f, -(float)j / 16.f), ang = (float)pos * inv; float sn, cs; sincosf(ang, &sn, &cs);
    T[pos * 32 + j] = cs; T[pos * 32 + 16 + j] = sn;
}
__global__ void __launch_bounds__(256) k_hprep(const float* __restrict__ xp, const float* __restrict__ xs, const float* __restrict__ mod, bf16* __restrict__ H) {
    const size_t i4 = (size_t)blockIdx.x * 256 + threadIdx.x;
    const int m = (int)(i4 >> 8), c = (int)(i4 & 255) * 4;
    const float* x = m < MP ? xp + (size_t)m * D : xs + (size_t)(m - MP) * D;
    const float* mr = mod + (size_t)row_modrow(m) * 3072;
    const f32x4v xv = *(const f32x4v*)(x + c), sh = *(const f32x4v*)(mr + c), sc = *(const f32x4v*)(mr + 1024 + c);
    ushort4 o; o.x = f2bf(xv.x * (1.f + sc.x) + sh.x); o.y = f2bf(xv.y * (1.f + sc.y) + sh.y); o.z = f2bf(xv.z * (1.f + sc.z) + sh.z); o.w = f2bf(xv.w * (1.f + sc.w) + sh.w);
    *(ushort4*)(H + (size_t)m * D + c) = o;
}

__global__ void __launch_bounds__(256) k_rows_ckv(const bf16* __restrict__ CKVR, const float* __restrict__ SSKV, const float* __restrict__ kvnorm, float* __restrict__ out) {
    const int lane = threadIdx.x & 63, m = blockIdx.x * 4 + (threadIdx.x >> 6);
    const float4 p = *(const float4*)(SSKV + (size_t)m * 4);
    const float r = rsqrtf(((p.x + p.y) + (p.z + p.w)) * (1.f / KVL) + EPS);
    const ushort4 v = *(const ushort4*)(CKVR + (size_t)m * KVL + 4 * lane); const float4 g = *(const float4*)(kvnorm + 4 * lane);
    float* o = m < MP ? out + O_CKVP + (size_t)m * KVL : out + O_CKVS + (size_t)(m - MP) * KVL;
    *(float4*)(o + 4 * lane) = make_float4(bf2f(v.x) * r * g.x, bf2f(v.y) * r * g.y, bf2f(v.z) * r * g.z, bf2f(v.w) * r * g.w);
}
__global__ void __launch_bounds__(256) k_qlat(const bf16* __restrict__ Q96, const float* __restrict__ w_uk, float* __restrict__ QLAT) {
    __shared__ float qs[MH * NOPE];
    const int ms = blockIdx.x, c = threadIdx.x;
    for (int e = threadIdx.x; e < MH * NOPE; e += 256) qs[e] = bf2f(Q96[(size_t)(MP + ms) * (MH * QHD) + (e >> 6) * QHD + (e & 63)]);
    __syncthreads();
    for (int h = 0; h < MH; ++h) { float acc = 0.f;
        for (int n = 0; n < NOPE; ++n) acc += qs[h * NOPE + n] * w_uk[(size_t)c * (MH * NOPE) + h * NOPE + n];
        QLAT[((size_t)ms * MH + h) * KVL + c] = acc; }
}

__global__ void __launch_bounds__(256) k_attn_prompt_naive(const bf16* __restrict__ Q96, const bf16* __restrict__ KVB, const bf16* __restrict__ KRB, const float* __restrict__ ropet, float* __restrict__ OMLA) {
    const int qb = (int)gridDim.x - 1 - (int)blockIdx.x, b = blockIdx.y / MH, h = blockIdx.y % MH;
    const int t = qb * 256 + threadIdx.x, m = b * SP + t;
    float q[QHD], acc[VD];
#pragma unroll
    for (int j = 0; j < QHD; ++j) q[j] = bf2f(Q96[(size_t)m * (MH * QHD) + h * QHD + j]);
#pragma unroll
    for (int j = 0; j < VD; ++j) acc[j] = 0.f;
#pragma unroll
    for (int j = 0; j < 16; ++j) { const float cs = ropet[t * 32 + j], sn = ropet[t * 32 + 16 + j], x1 = q[NOPE + j], x2 = q[NOPE + 16 + j]; q[NOPE + j] = x1 * cs - x2 * sn; q[NOPE + 16 + j] = x2 * cs + x1 * sn; }
    float mx = -INFINITY, l = 0.f;
    const int jend = qb * 256 + 256;
    for (int j = 0; j < jend; ++j) {
        const bf16* kn = KVB + (size_t)(b * SP + j) * 1024 + h * NOPE; const bf16* kr = KRB + (size_t)(b * SP + j) * ROPE; const bf16* vv = KVB + (size_t)(b * SP + j) * 1024 + 512 + h * VD;
        float s = 0.f;
#pragma unroll
        for (int d = 0; d < NOPE; ++d) s += q[d] * bf2f(kn[d]);
#pragma unroll
        for (int d = 0; d < ROPE; ++d) s += q[NOPE + d] * bf2f(kr[d]);
        if (j <= t) {
            const float mn = fmaxf(mx, s), al = exp2f(mx - mn), p = exp2f(s - mn);
            l = l * al + p; mx = mn;
#pragma unroll
            for (int d = 0; d < VD; ++d) acc[d] = acc[d] * al + p * bf2f(vv[d]);
        }
    }
    const float il = 1.f / l;
#pragma unroll
    for (int d = 0; d < VD; ++d) OMLA[(size_t)m * 512 + h * VD + d] = acc[d] * il;
}

__global__ void __launch_bounds__(256) k_attn_sample_naive(const float* __restrict__ QLAT, const bf16* __restrict__ Q96, const float* __restrict__ cache_ckv, const float* __restrict__ cache_kr,
                                                           const int* __restrict__ page_table, const float* __restrict__ ckv_new  , const bf16* __restrict__ KRB, const float* __restrict__ ropet, float* __restrict__ OLAT) {
    __shared__ float s_m[4][DS], s_l[4][DS], s_acc[4][DS][KVL];
    const int b = blockIdx.x / MH, h = blockIdx.x % MH, lane = threadIdx.x & 63, w = threadIdx.x >> 6;
    float ql[DS][4], qr[DS], acc[DS][4], mx[DS], l[DS];
#pragma unroll
    for (int i = 0; i < DS; ++i) {
#pragma unroll
        for (int j = 0; j < 4; ++j) { ql[i][j] = QLAT[((size_t)(b * DS + i) * MH + h) * KVL + lane + 64 * j]; acc[i][j] = 0.f; }
        { const float x = lane < ROPE ? bf2f(Q96[(size_t)(MP + b * DS + i) * (MH * QHD) + h * QHD + NOPE + lane]) : 0.f, o = __shfl_xor(x, 16);
          const float cs = ropet[(PAST + i) * 32 + (lane & 15)], sn = ropet[(PAST + i) * 32 + 16 + (lane & 15)];
          qr[i] = lane < 16 ? x * cs - o * sn : (lane < 32 ? x * cs + o * sn : 0.f); }
        mx[i] = -INFINITY; l[i] = 0.f;
    }
    for (int key = w; key < PAST + DS; key += 4) {
        const float* kc; const float* kr = nullptr; const bf16* krn = nullptr;
        if (key < PAST) { const int pg = page_table[b * NPAGES + (key >> 7)]; kc = cache_ckv + ((size_t)pg * PAGE + (key & 127)) * KVL; kr = cache_kr + ((size_t)pg * PAGE + (key & 127)) * ROPE; }
        else { kc = ckv_new + (size_t)(b * DS + key - PAST) * KVL; krn = KRB + (size_t)(MP + b * DS + key - PAST) * ROPE; }
        float kv[4];
#pragma unroll
        for (int j = 0; j < 4; ++j) kv[j] = kc[lane + 64 * j];
        const float krv = lane < ROPE ? (kr ? kr[lane] : bf2f(krn[lane])) : 0.f;
#pragma unroll
        for (int i = 0; i < DS; ++i) {
            float s = ql[i][0] * kv[0] + ql[i][1] * kv[1] + ql[i][2] * kv[2] + ql[i][3] * kv[3] + qr[i] * krv;
            s = wave_sum(s);
            if (key < PAST + i + 1) {
                const float mn = fmaxf(mx[i], s), al = exp2f(mx[i] - mn), p = exp2f(s - mn);
                l[i] = l[i] * al + p; mx[i] = mn;
#pragma unroll
                for (int j = 0; j < 4; ++j) acc[i][j] = acc[i][j] * al + p * kv[j];
            }
        }
    }
#pragma unroll
    for (int i = 0; i < DS; ++i) { if (lane == 0) { s_m[w][i] = mx[i]; s_l[w][i] = l[i]; }
#pragma unroll
        for (int j = 0; j < 4; ++j) s_acc[w][i][lane + 64 * j] = acc[i][j]; }
    __syncthreads();
    for (int e = threadIdx.x; e < DS * KVL; e += 256) { const int i = e >> 8, c = e & 255;
        const float mm = fmaxf(fmaxf(s_m[0][i], s_m[1][i]), fmaxf(s_m[2][i], s_m[3][i]));
        float num = 0.f, den = 0.f;
#pragma unroll
        for (int ww = 0; ww < 4; ++ww) { const float f = exp2f(s_m[ww][i] - mm); num += f * s_acc[ww][i][c]; den += f * s_l[ww][i]; }
        OLAT[((size_t)(b * DS + i) * MH + h) * KVL + c] = num / den; }
}
__global__ void __launch_bounds__(512) k_olat_uv(const float* __restrict__ OLAT, const float* __restrict__ w_uv, float* __restrict__ OMLA) {
    __shared__ float os[MH * KVL];
    const int ms = blockIdx.x, tid = threadIdx.x, h = tid >> 6;
    for (int e = tid; e < MH * KVL; e += 512) os[e] = OLAT[(size_t)ms * MH * KVL + e];
    __syncthreads();
    float acc = 0.f;
    for (int c = 0; c < KVL; ++c) acc += os[h * KVL + c] * w_uv[(size_t)c * 512 + tid];
    OMLA[(size_t)(MP + ms) * 512 + tid] = acc;
}

__global__ void __launch_bounds__(256) k_ml_a(const bf16* __restrict__ ZB, const float* __restrict__ GATES, const float* __restrict__ b_i, const float* __restrict__ b_f, float* __restrict__ G, float* __restrict__ U, float* __restrict__ DC, float* __restrict__ DN) {
    __shared__ float s_w[LC], s_F[LC], s_ig[LC], s_red[2];
    const int bh = blockIdx.x / NCH, c = blockIdx.x % NCH, b = bh / LH, h = bh % LH, tid = threadIdx.x;
    const size_t row0 = (size_t)b * SP + (size_t)c * LC;
    if (tid < LC) { const float* z = GATES + (row0 + tid) * 8; s_ig[tid] = z[h] + b_i[h]; s_F[tid] = logsigmoidf_(z[4 + h] + b_f[h]); }
    __syncthreads();
    if (tid == 0) { float f = 0.f; for (int s = 0; s < LC; ++s) { f += s_F[s]; s_F[s] = f; } const float g = f; float u = -INFINITY;
        for (int s = 0; s < LC; ++s) u = fmaxf(u, g - s_F[s] + s_ig[s]); s_red[0] = g; s_red[1] = u; }
    __syncthreads();
    const float g = s_red[0], u = s_red[1];
    if (tid < LC) s_w[tid] = __expf(g - s_F[tid] + s_ig[tid] - u);
    __syncthreads();
    const int dk = tid >> 1, dv0 = (tid & 1) * 64;
    float acc[64]; float an = 0.f;
#pragma unroll
    for (int j = 0; j < 64; ++j) acc[j] = 0.f;
    for (int s = 0; s < LC; ++s) { const bf16* z = ZB + (row0 + s) * 3072; const float kw = bf2f(z[ZK + h * DK + dk]) * s_w[s]; an += kw;
#pragma unroll
        for (int j = 0; j < 64; ++j) acc[j] += kw * bf2f(z[ZV + h * DV + dv0 + j]); }
    float* dc = DC + ((size_t)blockIdx.x * DK + dk) * DV + dv0;
#pragma unroll
    for (int j = 0; j < 64; ++j) dc[j] = acc[j];
    if ((tid & 1) == 0) DN[(size_t)blockIdx.x * DK + dk] = an;
    if (tid == 0) { G[blockIdx.x] = g; U[blockIdx.x] = u; }
}
__global__ void __launch_bounds__(256) k_ml_b(const float* __restrict__ G, const float* __restrict__ U, const float* __restrict__ DC, const float* __restrict__ DN,
                                              float* __restrict__ CS, float* __restrict__ NS, float* __restrict__ MSs, float* __restrict__ out) {
    const int gid = blockIdx.x * 256 + threadIdx.x, bh = gid / (DK * DV + DK), e = gid % (DK * DV + DK);
    float m = -INFINITY, x = 0.f;
    for (int c = 0; c < NCH; ++c) {
        const int ci = bh * NCH + c;
        if (e < DK * DV) CS[(size_t)ci * DK * DV + e] = x; else NS[(size_t)ci * DK + (e - DK * DV)] = x;
        if (e == 0) MSs[ci] = m;
        const float g = G[ci], u = U[ci], mn = fmaxf(g + m, u), al = __expf(g + m - mn), be = __expf(u - mn);
        const float d = e < DK * DV ? DC[(size_t)ci * DK * DV + e] : DN[(size_t)ci * DK + (e - DK * DV)];
        x = al * x + be * d; m = mn;
    }
    if (e < DK * DV) out[O_CP + (size_t)bh * DK * DV + e] = x; else out[O_NP + (size_t)bh * DK + (e - DK * DV)] = x;
    if (e == 0) out[O_MPR + bh] = m;
}
__global__ void __launch_bounds__(256) k_ml_c(const bf16* __restrict__ ZB, const float* __restrict__ GATES, const float* __restrict__ b_i, const float* __restrict__ b_f, const float* __restrict__ CS, const float* __restrict__ NS, const float* __restrict__ MSs, float* __restrict__ HML) {
    __shared__ float s_F[LC], s_ig[LC];
    const int bh = blockIdx.x / NCH, c = blockIdx.x % NCH, b = bh / LH, h = bh % LH, tid = threadIdx.x;
    const size_t row0 = (size_t)b * SP + (size_t)c * LC;
    if (tid < LC) { const float* z = GATES + (row0 + tid) * 8; s_ig[tid] = z[h] + b_i[h]; s_F[tid] = logsigmoidf_(z[4 + h] + b_f[h]); }
    __syncthreads();
    if (tid == 0) { float f = 0.f; for (int s = 0; s < LC; ++s) { f += s_F[s]; s_F[s] = f; } }
    __syncthreads();
    const int t = tid >> 1, dv0 = (tid & 1) * 64;
    const float mprev = MSs[blockIdx.x], Ft = s_F[t];
    float mt = Ft + mprev;
    for (int s = 0; s <= t; ++s) mt = fmaxf(mt, Ft - s_F[s] + s_ig[s]);
    const float a = __expf(Ft + mprev - mt);
    const bf16* zq = ZB + (row0 + t) * 3072 + ZQ + h * DK;
    float acc[64]; float den = 0.f;
#pragma unroll
    for (int j = 0; j < 64; ++j) acc[j] = 0.f;
    for (int s = 0; s <= t; ++s) {
        const bf16* z = ZB + (row0 + s) * 3072; float dot = 0.f;
        for (int d = 0; d < DK; ++d) dot += bf2f(zq[d]) * bf2f(z[ZK + h * DK + d]);
        const float sq = dot * __expf(Ft - s_F[s] + s_ig[s] - mt); den += sq;
#pragma unroll
        for (int j = 0; j < 64; ++j) acc[j] += sq * bf2f(z[ZV + h * DV + dv0 + j]);
    }
    const float* cs = CS + (size_t)blockIdx.x * DK * DV; const float* ns = NS + (size_t)blockIdx.x * DK;
    float qn = 0.f;
    for (int d = 0; d < DK; ++d) { const float qa = bf2f(zq[d]) * a; qn += qa * ns[d];
#pragma unroll
        for (int j = 0; j < 64; ++j) acc[j] += qa * cs[(size_t)d * DV + dv0 + j]; }
    den += qn;
    const float inv = 1.f / fmaxf(fabsf(den), __expf(-mt));
    float* o = HML + (row0 + t) * 512 + h * DV + dv0;
#pragma unroll
    for (int j = 0; j < 64; ++j) o[j] = acc[j] * inv;
}
__global__ void __launch_bounds__(256) k_ml_sample(const bf16* __restrict__ ZB, const float* __restrict__ GATES, const float* __restrict__ b_i, const float* __restrict__ b_f, const float* __restrict__ C0, const float* __restrict__ n0, const float* __restrict__ m0,
                                                   float* __restrict__ HML, float* __restrict__ out) {
    __shared__ float s_q[DS][DK], s_k[DS][DK], s_v[DS][DV], s_F[DS], s_ig[DS], s_mt[DS], s_a[DS], s_S[DS][DS], s_den[DS], s_qc[2][DS][DV], s_wl[DS];
    const int b = blockIdx.x / LH, h = blockIdx.x % LH, tid = threadIdx.x;
    const size_t row0 = (size_t)MP + (size_t)b * DS;
    for (int e = tid; e < DS * DK; e += 256) { const int t = e >> 7, d = e & 127; const bf16* z = ZB + (row0 + t) * 3072;
        s_q[t][d] = bf2f(z[ZQ + h * DK + d]); s_k[t][d] = bf2f(z[ZK + h * DK + d]); s_v[t][d] = bf2f(z[ZV + h * DV + d]); }
    if (tid < DS) { const float* z = GATES + (row0 + tid) * 8; s_ig[tid] = z[h] + b_i[h]; s_F[tid] = logsigmoidf_(z[4 + h] + b_f[h]); }
    __syncthreads();
    const float mprev = m0[b * LH + h];
    if (tid == 0) { float f = 0.f; for (int s = 0; s < DS; ++s) { f += s_F[s]; s_F[s] = f; }
        for (int t = 0; t < DS; ++t) { float mt = s_F[t] + mprev; for (int s = 0; s <= t; ++s) mt = fmaxf(mt, s_F[t] - s_F[s] + s_ig[s]); s_mt[t] = mt; s_a[t] = __expf(s_F[t] + mprev - mt); }
        for (int s = 0; s < DS; ++s) s_wl[s] = __expf(s_F[DS - 1] - s_F[s] + s_ig[s] - s_mt[DS - 1]); }
    __syncthreads();
    if (tid < DS * DS) { const int t = tid >> 3, s = tid & 7; float v = 0.f;
        if (s <= t) { float dot = 0.f; for (int d = 0; d < DK; ++d) dot += s_q[t][d] * s_k[s][d]; v = dot * __expf(s_F[t] - s_F[s] + s_ig[s] - s_mt[t]); }
        s_S[t][s] = v; }
    __syncthreads();
    const int dv = tid & 127, hf = tid >> 7;
    const float* c0 = C0 + (size_t)blockIdx.x * DK * DV; float* cn = out + O_CS + (size_t)blockIdx.x * DK * DV;
    const float al = s_a[DS - 1];
    float qc[DS];
#pragma unroll
    for (int t = 0; t < DS; ++t) qc[t] = 0.f;
    for (int d = hf * 64; d < hf * 64 + 64; ++d) {
        const float cv = c0[(size_t)d * DV + dv]; float nv = al * cv;
#pragma unroll
        for (int t = 0; t < DS; ++t) { qc[t] += s_q[t][d] * cv; nv += s_wl[t] * s_k[t][d] * s_v[t][dv]; }
        cn[(size_t)d * DV + dv] = nv;
    }
#pragma unroll
    for (int t = 0; t < DS; ++t) s_qc[hf][t][dv] = qc[t];
    if (tid < DS) { const int t = tid; float dn = 0.f; for (int s = 0; s <= t; ++s) dn += s_S[t][s]; float qn = 0.f; const float* nn = n0 + (size_t)blockIdx.x * DK;
        for (int d = 0; d < DK; ++d) qn += s_q[t][d] * nn[d]; s_den[t] = dn + s_a[t] * qn; }
    if (tid >= 128 && tid < 128 + DK) { const int d = tid - 128; float nv = al * n0[(size_t)blockIdx.x * DK + d];
        for (int s = 0; s < DS; ++s) nv += s_wl[s] * s_k[s][d]; out[O_NS + (size_t)blockIdx.x * DK + d] = nv; }
    if (tid == 0) out[O_MS + blockIdx.x] = s_mt[DS - 1];
    __syncthreads();
    for (int e = tid; e < DS * DV; e += 256) { const int t = e >> 7, d = e & 127; float num = s_a[t] * (s_qc[0][t][d] + s_qc[1][t][d]);
        for (int s = 0; s <= t; ++s) num += s_S[t][s] * s_v[s][d];
        HML[(row0 + t) * 512 + h * DV + d] = num / fmaxf(fabsf(s_den[t]), __expf(-s_mt[t])); }
}

__global__ void __launch_bounds__(256) k_back_rows(const bf16* __restrict__ ZB, const float* __restrict__ HML, const float* __restrict__ OMLA, const float* __restrict__ gn, bf16* __restrict__ YCAT) {
    const int lane = threadIdx.x & 63, m = MP + blockIdx.x * 4 + (threadIdx.x >> 6);
    const bf16* z = ZB + (size_t)m * 3072;
#pragma unroll
    for (int h = 0; h < LH; ++h) {
        const int c0 = h * DV + lane, c1 = c0 + 64;
        const float a0 = HML[(size_t)m * 512 + c0] * sigmoidf_(bf2f(z[ZO + c0])), a1 = HML[(size_t)m * 512 + c1] * sigmoidf_(bf2f(z[ZO + c1]));
        const float mu = wave_sum(a0 + a1) * (1.f / DV), d0 = a0 - mu, d1 = a1 - mu, var = wave_sum(d0 * d0 + d1 * d1) * (1.f / DV), r = rsqrtf(var + EPS);
        YCAT[(size_t)m * D + c0] = f2bf(d0 * r * gn[c0] * siluf_(bf2f(z[ZZ + c0]))); YCAT[(size_t)m * D + c1] = f2bf(d1 * r * gn[c1] * siluf_(bf2f(z[ZZ + c1])));
    }
#pragma unroll
    for (int i = 0; i < 8; ++i) if (m >= MP) { const int c = lane + 64 * i; YCAT[(size_t)m * D + 512 + c] = f2bf(OMLA[(size_t)m * 512 + c] * siluf_(bf2f(z[ZAZ + c]))); }
}
__global__ void __launch_bounds__(256) k_final_ln(const float* __restrict__ xp, const float* __restrict__ xs, const float* __restrict__ mod, const float* __restrict__ OUT, const float* __restrict__ lg, const float* __restrict__ lb, float* __restrict__ out) {
    const int lane = threadIdx.x & 63, m = blockIdx.x * 4 + (threadIdx.x >> 6);
    const float* x = m < MP ? xp + (size_t)m * D : xs + (size_t)(m - MP) * D;
    const float* gate = mod + (size_t)row_modrow(m) * 3072 + 2048;
    float* y = m < MP ? out + O_YP + (size_t)m * D : out + O_YS + (size_t)(m - MP) * D;
    f32x4v v[4]; float s = 0.f;
#pragma unroll
    for (int j = 0; j < 4; ++j) { const int c = 4 * lane + 256 * j; const f32x4v xv = *(const f32x4v*)(x + c), gv = *(const f32x4v*)(gate + c), ov = *(const f32x4v*)(OUT + (size_t)m * D + c);
        v[j] = xv * ALPHA + gv * ov; s += (v[j].x + v[j].y) + (v[j].z + v[j].w); }
    const float mu = wave_sum(s) * (1.f / D); float s2 = 0.f;
#pragma unroll
    for (int j = 0; j < 4; ++j) { v[j] = v[j] - mu; s2 += (v[j].x * v[j].x + v[j].y * v[j].y) + (v[j].z * v[j].z + v[j].w * v[j].w); }
    const float r = rsqrtf(wave_sum(s2) * (1.f / D) + EPS);
#pragma unroll
    for (int j = 0; j < 4; ++j) { const int c = 4 * lane + 256 * j; const f32x4v g = *(const f32x4v*)(lg + c), bb = *(const f32x4v*)(lb + c); *(f32x4v*)(y + c) = v[j] * r * g + bb; }
}
namespace pa {
typedef short bf16x8 __attribute__((ext_vector_type(8)));
typedef short s16x4 __attribute__((ext_vector_type(4)));
typedef float f32x16 __attribute__((ext_vector_type(16)));
typedef unsigned u32x4 __attribute__((ext_vector_type(4)));
typedef unsigned u32x2 __attribute__((ext_vector_type(2)));
typedef float f32x2_t __attribute__((ext_vector_type(2))); typedef __bf16 bf16x2_t __attribute__((ext_vector_type(2)));
constexpr int KP = 208, VP = 128, KBUF = 64 * KP, VBUF = 64 * VP, L_K = 0, L_V = 2 * KBUF, LDS_BYTES = 2 * KBUF + 2 * VBUF;
__device__ __forceinline__ unsigned cvtpk(float lo, float hi) { f32x2_t v = {lo, hi}; bf16x2_t b = __builtin_convertvector(v, bf16x2_t); return __builtin_bit_cast(unsigned, b); }
__device__ __forceinline__ bf16x8 pack8(const f32x16& p, int s) { u32x4 w; w.x = cvtpk(p[8 * s], p[8 * s + 1]); w.y = cvtpk(p[8 * s + 2], p[8 * s + 3]); w.z = cvtpk(p[8 * s + 4], p[8 * s + 5]); w.w = cvtpk(p[8 * s + 6], p[8 * s + 7]); return __builtin_bit_cast(bf16x8, w); }
__device__ __forceinline__ s16x4 vtr(const LAS unsigned char* p) { return __builtin_bit_cast(s16x4, __builtin_amdgcn_ds_read_tr16_b64_v4i16((LAS s16x4*)p)); }
__device__ __forceinline__ int crow(int r, int hf) { return (r & 3) + 8 * (r >> 2) + 4 * hf; }
#define PA_MFMA(a, b, c) __builtin_amdgcn_mfma_f32_32x32x16_bf16((a), (b), (c), 0, 0, 0)

struct Tensors { const bf16* Q96; const bf16* KVB; const bf16* KRB; const bf16* ZB; const float* ropet; bf16* YCAT; };

__device__ __forceinline__ void unit(LAS unsigned char* lds, const Tensors& T, int b, int h, int qb) {
    const int tid = threadIdx.x, lane = tid & 63, w = __builtin_amdgcn_readfirstlane(tid >> 6), q32 = lane & 31, hf = lane >> 5;
    const int Q0 = qb * 256, NT = (Q0 + 256) / 64;
    const size_t rowb = (size_t)b * SP;
    const int rv = tid >> 3, cv = tid & 7;
    const bf16* gV = T.KVB + (rowb + rv) * 1024 + 512 + h * 64 + cv * 8;
    const bf16* gK = T.KVB + (rowb + rv) * 1024 + h * 64 + cv * 8;
    const bf16* gR = T.KRB + (rowb + (tid >> 2)) * 32 + (tid & 3) * 8;
    const int dV = L_V + rv * VP + ((cv ^ (((rv >> 1) & 1) << 2)) * 16), dK = L_K + rv * KP + cv * 16, dR = L_K + (tid >> 2) * KP + 128 + (tid & 3) * 16;
    u32x4 sV, sK, sR = {0u, 0u, 0u, 0u};
    sV = *(const u32x4*)gV; sK = *(const u32x4*)gK; if (tid < 256) sR = *(const u32x4*)gR;
    const int qg = Q0 + 32 * w + q32;
    const bf16* qrow = T.Q96 + (rowb + qg) * 768 + h * 96 + 8 * hf;
    bf16x8 qf[6];
#pragma unroll
    for (int ks = 0; ks < 6; ++ks) qf[ks] = *(const bf16x8*)(qrow + 16 * ks);
    {   const float* tb = T.ropet + (size_t)qg * 32 + 8 * hf;
        u32x4 y1, y2;
#pragma unroll
        for (int e = 0; e < 8; e += 2) {
            const float c0 = tb[e], c1 = tb[e + 1], s0 = tb[16 + e], s1 = tb[16 + e + 1];
            const float a0 = bf2f((unsigned short)qf[4][e]), a1 = bf2f((unsigned short)qf[4][e + 1]), b0 = bf2f((unsigned short)qf[5][e]), b1 = bf2f((unsigned short)qf[5][e + 1]);
            y1[e >> 1] = cvtpk(a0 * c0 - b0 * s0, a1 * c1 - b1 * s1); y2[e >> 1] = cvtpk(b0 * c0 + a0 * s0, b1 * c1 + a1 * s1);
        }
        qf[4] = __builtin_bit_cast(bf16x8, y1); qf[5] = __builtin_bit_cast(bf16x8, y2); }
    __syncthreads();
    *(LAS u32x4*)(lds + dV) = sV; *(LAS u32x4*)(lds + dK) = sK; if (tid < 256) *(LAS u32x4*)(lds + dR) = sR;
    __syncthreads();
    f32x16 o0, o1;
#pragma unroll
    for (int i = 0; i < 16; ++i) { o0[i] = 0.f; o1[i] = 0.f; }
    float mref = 0.f, l = 0.f;
    const int i16 = lane & 15, q4 = i16 >> 2, p4 = i16 & 3, blk = (lane >> 4) & 1;
    const int vo0 = q4 * VP + (((0 + 2 * blk + (p4 >> 1)) ^ (((q4 >> 1) & 1) << 2)) * 16) + (p4 & 1) * 8 + 4 * hf * VP;
    const int vo1 = q4 * VP + (((4 + 2 * blk + (p4 >> 1)) ^ (((q4 >> 1) & 1) << 2)) * 16) + (p4 & 1) * 8 + 4 * hf * VP;
    for (int t = 0; t < NT; ++t) {
        const int buf = t & 1;
        if (t + 1 < NT) { const size_t adv = (size_t)(t + 1) * 64; sV = *(const u32x4*)(gV + adv * 1024); sK = *(const u32x4*)(gK + adv * 1024); if (tid < 256) sR = *(const u32x4*)(gR + adv * 32); }
        const int kv0 = 64 * t;
        if (kv0 <= Q0 + 32 * w + 31) {
            f32x16 p0, p1;
#pragma unroll
            for (int i = 0; i < 16; ++i) { p0[i] = 0.f; p1[i] = 0.f; }
            const LAS unsigned char* kb = lds + L_K + buf * KBUF + q32 * KP + hf * 16;
#pragma unroll
            for (int ks = 0; ks < 6; ++ks) {
                const bf16x8 a0 = *(const LAS bf16x8*)(kb + ks * 32), a1 = *(const LAS bf16x8*)(kb + 32 * KP + ks * 32);
                p0 = PA_MFMA(a0, qf[ks], p0); p1 = PA_MFMA(a1, qf[ks], p1);
            }
            if (kv0 + 63 > Q0 + 32 * w) {
#pragma unroll
                for (int i = 0; i < 16; ++i) { const int kvg = kv0 + crow(i, hf); if (kvg > qg) p0[i] = -INFINITY; if (kvg + 32 > qg) p1[i] = -INFINITY; }
            }
            float rm = fmaxf(p0[0], p1[0]);
#pragma unroll
            for (int i = 1; i < 16; ++i) rm = fmaxf(rm, fmaxf(p0[i], p1[i]));
            rm = fmaxf(rm, __shfl_xor(rm, 32));
            if (t == 0) mref = rm == -INFINITY ? 0.f : rm;
            else if (__any(rm > mref + 8.f)) { const float mn = fmaxf(mref, rm), al = __builtin_amdgcn_exp2f(mref - mn); l *= al; mref = mn;
#pragma unroll
                for (int i = 0; i < 16; ++i) { o0[i] *= al; o1[i] *= al; } }
            float ls = 0.f;
#pragma unroll
            for (int i = 0; i < 16; ++i) { p0[i] = __builtin_amdgcn_exp2f(p0[i] - mref); p1[i] = __builtin_amdgcn_exp2f(p1[i] - mref); ls += p0[i] + p1[i]; }
            l += ls;
            const bf16x8 pb0 = pack8(p0, 0), pb1 = pack8(p0, 1), pb2 = pack8(p1, 0), pb3 = pack8(p1, 1);
            const LAS unsigned char* vb = lds + L_V + buf * VBUF;
#define PA_PV(PB, RB) do { const s16x4 l0 = vtr(vb + (RB) * VP + vo0), h0 = vtr(vb + ((RB) + 8) * VP + vo0), l1 = vtr(vb + (RB) * VP + vo1), h1 = vtr(vb + ((RB) + 8) * VP + vo1); \
                const bf16x8 a0 = __builtin_shufflevector(l0, h0, 0, 1, 2, 3, 4, 5, 6, 7), a1 = __builtin_shufflevector(l1, h1, 0, 1, 2, 3, 4, 5, 6, 7); \
                o0 = PA_MFMA(a0, PB, o0); o1 = PA_MFMA(a1, PB, o1); } while (0)
            PA_PV(pb0, 0); PA_PV(pb1, 16); PA_PV(pb2, 32); PA_PV(pb3, 48);
#undef PA_PV
        }
        if (t + 1 < NT) { const int nb = (buf ^ 1); *(LAS u32x4*)(lds + nb * VBUF + dV) = sV; *(LAS u32x4*)(lds + nb * KBUF + dK) = sK; if (tid < 256) *(LAS u32x4*)(lds + nb * KBUF + dR) = sR; }
        __syncthreads();
    }
    l += __shfl_xor(l, 32);
    const float il = 1.f / l;
    const size_t row = rowb + qg;
    const bf16* az = T.ZB + row * 3072 + ZAZ + h * 64 + 4 * hf; bf16* yo = T.YCAT + row * 1024 + 512 + h * 64 + 4 * hf;
#pragma unroll
    for (int d = 0; d < 2; ++d)
#pragma unroll
        for (int g = 0; g < 4; ++g) { const u32x2 a = *(const u32x2*)(az + 32 * d + 8 * g);
            const float z0 = bf2f((unsigned short)(a.x & 0xffff)), z1 = bf2f((unsigned short)(a.x >> 16)), z2 = bf2f((unsigned short)(a.y & 0xffff)), z3 = bf2f((unsigned short)(a.y >> 16));
            const f32x16& o = d == 0 ? o0 : o1;
            u32x2 r; r.x = cvtpk(o[4 * g] * il * siluf_(z0), o[4 * g + 1] * il * siluf_(z1)); r.y = cvtpk(o[4 * g + 2] * il * siluf_(z2), o[4 * g + 3] * il * siluf_(z3));
            *(u32x2*)(yo + 32 * d + 8 * g) = r; }
}
__device__ __forceinline__ void phase(LAS unsigned char* lds, const Tensors& T, int vcu, int G) {
    for (int v = vcu; v < 256; v += G) { const int bh = v >> 4, s = v & 15;
        unit(lds, T, bh >> 3, bh & 7, 31 - s); unit(lds, T, bh >> 3, bh & 7, s); }
}
}
struct PAArgs { pa::Tensors T; };
__global__ void __launch_bounds__(512, 2) k_attn_prompt(PAArgs a) {
    extern __shared__ __attribute__((aligned(16))) unsigned char lds[];
    pa::phase((LAS unsigned char*)lds, a.T, (int)blockIdx.x, (int)gridDim.x);
}
namespace sa {
typedef short bf16x8 __attribute__((ext_vector_type(8)));
typedef short s16x4 __attribute__((ext_vector_type(4)));
typedef float f32x16 __attribute__((ext_vector_type(16)));
typedef float f32x4 __attribute__((ext_vector_type(4)));
typedef unsigned u32x4 __attribute__((ext_vector_type(4)));
typedef unsigned u32x2 __attribute__((ext_vector_type(2)));
constexpr int NSPLIT = 2, PPS = NPAGES / NSPLIT;
constexpr int KP = 592, PP = 272;
constexpr int L_KT = 0, L_Q = 128 * KP, L_P = L_Q + 64 * KP, L_SMAX = L_P + 64 * PP, L_SSUM = L_SMAX + 4 * 64 * 4, LDS_BYTES = L_SSUM + 4 * 64 * 4;
using pa::cvtpk; using pa::vtr; using pa::crow;
#define SA_MFMA(a, b, c) __builtin_amdgcn_mfma_f32_32x32x16_bf16((a), (b), (c), 0, 0, 0)
struct Tensors { const bf16* Q96; const bf16* WUKB; const float* cache_ckv; const float* cache_kr; const int* page_table; const float* ckv_new; const bf16* KRB; const float* ropet;
                 float* PARTO; float* PARTML; };

__device__ __forceinline__ void unit(LAS unsigned char* lds, const Tensors& T, int b, int sp) {
    const int tid = threadIdx.x, lane = tid & 63, w = __builtin_amdgcn_readfirstlane(tid >> 6), q32 = lane & 31, hf = lane >> 5;
    __syncthreads();
    {   const int h = w;
        bf16x8 qb[4];
#pragma unroll
        for (int ks = 0; ks < 4; ++ks) { bf16x8 z = {0, 0, 0, 0, 0, 0, 0, 0}; qb[ks] = q32 < DS ? *(const bf16x8*)(T.Q96 + (size_t)(MP + b * DS + q32) * 768 + h * 96 + 16 * ks + 8 * hf) : z; }
#pragma unroll
        for (int cb = 0; cb < 8; ++cb) {
            f32x16 acc;
#pragma unroll
            for (int i = 0; i < 16; ++i) acc[i] = 0.f;
#pragma unroll
            for (int ks = 0; ks < 4; ++ks) { const bf16x8 a = *(const bf16x8*)(T.WUKB + (size_t)(32 * cb + q32) * 512 + h * 64 + 16 * ks + 8 * hf); acc = SA_MFMA(a, qb[ks], acc); }
            if (q32 < DS) {
#pragma unroll
                for (int g = 0; g < 4; ++g) { u32x2 r; r.x = cvtpk(acc[4 * g], acc[4 * g + 1]); r.y = cvtpk(acc[4 * g + 2], acc[4 * g + 3]);
                    *(LAS u32x2*)(lds + L_Q + (h * 8 + q32) * KP + (32 * cb + 8 * g + 4 * hf) * 2) = r; }
            }
        }
#pragma unroll
        for (int e = 0; e < 2; ++e) { const int id = tid + 512 * e, r = id >> 4, j = id & 15, hh = r >> 3, t = r & 7;
            const bf16* qs = T.Q96 + (size_t)(MP + b * DS + t) * 768 + hh * 96 + 64; const float* tb = T.ropet + (size_t)(PAST + t) * 32;
            const float x1 = bf2f(qs[j]), x2 = bf2f(qs[16 + j]), cs = tb[j], sn = tb[16 + j];
            *(LAS unsigned short*)(lds + L_Q + r * KP + (256 + j) * 2) = f2bf(x1 * cs - x2 * sn); *(LAS unsigned short*)(lds + L_Q + r * KP + (272 + j) * 2) = f2bf(x2 * cs + x1 * sn); }
    }
    f32x4 st[18];
    const int pg0 = sp * PPS;
    auto issue = [&](int page) {
        const int phys = T.page_table[b * NPAGES + page];
        const float* gc = T.cache_ckv + (size_t)phys * (PAGE * KVL) + tid * 4; const float* gr = T.cache_kr + (size_t)phys * (PAGE * ROPE) + tid * 4;
#pragma unroll
        for (int j = 0; j < 16; ++j) st[j] = __builtin_nontemporal_load((const f32x4*)(gc + j * 2048));
#pragma unroll
        for (int j = 0; j < 2; ++j) st[16 + j] = __builtin_nontemporal_load((const f32x4*)(gr + j * 2048));
    };
    issue(pg0);
    f32x16 o0, o1;
#pragma unroll
    for (int i = 0; i < 16; ++i) { o0[i] = 0.f; o1[i] = 0.f; }
    float mrun0 = -INFINITY, mrun1 = -INFINITY, lrun0 = 0.f, lrun1 = 0.f;
    const int kvb = w >> 1, qbk = w & 1;
    const int i16 = lane & 15, q4 = i16 >> 2, p4 = i16 & 3, blk = (lane >> 4) & 1;
    const int vo = (8 * hf + q4) * KP + 64 * w + 32 * blk + 8 * p4;
    const bool has_tail = (sp == NSPLIT - 1);
    const int niter = PPS + (has_tail ? 1 : 0);
    for (int it = 0; it < niter; ++it) {
        const bool tail = (it == PPS);
        const int nblk = tail ? 1 : 4;
        __syncthreads();
        if (!tail) {
#pragma unroll
            for (int j = 0; j < 16; ++j) { const int id = tid + 512 * j, r = id >> 6, c = (id & 63) * 4; u32x2 v; v.x = cvtpk(st[j][0], st[j][1]); v.y = cvtpk(st[j][2], st[j][3]);
                *(LAS u32x2*)(lds + L_KT + r * KP + c * 2) = v; }
#pragma unroll
            for (int j = 0; j < 2; ++j) { const int id = tid + 512 * j, r = id >> 3, c = 256 + (id & 7) * 4; u32x2 v; v.x = cvtpk(st[16 + j][0], st[16 + j][1]); v.y = cvtpk(st[16 + j][2], st[16 + j][3]);
                *(LAS u32x2*)(lds + L_KT + r * KP + c * 2) = v; }
        } else {
            for (int id = tid; id < 32 * 72; id += 512) { const int r = id / 72, c4 = (id % 72) * 4; u32x2 v = {0u, 0u};
                if (r < DS) { if (c4 < KVL) { const f32x4 x = *(const f32x4*)(T.ckv_new + (size_t)(b * DS + r) * KVL + c4); v.x = cvtpk(x[0], x[1]); v.y = cvtpk(x[2], x[3]); }
                              else v = *(const u32x2*)(T.KRB + (size_t)(MP + b * DS + r) * ROPE + (c4 - KVL)); }
                *(LAS u32x2*)(lds + L_KT + r * KP + c4 * 2) = v; }
        }
        __syncthreads();
        if (it + 1 < PPS) issue(pg0 + it + 1);
        f32x16 s;
        float lmax = -INFINITY;
        if (kvb < nblk) {
#pragma unroll
            for (int i = 0; i < 16; ++i) s[i] = 0.f;
            const LAS unsigned char* ka = lds + L_KT + (32 * kvb + q32) * KP + hf * 16; const LAS unsigned char* qa = lds + L_Q + (32 * qbk + q32) * KP + hf * 16;
#pragma unroll
            for (int ks = 0; ks < 18; ++ks) s = SA_MFMA(*(const LAS bf16x8*)(ka + ks * 32), *(const LAS bf16x8*)(qa + ks * 32), s);
            if (tail) {
#pragma unroll
                for (int i = 0; i < 16; ++i) if (crow(i, hf) > (q32 & 7)) s[i] = -INFINITY;
            }
#pragma unroll
            for (int i = 0; i < 16; ++i) lmax = fmaxf(lmax, s[i]);
            lmax = fmaxf(lmax, __shfl_xor(lmax, 32));
        }
        if (hf == 0) *(LAS float*)(lds + L_SMAX + (kvb * 64 + 32 * qbk + q32) * 4) = lmax;
        __syncthreads();
        float tm0 = -INFINITY, tm1 = -INFINITY;
#pragma unroll
        for (int k = 0; k < 4; ++k) { tm0 = fmaxf(tm0, *(const LAS float*)(lds + L_SMAX + (k * 64 + q32) * 4)); tm1 = fmaxf(tm1, *(const LAS float*)(lds + L_SMAX + (k * 64 + 32 + q32) * 4)); }
        const float mn0 = fmaxf(mrun0, tm0), mn1 = fmaxf(mrun1, tm1);
        const float al0 = __builtin_amdgcn_exp2f(mrun0 - mn0), al1 = __builtin_amdgcn_exp2f(mrun1 - mn1);
        mrun0 = mn0; mrun1 = mn1;
        float lsum = 0.f;
        if (kvb < nblk) {
            const float mn = qbk ? mn1 : mn0;
#pragma unroll
            for (int i = 0; i < 16; ++i) { s[i] = __builtin_amdgcn_exp2f(s[i] - mn); lsum += s[i]; }
            lsum += __shfl_xor(lsum, 32);
#pragma unroll
            for (int g = 0; g < 4; ++g) { u32x2 r; r.x = cvtpk(s[4 * g], s[4 * g + 1]); r.y = cvtpk(s[4 * g + 2], s[4 * g + 3]);
                *(LAS u32x2*)(lds + L_P + (32 * qbk + q32) * PP + (32 * kvb + 8 * g + 4 * hf) * 2) = r; }
        }
        if (hf == 0) *(LAS float*)(lds + L_SSUM + (kvb * 64 + 32 * qbk + q32) * 4) = lsum;
        __syncthreads();
        float ts0 = 0.f, ts1 = 0.f;
#pragma unroll
        for (int k = 0; k < 4; ++k) { ts0 += *(const LAS float*)(lds + L_SSUM + (k * 64 + q32) * 4); ts1 += *(const LAS float*)(lds + L_SSUM + (k * 64 + 32 + q32) * 4); }
        lrun0 = lrun0 * al0 + ts0; lrun1 = lrun1 * al1 + ts1;
#pragma unroll
        for (int i = 0; i < 16; ++i) { o0[i] *= al0; o1[i] *= al1; }
        const LAS unsigned char* vb = lds + L_KT + vo; const LAS unsigned char* pb = lds + L_P + q32 * PP + hf * 16;
        const int nks = 2 * nblk;
#pragma unroll 2
        for (int ks = 0; ks < nks; ++ks) {
            const s16x4 lo = vtr(vb + (16 * ks) * KP), hi = vtr(vb + (16 * ks + 4) * KP);
            const bf16x8 a = __builtin_shufflevector(lo, hi, 0, 1, 2, 3, 4, 5, 6, 7);
            o0 = SA_MFMA(a, *(const LAS bf16x8*)(pb + ks * 32), o0); o1 = SA_MFMA(a, *(const LAS bf16x8*)(pb + 32 * PP + ks * 32), o1);
        }
    }
    float* po = T.PARTO + (size_t)(b * NSPLIT + sp) * 64 * KVL;
#pragma unroll
    for (int g = 0; g < 4; ++g) {
        *(f32x4*)(po + (size_t)q32 * KVL + 32 * w + 8 * g + 4 * hf) = (f32x4){o0[4 * g], o0[4 * g + 1], o0[4 * g + 2], o0[4 * g + 3]};
        *(f32x4*)(po + (size_t)(32 + q32) * KVL + 32 * w + 8 * g + 4 * hf) = (f32x4){o1[4 * g], o1[4 * g + 1], o1[4 * g + 2], o1[4 * g + 3]};
    }
    if (w == 0 && hf == 0) { float* pm = T.PARTML + (size_t)(b * NSPLIT + sp) * 128; pm[q32] = mrun0; pm[32 + q32] = mrun1; pm[64 + q32] = lrun0; pm[96 + q32] = lrun1; }
}
__device__ __forceinline__ void phase(LAS unsigned char* lds, const Tensors& T, int vcu, int G) {
    for (int v = vcu; v < DB * NSPLIT; v += G) unit(lds, T, v / NSPLIT, v % NSPLIT);
}
}
struct SAArgs { sa::Tensors T; };
__global__ void __launch_bounds__(512, 2) k_attn_sample(SAArgs a) {
    extern __shared__ __attribute__((aligned(16))) unsigned char lds[];
    sa::phase((LAS unsigned char*)lds, a.T, (int)blockIdx.x, (int)gridDim.x);
}
__global__ void __launch_bounds__(512) k_scomb(const float* __restrict__ PARTO, const float* __restrict__ PARTML, const float* __restrict__ w_uv, float* __restrict__ OMLA) {
    __shared__ float os[MH * KVL];
    const int ms = blockIdx.x, b = ms >> 3, t = ms & 7, tid = threadIdx.x, h = tid >> 6;
    for (int e = tid; e < MH * KVL; e += 512) { const int hh = e >> 8, c = e & 255, q = hh * 8 + t;
        float mm = -INFINITY;
        for (int sp = 0; sp < sa::NSPLIT; ++sp) mm = fmaxf(mm, PARTML[(size_t)(b * sa::NSPLIT + sp) * 128 + q]);
        float num = 0.f, den = 0.f;
        for (int sp = 0; sp < sa::NSPLIT; ++sp) { const float* pm = PARTML + (size_t)(b * sa::NSPLIT + sp) * 128; const float f = exp2f(pm[q] - mm);
            num += f * PARTO[((size_t)(b * sa::NSPLIT + sp) * 64 + q) * KVL + c]; den += f * pm[64 + q]; }
        os[e] = num / den; }
    __syncthreads();
    float acc = 0.f;
    for (int c = 0; c < KVL; ++c) acc += os[h * KVL + c] * w_uv[(size_t)c * 512 + tid];
    OMLA[(size_t)(MP + ms) * 512 + tid] = acc;
}
namespace ml {
typedef short bf16x8 __attribute__((ext_vector_type(8)));
typedef short s16x4 __attribute__((ext_vector_type(4)));
typedef float f32x16 __attribute__((ext_vector_type(16)));
typedef float f32x4 __attribute__((ext_vector_type(4)));
typedef unsigned u32x4 __attribute__((ext_vector_type(4)));
typedef unsigned u32x2 __attribute__((ext_vector_type(2)));
using pa::cvtpk; using pa::vtr; using pa::crow;
#define ML_MFMA(a, b, c) __builtin_amdgcn_mfma_f32_32x32x16_bf16((a), (b), (c), 0, 0, 0)
constexpr int RP = 272;
constexpr int L_Q = 0, L_K = 128 * RP, L_V = 2 * 128 * RP, L_C = L_V + 32768, L_F = L_C + 32768, L_B = L_F + 512, L_M = L_B + 512, L_N = L_M + 512, L_X = L_N + 512, LDS_BYTES = L_X + 2048;
__device__ __forceinline__ int swz(int r) { return (((r >> 1) & 1) << 2) ^ ((r & 1) << 3); }
__device__ __forceinline__ int tr_dst(int row, int c16) { return row * 256 + ((c16 ^ swz(row)) * 16); }
__device__ __forceinline__ int tr_off(int lane, int cb) { const int i16 = lane & 15, q4 = i16 >> 2, p4 = i16 & 3, blk = (lane >> 4) & 1; return q4 * 256 + (((4 * cb + 2 * blk + (p4 >> 1)) ^ swz(q4)) * 16) + (p4 & 1) * 8; }
__device__ __forceinline__ bf16x8 tr_frag(const LAS unsigned char* p, int second_rows) { const s16x4 lo = vtr(p), hi = vtr(p + second_rows * 256); return __builtin_shufflevector(lo, hi, 0, 1, 2, 3, 4, 5, 6, 7); }

__device__ __forceinline__ void chunk_gates(LAS unsigned char* lds, const float* GATES, size_t row0, int h, float bi, float bf_, int lane) {
    const float* g0 = GATES + (row0 + 2 * lane) * 8; const float* g1 = g0 + 8;
    const float x0 = logsigmoidf_(g0[4 + h] + bf_), x1 = logsigmoidf_(g1[4 + h] + bf_), i0 = g0[h] + bi, i1 = g1[h] + bi;
    float sc = x0 + x1;
#pragma unroll
    for (int o = 1; o < 64; o <<= 1) { const float y = __shfl_up(sc, o); if (lane >= o) sc += y; }
    const float F1 = sc, F0 = sc - x1, b0 = i0 - F0, b1 = i1 - F1;
    float mx = fmaxf(b0, b1);
#pragma unroll
    for (int o = 1; o < 64; o <<= 1) { const float y = __shfl_up(mx, o); if (lane >= o) mx = fmaxf(mx, y); }
    float pm = __shfl_up(mx, 1); if (lane == 0) pm = -INFINITY;
    LAS float* F = (LAS float*)(lds + L_F); LAS float* B = (LAS float*)(lds + L_B); LAS float* M = (LAS float*)(lds + L_M);
    F[2 * lane] = F0; F[2 * lane + 1] = F1; B[2 * lane] = b0; B[2 * lane + 1] = b1; M[2 * lane] = fmaxf(pm, b0); M[2 * lane + 1] = mx;
}

struct TensorsA { const bf16* ZB; const float* GATES; const float* b_i; const float* b_f; float* G; float* U; float* DC; float* DN; };
__device__ __forceinline__ void unit_a(LAS unsigned char* lds, const TensorsA& T, int ci) {
    const int tid = threadIdx.x, lane = tid & 63, w = __builtin_amdgcn_readfirstlane(tid >> 6), q32 = lane & 31, hf = lane >> 5;
    const int bh = ci / NCH, c = ci % NCH, b = bh / LH, h = bh % LH;
    const size_t row0 = (size_t)b * SP + (size_t)c * LC;
    __syncthreads();
    if (w == 0) chunk_gates(lds, T.GATES, row0, h, T.b_i[h], T.b_f[h], lane);
    u32x4 sk[4], sv[4];
#pragma unroll
    for (int j = 0; j < 4; ++j) { const int id = tid + 512 * j, r = id >> 4, c16 = id & 15; const bf16* z = T.ZB + (row0 + r) * 3072 + h * 128 + c16 * 8; sk[j] = *(const u32x4*)(z + ZK); sv[j] = *(const u32x4*)(z + ZV); }
    __syncthreads();
    const float Mx = *(const LAS float*)(lds + L_M + 127 * 4);
#pragma unroll
    for (int j = 0; j < 4; ++j) { const int id = tid + 512 * j, r = id >> 4, c16 = id & 15;
        const float wgt = __expf(*(const LAS float*)(lds + L_B + r * 4) - Mx);
        u32x4 kw;
#pragma unroll
        for (int e = 0; e < 4; ++e) kw[e] = cvtpk(bf2f((unsigned short)(sk[j][e] & 0xffff)) * wgt, bf2f((unsigned short)(sk[j][e] >> 16)) * wgt);
        *(LAS u32x4*)(lds + L_V + tr_dst(r, c16)) = kw; *(LAS u32x4*)(lds + L_C + tr_dst(r, c16)) = sv[j]; }
    __syncthreads();
    const int dkb = w >> 1, dvb0 = 2 * (w & 1);
    const int oa = tr_off(lane, dkb) + 8 * hf * 256, ob0 = tr_off(lane, dvb0) + 8 * hf * 256, ob1 = tr_off(lane, dvb0 + 1) + 8 * hf * 256;
    f32x16 a0, a1;
#pragma unroll
    for (int i = 0; i < 16; ++i) { a0[i] = 0.f; a1[i] = 0.f; }
#pragma unroll
    for (int ks = 0; ks < 8; ++ks) { const bf16x8 fa = tr_frag(lds + L_V + ks * 16 * 256 + oa, 4), fb0 = tr_frag(lds + L_C + ks * 16 * 256 + ob0, 4), fb1 = tr_frag(lds + L_C + ks * 16 * 256 + ob1, 4);
        a0 = ML_MFMA(fa, fb0, a0); a1 = ML_MFMA(fa, fb1, a1); }
    float* dc = T.DC + (size_t)ci * DK * DV;
#pragma unroll
    for (int i = 0; i < 16; ++i) { const int dk = 32 * dkb + crow(i, hf); dc[(size_t)dk * DV + 32 * dvb0 + q32] = a0[i]; dc[(size_t)dk * DV + 32 * dvb0 + 32 + q32] = a1[i]; }
    if (tid < DK) { float s = 0.f; const int c16 = tid >> 3, e = tid & 7;
        for (int r = 0; r < LC; ++r) s += bf2f(*(const LAS unsigned short*)(lds + L_V + tr_dst(r, c16) + e * 2));
        T.DN[(size_t)ci * DK + tid] = s; }
    if (tid == 0) { const float g = *(const LAS float*)(lds + L_F + 127 * 4); T.G[ci] = g; T.U[ci] = g + Mx; }
}

struct TensorsC { const bf16* ZB; const float* GATES; const float* b_i; const float* b_f; const float* CS; const float* NS; const float* MSs; const float* gn; bf16* YCAT; };
__device__ __forceinline__ void unit_c(LAS unsigned char* lds, const TensorsC& T, int ci) {
    const int tid = threadIdx.x, lane = tid & 63, w = __builtin_amdgcn_readfirstlane(tid >> 6), q32 = lane & 31, hf = lane >> 5;
    const int bh = ci / NCH, c = ci % NCH, b = bh / LH, h = bh % LH;
    const size_t row0 = (size_t)b * SP + (size_t)c * LC;
    __syncthreads();
    if (w == 0) chunk_gates(lds, T.GATES, row0, h, T.b_i[h], T.b_f[h], lane);
    if (tid >= 64 && tid < 64 + DK) *(LAS float*)(lds + L_N + (tid - 64) * 4) = T.NS[(size_t)ci * DK + tid - 64];
#pragma unroll
    for (int j = 0; j < 4; ++j) { const int id = tid + 512 * j, r = id >> 4, c16 = id & 15; const bf16* z = T.ZB + (row0 + r) * 3072 + h * 128 + c16 * 8;
        const u32x4 q = *(const u32x4*)(z + ZQ), k = *(const u32x4*)(z + ZK), v = *(const u32x4*)(z + ZV);
        *(LAS u32x4*)(lds + L_Q + r * RP + c16 * 16) = q; *(LAS u32x4*)(lds + L_K + r * RP + c16 * 16) = k; *(LAS u32x4*)(lds + L_V + tr_dst(r, c16)) = v; }
    {   const float* cs = T.CS + (size_t)ci * DK * DV;
#pragma unroll
        for (int j = 0; j < 8; ++j) { const int id = tid + 512 * j, r = id >> 5, c4 = (id & 31) * 4; const f32x4 x = *(const f32x4*)(cs + (size_t)r * DV + c4);
            u32x2 y; y.x = cvtpk(x[0], x[1]); y.y = cvtpk(x[2], x[3]);
            *(LAS u32x2*)(lds + L_C + tr_dst(r, c4 >> 3) + (c4 & 7) * 2) = y; } }
    __syncthreads();
    const int tb = w >> 1, dh = w & 1, t = 32 * tb + q32;
    const float mprev = T.MSs[ci];
    const float mu = fmaxf(mprev, *(const LAS float*)(lds + L_M + t * 4)), a_t = __expf(mprev - mu), m_t = *(const LAS float*)(lds + L_F + t * 4) + mu;
    bf16x8 qf[8]; float qn = 0.f;
#pragma unroll
    for (int ks = 0; ks < 8; ++ks) { qf[ks] = *(const LAS bf16x8*)(lds + L_Q + t * RP + ks * 32 + hf * 16);
#pragma unroll
        for (int e = 0; e < 8; ++e) qn += bf2f((unsigned short)qf[ks][e]) * *(const LAS float*)(lds + L_N + (16 * ks + 8 * hf + e) * 4); }
    qn += __shfl_xor(qn, 32);
    const int oc0 = tr_off(lane, 2 * dh) + 8 * hf * 256, oc1 = tr_off(lane, 2 * dh + 1) + 8 * hf * 256;
    f32x16 acc0, acc1;
#pragma unroll
    for (int i = 0; i < 16; ++i) { acc0[i] = 0.f; acc1[i] = 0.f; }
#pragma unroll
    for (int ks = 0; ks < 8; ++ks) { acc0 = ML_MFMA(tr_frag(lds + L_C + ks * 16 * 256 + oc0, 4), qf[ks], acc0); acc1 = ML_MFMA(tr_frag(lds + L_C + ks * 16 * 256 + oc1, 4), qf[ks], acc1); }
#pragma unroll
    for (int i = 0; i < 16; ++i) { acc0[i] *= a_t; acc1[i] *= a_t; }
    const int ov0 = tr_off(lane, 2 * dh) + 4 * hf * 256, ov1 = tr_off(lane, 2 * dh + 1) + 4 * hf * 256;
    float den = 0.f;
    for (int sb = 0; sb <= tb; ++sb) {
        f32x16 s;
#pragma unroll
        for (int i = 0; i < 16; ++i) s[i] = 0.f;
        const LAS unsigned char* ka = lds + L_K + (32 * sb + q32) * RP + hf * 16;
#pragma unroll
        for (int ks = 0; ks < 8; ++ks) s = ML_MFMA(*(const LAS bf16x8*)(ka + ks * 32), qf[ks], s);
#pragma unroll
        for (int i = 0; i < 16; ++i) { const int sidx = 32 * sb + crow(i, hf); const float wg = sidx <= t ? __expf(*(const LAS float*)(lds + L_B + sidx * 4) - mu) : 0.f; s[i] *= wg; den += s[i]; }
        const bf16x8 p0 = pa::pack8(s, 0), p1 = pa::pack8(s, 1);
        const LAS unsigned char* vb = lds + L_V + (32 * sb) * 256;
        acc0 = ML_MFMA(tr_frag(vb + ov0, 8), p0, acc0); acc1 = ML_MFMA(tr_frag(vb + ov1, 8), p0, acc1);
        acc0 = ML_MFMA(tr_frag(vb + 16 * 256 + ov0, 8), p1, acc0); acc1 = ML_MFMA(tr_frag(vb + 16 * 256 + ov1, 8), p1, acc1);
    }
    den += __shfl_xor(den, 32);
    den += a_t * qn;
    const float inv = 1.f / fmaxf(fabsf(den), __expf(-m_t));
    const size_t row = row0 + t;
    const bf16* zo = T.ZB + row * 3072 + ZO + h * 128 + 64 * dh + 4 * hf; const bf16* zz = T.ZB + row * 3072 + ZZ + h * 128 + 64 * dh + 4 * hf;
    float sum = 0.f, ssq = 0.f;
#pragma unroll
    for (int j = 0; j < 2; ++j)
#pragma unroll
        for (int g = 0; g < 4; ++g) { const u32x2 o = *(const u32x2*)(zo + 32 * j + 8 * g); f32x16& a = j == 0 ? acc0 : acc1;
            a[4 * g] = a[4 * g] * inv * sigmoidf_(bf2f((unsigned short)(o.x & 0xffff))); a[4 * g + 1] = a[4 * g + 1] * inv * sigmoidf_(bf2f((unsigned short)(o.x >> 16)));
            a[4 * g + 2] = a[4 * g + 2] * inv * sigmoidf_(bf2f((unsigned short)(o.y & 0xffff))); a[4 * g + 3] = a[4 * g + 3] * inv * sigmoidf_(bf2f((unsigned short)(o.y >> 16)));
            sum += (a[4 * g] + a[4 * g + 1]) + (a[4 * g + 2] + a[4 * g + 3]); ssq += (a[4 * g] * a[4 * g] + a[4 * g + 1] * a[4 * g + 1]) + (a[4 * g + 2] * a[4 * g + 2] + a[4 * g + 3] * a[4 * g + 3]); }
    sum += __shfl_xor(sum, 32); ssq += __shfl_xor(ssq, 32);
    LAS float* X = (LAS float*)(lds + L_X);
    if (hf == 0) { X[(t * 2 + dh) * 2] = sum; X[(t * 2 + dh) * 2 + 1] = ssq; }
    __syncthreads();
    sum += X[(t * 2 + (dh ^ 1)) * 2]; ssq += X[(t * 2 + (dh ^ 1)) * 2 + 1];
    const float mean = sum * (1.f / DV), var = fmaxf(ssq * (1.f / DV) - mean * mean, 0.f), rs = rsqrtf(var + EPS);
    const float* gnp = T.gn + h * 128 + 64 * dh + 4 * hf; bf16* yo = T.YCAT + row * 1024 + h * 128 + 64 * dh + 4 * hf;
#pragma unroll
    for (int j = 0; j < 2; ++j)
#pragma unroll
        for (int g = 0; g < 4; ++g) { const u32x2 z = *(const u32x2*)(zz + 32 * j + 8 * g); const f32x4 gv = *(const f32x4*)(gnp + 32 * j + 8 * g); const f32x16& a = j == 0 ? acc0 : acc1;
            u32x2 r; r.x = cvtpk((a[4 * g] - mean) * rs * gv[0] * siluf_(bf2f((unsigned short)(z.x & 0xffff))), (a[4 * g + 1] - mean) * rs * gv[1] * siluf_(bf2f((unsigned short)(z.x >> 16))));
            r.y = cvtpk((a[4 * g + 2] - mean) * rs * gv[2] * siluf_(bf2f((unsigned short)(z.y & 0xffff))), (a[4 * g + 3] - mean) * rs * gv[3] * siluf_(bf2f((unsigned short)(z.y >> 16))));
            *(u32x2*)(yo + 32 * j + 8 * g) = r; }
}
}
struct MLAArgs { ml::TensorsA T; };
__global__ void __launch_bounds__(512, 2) k_ml_a2(MLAArgs a) {
    extern __shared__ __attribute__((aligned(16))) unsigned char lds[];
    for (int ci = blockIdx.x; ci < BP * LH * NCH; ci += gridDim.x) ml::unit_a((LAS unsigned char*)lds, a.T, ci);
}
struct MLCArgs { ml::TensorsC T; };
__global__ void __launch_bounds__(512, 2) k_ml_c2(MLCArgs a) {
    extern __shared__ __attribute__((aligned(16))) unsigned char lds[];
    for (int ci = blockIdx.x; ci < BP * LH * NCH; ci += gridDim.x) ml::unit_c((LAS unsigned char*)lds, a.T, ci);
}

static void launch_gemm(const bf16* A, const bf16* Bt, float* C, int M, int N, int K, int ldc, hipStream_t stream) {
    GemmArgs a{}; a.A = A; a.Bt = Bt; a.C = C; a.M = M; a.N = N; a.K = K; a.ldc = ldc;
    hipLaunchKernelGGL(k_gemm_f32, dim3(256), dim3(512), pg8::STAGE_BYTES, stream, a);
}
extern "C" void kernel_launch(void* const* d_in, const int* in_sizes, int n_in, void* d_out, int out_size, void* d_ws, size_t ws_size, hipStream_t stream) {
    static int ready = 0;
    if (ready == 0) {
        if (n_in != 24 || out_size != (int)O_END || ws_size < WS_END) { fprintf(stderr, "kernel_launch: unexpected shapes: n_in %d out %d ws %zu\n", n_in, out_size, ws_size); ready = -1; return; }
        const void* gk[4] = {(const void*)k_gemm_f32, (const void*)k_gemm_inproj, (const void*)k_gemm_q, (const void*)k_gemm_kv};
        if (hipFuncSetAttribute((const void*)k_ml_a2, hipFuncAttributeMaxDynamicSharedMemorySize, ml::LDS_BYTES) != hipSuccess || hipFuncSetAttribute((const void*)k_ml_c2, hipFuncAttributeMaxDynamicSharedMemorySize, ml::LDS_BYTES) != hipSuccess) { fprintf(stderr, "kernel_launch: hipFuncSetAttribute failed\n"); ready = -1; return; }
        if (hipFuncSetAttribute((const void*)k_attn_sample, hipFuncAttributeMaxDynamicSharedMemorySize, sa::LDS_BYTES) != hipSuccess) { fprintf(stderr, "kernel_launch: hipFuncSetAttribute failed\n"); ready = -1; return; }
        for (int i = 0; i < 4; ++i) if (hipFuncSetAttribute(gk[i], hipFuncAttributeMaxDynamicSharedMemorySize, pg8::STAGE_BYTES) != hipSuccess) { fprintf(stderr, "kernel_launch: hipFuncSetAttribute failed\n"); ready = -1; return; }
        ready = 1;
    }
    if (ready < 0) return;
    const float* xp = (const float*)d_in[0]; const float* xs = (const float*)d_in[1]; const float* cp = (const float*)d_in[2]; const float* cs = (const float*)d_in[3];
    const float* cache_ckv = (const float*)d_in[4]; const float* cache_kr = (const float*)d_in[5]; const float* st_C = (const float*)d_in[6]; const float* st_n = (const float*)d_in[7]; const float* st_m = (const float*)d_in[8];
    const int* page_table = (const int*)d_in[9];
    const float* w_ada = (const float*)d_in[10]; const float* b_ada = (const float*)d_in[11]; const float* w_in = (const float*)d_in[12]; const float* b_i = (const float*)d_in[13]; const float* b_f = (const float*)d_in[14];
    const float* ml_gn = (const float*)d_in[15]; const float* qnorm = (const float*)d_in[16]; const float* kvnorm = (const float*)d_in[17]; const float* w_uq = (const float*)d_in[18]; const float* w_uk = (const float*)d_in[19];
    const float* w_uv = (const float*)d_in[20]; const float* w_out = (const float*)d_in[21]; const float* ln_g = (const float*)d_in[22]; const float* ln_b = (const float*)d_in[23];
    float* out = (float*)d_out; unsigned char* ws = (unsigned char*)d_ws;
    float* MOD = (float*)(ws + WS_MOD); float* ROPET = (float*)(ws + WS_ROPET); bf16* WIN = (bf16*)(ws + WS_WIN); bf16* WUQ = (bf16*)(ws + WS_WUQ); bf16* WKV = (bf16*)(ws + WS_WKV); bf16* WOUT = (bf16*)(ws + WS_WOUT);
    bf16* H = (bf16*)(ws + WS_H); bf16* ZB = (bf16*)(ws + WS_ZB); float* GATES = (float*)(ws + WS_GATES); bf16* CKVR = (bf16*)(ws + WS_CKVR); bf16* CQR = (bf16*)(ws + WS_CQR);
    float* SSKV = (float*)(ws + WS_SSKV); float* SSQ = (float*)(ws + WS_SSQ); bf16* KRB = (bf16*)(ws + WS_KRB); bf16* Q96 = (bf16*)(ws + WS_Q96); bf16* KVB = (bf16*)(ws + WS_KVB);
    float* PARTO = (float*)(ws + WS_PARTO); float* PARTML = (float*)(ws + WS_PARTML); bf16* WUKB = (bf16*)(ws + WS_WUKB);
    float* QLAT = (float*)(ws + WS_QLAT); float* OLAT = (float*)(ws + WS_OLAT); float* OMLA = (float*)(ws + WS_OMLA);
    float* HML = (float*)(ws + WS_HML); float* MLG = (float*)(ws + WS_MLG); float* MLU = (float*)(ws + WS_MLU); float* MLDC = (float*)(ws + WS_MLDC); float* MLDN = (float*)(ws + WS_MLDN);
    float* MLCS = (float*)(ws + WS_MLCS); float* MLNS = (float*)(ws + WS_MLNS); float* MLMS = (float*)(ws + WS_MLMS); bf16* YCAT = (bf16*)(ws + WS_YCAT); float* OUT = (float*)(ws + WS_OUT);

    hipLaunchKernelGGL(k_mod, dim3(12, 10), dim3(256), 0, stream, cp, cs, w_ada, b_ada, MOD);
    hipLaunchKernelGGL(k_ropetab, dim3(((PAST + DS) * 16 + 255) / 256), dim3(256), 0, stream, ROPET);
    hipLaunchKernelGGL(k_wt, dim3(D / 32, NINP / 32), dim3(32, 8), 0, stream, w_in, NIN, D, WIN, 1, (const float*)nullptr);
    hipLaunchKernelGGL(k_wt, dim3(QL / 32, (MH * QHD) / 32), dim3(32, 8), 0, stream, w_uq, MH * QHD, QL, WUQ, 0, qnorm);
    hipLaunchKernelGGL(k_wt, dim3(KVL / 32, 512 / 32), dim3(32, 8), 0, stream, w_uk, 512, KVL, WKV, 0, kvnorm);
    hipLaunchKernelGGL(k_wt, dim3(KVL / 32, 512 / 32), dim3(32, 8), 0, stream, w_uv, 512, KVL, WKV + (size_t)512 * KVL, 0, kvnorm);
    hipLaunchKernelGGL(k_wt, dim3(D / 32, D / 32), dim3(32, 8), 0, stream, w_out, D, D, WOUT, 0, (const float*)nullptr);
    hipLaunchKernelGGL(k_cvt, dim3(KVL * 512 / 4 / 256), dim3(256), 0, stream, w_uk, WUKB, KVL * 512 / 4);
    hipLaunchKernelGGL(k_hprep, dim3(MT), dim3(256), 0, stream, xp, xs, MOD, H);
    { InProjArgs a{}; a.A = H; a.Bt = WIN; a.E.ZB = ZB; a.E.CKVR = CKVR; a.E.CQR = CQR; a.E.SSKV = SSKV; a.E.SSQ = SSQ; a.E.GATES = GATES; a.E.KRB = KRB; a.E.out_krp = out + O_KRP; a.E.out_krs = out + O_KRS; a.E.ropet = ROPET;
      hipLaunchKernelGGL(k_gemm_inproj, dim3(256), dim3(512), pg8::STAGE_BYTES, stream, a); }
    { QArgs a{}; a.A = CQR; a.Bt = WUQ; a.E.Q96 = Q96; a.E.SSQ = SSQ; a.E.qscale = MLA_SCALE * LOG2E;
      hipLaunchKernelGGL(k_gemm_q, dim3(256), dim3(512), pg8::STAGE_BYTES, stream, a); }
    { KVArgs a{}; a.A = CKVR; a.Bt = WKV; a.E.KVB = KVB; a.E.SSKV = SSKV;
      hipLaunchKernelGGL(k_gemm_kv, dim3(256), dim3(512), pg8::STAGE_BYTES, stream, a); }
    hipLaunchKernelGGL(k_rows_ckv, dim3(MT / 4), dim3(256), 0, stream, CKVR, SSKV, kvnorm, out);
    { PAArgs a{}; a.T.Q96 = Q96; a.T.KVB = KVB; a.T.KRB = KRB; a.T.ZB = ZB; a.T.ropet = ROPET; a.T.YCAT = YCAT;
      hipLaunchKernelGGL(k_attn_prompt, dim3(256), dim3(512), pa::LDS_BYTES, stream, a); }
    { SAArgs a{}; a.T.Q96 = Q96; a.T.WUKB = WUKB; a.T.cache_ckv = cache_ckv; a.T.cache_kr = cache_kr; a.T.page_table = page_table; a.T.ckv_new = out + O_CKVS; a.T.KRB = KRB; a.T.ropet = ROPET;
      a.T.PARTO = PARTO; a.T.PARTML = PARTML;
      hipLaunchKernelGGL(k_attn_sample, dim3(256), dim3(512), sa::LDS_BYTES, stream, a); }
    hipLaunchKernelGGL(k_scomb, dim3(MS), dim3(512), 0, stream, PARTO, PARTML, w_uv, OMLA);
    { MLAArgs a{}; a.T.ZB = ZB; a.T.GATES = GATES; a.T.b_i = b_i; a.T.b_f = b_f; a.T.G = MLG; a.T.U = MLU; a.T.DC = MLDC; a.T.DN = MLDN;
      hipLaunchKernelGGL(k_ml_a2, dim3(256), dim3(512), ml::LDS_BYTES, stream, a); }
    hipLaunchKernelGGL(k_ml_b, dim3(BP * LH * (DK * DV + DK) / 256), dim3(256), 0, stream, MLG, MLU, MLDC, MLDN, MLCS, MLNS, MLMS, out);
    { MLCArgs a{}; a.T.ZB = ZB; a.T.GATES = GATES; a.T.b_i = b_i; a.T.b_f = b_f; a.T.CS = MLCS; a.T.NS = MLNS; a.T.MSs = MLMS; a.T.gn = ml_gn; a.T.YCAT = YCAT;
      hipLaunchKernelGGL(k_ml_c2, dim3(256), dim3(512), ml::LDS_BYTES, stream, a); }
    hipLaunchKernelGGL(k_ml_sample, dim3(DB * LH), dim3(256), 0, stream, ZB, GATES, b_i, b_f, st_C, st_n, st_m, HML, out);
    hipLaunchKernelGGL(k_back_rows, dim3(MS / 4), dim3(256), 0, stream, ZB, HML, OMLA, ml_gn, YCAT);
    launch_gemm(YCAT, WOUT, OUT, MT, D, D, D, stream);
    hipLaunchKernelGGL(k_final_ln, dim3(MT / 4), dim3(256), 0, stream, xp, xs, MOD, OUT, ln_g, ln_b, out);
}
```

```cpp
#include <hip/hip_runtime.h>
#include <cstdio>
#include <cstdint>
#include <cmath>

constexpr int D = 1024, BP = 2, SP = 8192, MP = BP * SP, DB = 128, DS = 8, MS = DB * DS, MT = MP + MS;
constexpr int NIN = 3752, NINP = 3840;
constexpr int QL = 384, KVL = 256, ROPE = 32, NOPE = 64, MH = 8, VD = 64, QHD = NOPE + ROPE;
constexpr int LH = 4, DK = 128, DV = 128, LC = 128, NCH = SP / LC;
constexpr int PAGE = 128, NPAGES = 64, PAST = 8192;
constexpr float EPS = 1e-6f, ALPHA = 1.189207115002721f, MLA_SCALE = 0.10206207261596575f  , KSCALE = 0.08838834764831845f  ;
constexpr int ZQ = 0, ZK = 512, ZV = 1024, ZO = 1536, ZZ = 2048, ZAZ = 2560, ZCKV = 3072, ZCQ = 3328, ZKR = 3712, ZMI = 3744, ZMF = 3748;
constexpr size_t O_YP = 0, O_YS = 16777216, O_CKVP = 17825792, O_KRP = 22020096, O_CP = 22544384, O_NP = 22675456, O_MPR = 22676480,
                 O_CKVS = 22676488, O_KRS = 22938632, O_CS = 22971400, O_NS = 31360008, O_MS = 31425544, O_END = 31426056;
constexpr size_t MiB = 1u << 20;
constexpr size_t WS_CTL = 0, WS_MOD = 1 * MiB, WS_ROPET = 260 * MiB, WS_WIN = 4 * MiB, WS_WUQ = 12 * MiB, WS_WKV = 13 * MiB, WS_WOUT = 14 * MiB, WS_H = 16 * MiB,
                 WS_ZB = 64 * MiB  , WS_GATES = 168 * MiB, WS_CKVR = 170 * MiB  , WS_CQR = 180 * MiB  , WS_SSKV = 194 * MiB, WS_SSQ = 195 * MiB,
                 WS_KRB = 196 * MiB  , WS_Q96 = 198 * MiB  , WS_KVB = 224 * MiB  , WS_QLAT = 484 * MiB,
                 WS_OLAT = 492 * MiB, WS_OMLA = 500 * MiB, WS_HML = 536 * MiB, WS_MLG = 572 * MiB, WS_MLU = 573 * MiB, WS_MLDC = 576 * MiB, WS_MLDN = 608 * MiB,
                 WS_MLCS = 612 * MiB, WS_MLNS = 644 * MiB, WS_MLMS = 646 * MiB, WS_YCAT = 648 * MiB, WS_OUT = 684 * MiB, WS_PARTO = 760 * MiB, WS_PARTML = 780 * MiB, WS_WUKB = 262 * MiB, WS_END = 784 * MiB;
constexpr float LOG2E = 1.4426950408889634f;

__host__ __device__ __forceinline__ int zsrc(int j) {
    if (j < 1536) return j;
    if (j < 2560) return j + 8;
    if (j < 3072) return 3240 + (j - 2560);
    if (j < 3328) return 2952 + (j - 3072);
    if (j < 3712) return 2568 + (j - 3328);
    if (j < 3744) return 3208 + (j - 3712);
    if (j < 3752) return 1536 + (j - 3744);
    return -1;
}
__device__ __forceinline__ unsigned short f2bf(float f) { unsigned u = __builtin_bit_cast(unsigned, f); return (unsigned short)((u + 0x7fffu + ((u >> 16) & 1u)) >> 16); }
__device__ __forceinline__ float bf2f(unsigned short h) { return __builtin_bit_cast(float, (unsigned)h << 16); }
__device__ __forceinline__ float wave_sum(float v) {
#pragma unroll
    for (int o = 1; o < 64; o <<= 1) v += __shfl_xor(v, o);
    return v;
}
__device__ __forceinline__ float wave_max(float v) {
#pragma unroll
    for (int o = 1; o < 64; o <<= 1) v = fmaxf(v, __shfl_xor(v, o));
    return v;
}
__device__ __forceinline__ float sigmoidf_(float x) { return 1.f / (1.f + __expf(-x)); }
__device__ __forceinline__ float siluf_(float x) { return x / (1.f + __expf(-x)); }
__device__ __forceinline__ float logsigmoidf_(float x) { return x >= 0.f ? -log1pf(expf(-x)) : x - log1pf(expf(x)); }
__device__ __forceinline__ int row_pos(int m) { return m < MP ? (m & (SP - 1)) : PAST + ((m - MP) & (DS - 1)); }
__device__ __forceinline__ int row_modrow(int m) { return m < MP ? (m >> 13) : 2 + ((m - MP) >> 3); }
namespace pg8 {
#define PG8_LAS __attribute__((address_space(3)))
typedef unsigned short bf16_t;
typedef short bf16x8 __attribute__((ext_vector_type(8)));
typedef float f32x4 __attribute__((ext_vector_type(4)));
typedef unsigned u32x4 __attribute__((ext_vector_type(4)));
constexpr int BM = 256, BK = 64, HALF = 128, HTB = HALF * BK * 2  , STAGE_BYTES = 8 * HTB, NXCD = 8, WGM = 8;

__host__ __device__ __forceinline__ int lds_byte(int r, int c) { const int st = (r >> 4) * 2 + (c >> 5), rr = r & 15, cc = c & 31, ob = rr * 64 + cc * 2; return st * 1024 + (ob ^ (((ob >> 9) & 1) << 5)); }
__host__ __device__ __forceinline__ void stage_rc(int b, int& R, int& C) { const int st = b / 1024, sb = b % 1024, swz = sb ^ (((sb >> 9) & 1) << 5); R = (st >> 1) * 16 + swz / 64; C = (st & 1) * 32 + (swz % 64) / 2; }
__host__ __device__ __forceinline__ int perm32(int rho) { const int n = rho >> 4, i = rho & 15; return 8 * (i >> 2) + 4 * n + (i & 3); }

struct Unit { int pm, pn; };
struct Gemm { const bf16_t* A; const bf16_t* Bt; int M, N, K; };

struct StaticOrder {
    int nM, nN, nwg, G, c;
    __host__ __device__ void init(int M, int N, int G_, int c_) { nM = M / BM; nN = N / BM; nwg = nM * nN; G = G_; c = c_; }
    __host__ __device__ bool next(int i, Unit& u) const {
        const long L = (long)i * G + c; if (L >= nwg) return false;
        int wgid = (int)L; { const int q = nwg / NXCD, r = nwg % NXCD, xcd = wgid % NXCD, off = wgid / NXCD; wgid = (xcd < r ? xcd * (q + 1) : r * (q + 1) + (xcd - r) * q) + off; }
        const int nig = WGM * nN, gid = wgid / nig, fm = gid * WGM, gsz = (nM - fm) < WGM ? (nM - fm) : WGM;
        u.pm = fm + ((wgid % nig) % gsz); u.pn = (wgid % nig) / gsz; return true;
    }
    __device__ __forceinline__ void a_ready(const Unit&) const {}
    __device__ __forceinline__ void done(const Unit&) const {}
};

__device__ __forceinline__ unsigned cvt_pk_bf16(float lo, float hi) { unsigned r; asm volatile("v_cvt_pk_bf16_f32 %0, %1, %2" : "=v"(r) : "v"(lo), "v"(hi)); return r; }
typedef float f32x2c __attribute__((ext_vector_type(2))); typedef __bf16 bf16x2c __attribute__((ext_vector_type(2)));
__device__ __forceinline__ unsigned cvt2(float lo, float hi) { f32x2c v = {lo, hi}; bf16x2c b = __builtin_convertvector(v, bf16x2c); return __builtin_bit_cast(unsigned, b); }
__device__ __forceinline__ u32x4 pack8(const f32x4& v0, const f32x4& v1) { u32x4 w; w.x = cvt2(v0[0], v0[1]); w.y = cvt2(v0[2], v0[3]); w.z = cvt2(v1[0], v1[1]); w.w = cvt2(v1[2], v1[3]); return w; }
__device__ __forceinline__ float sq8(const f32x4& a, const f32x4& b) { return (a[0] * a[0] + a[1] * a[1]) + (a[2] * a[2] + a[3] * a[3]) + (b[0] * b[0] + b[1] * b[1]) + (b[2] * b[2] + b[3] * b[3]); }
__device__ __forceinline__ int epi_row_pos(int m) { return m < 16384 ? (m & 8191) : 8192 + ((m - 16384) & 7); }
__device__ __forceinline__ void rope8(f32x4& v0, f32x4& v1, const float* tab, int fq) {
    const int j0 = 8 * (fq & 1);
    const f32x4 c0 = *(const f32x4*)(tab + j0), c1 = *(const f32x4*)(tab + j0 + 4), s0 = *(const f32x4*)(tab + 16 + j0), s1 = *(const f32x4*)(tab + 16 + j0 + 4);
    f32x4 o0, o1;
#pragma unroll
    for (int i = 0; i < 4; ++i) { o0[i] = __shfl_xor(v0[i], 32); o1[i] = __shfl_xor(v1[i], 32); }
    if (fq < 2) { v0 = v0 * c0 - o0 * s0; v1 = v1 * c1 - o1 * s1; } else { v0 = v0 * c0 + o0 * s0; v1 = v1 * c1 + o1 * s1; }
}
struct EpiInProj {
    static constexpr bool PERM = true, AFTER_DRAIN = false;
    bf16_t* ZB; bf16_t* CKVR; bf16_t* CQR; float* SSKV; float* SSQ; float* GATES; bf16_t* KRB; float* out_krp; float* out_krs; const float* ropet;
    __device__ __forceinline__ void operator()(const f32x4 (&acc)[2][2][4][2], const Unit& u, int wr, int wc, int fr, int fq) const {
        const int row0 = u.pm * BM + wr * 64 + fr, cw = wc * 32 + 8 * fq;
        if (u.pn < 12) {
#pragma unroll
            for (int ai = 0; ai < 2; ++ai)
#pragma unroll
                for (int m = 0; m < 4; ++m) { bf16_t* rowp = ZB + (size_t)(row0 + ai * HALF + m * 16) * 3072 + u.pn * BM + cw;
#pragma unroll
                    for (int bj = 0; bj < 2; ++bj) *(u32x4*)(rowp + bj * HALF) = pack8(acc[ai][bj][m][0], acc[ai][bj][m][1]); }
        } else if (u.pn < 14) {
            bf16_t* dst = u.pn == 12 ? CKVR : CQR; const int ld = u.pn == 12 ? 256 : 384; float* ss = u.pn == 12 ? SSKV : SSQ; const int ssl = u.pn == 12 ? 4 : 8;
#pragma unroll
            for (int ai = 0; ai < 2; ++ai)
#pragma unroll
                for (int m = 0; m < 4; ++m) { const int row = row0 + ai * HALF + m * 16; bf16_t* rowp = dst + (size_t)row * ld + cw;
                    float s = 0.f;
#pragma unroll
                    for (int bj = 0; bj < 2; ++bj) { *(u32x4*)(rowp + bj * HALF) = pack8(acc[ai][bj][m][0], acc[ai][bj][m][1]); s += sq8(acc[ai][bj][m][0], acc[ai][bj][m][1]); }
                    s += __shfl_xor(s, 16); s += __shfl_xor(s, 32);
                    if (fq == 0) ss[(size_t)row * ssl + wc] = s; }
        } else {
#pragma unroll
            for (int ai = 0; ai < 2; ++ai)
#pragma unroll
                for (int m = 0; m < 4; ++m) { const int row = row0 + ai * HALF + m * 16;
                    *(u32x4*)(CQR + (size_t)row * 384 + 256 + cw) = pack8(acc[ai][0][m][0], acc[ai][0][m][1]);
                    float s = sq8(acc[ai][0][m][0], acc[ai][0][m][1]);
                    s += __shfl_xor(s, 16); s += __shfl_xor(s, 32);
                    if (fq == 0) SSQ[(size_t)row * 8 + 4 + wc] = s;
                    if (wc == 0) {
                        f32x4 v0 = acc[ai][1][m][0], v1 = acc[ai][1][m][1];
                        rope8(v0, v1, ropet + (size_t)epi_row_pos(row) * 32, fq);
                        float* o = row < 16384 ? out_krp + (size_t)row * 32 : out_krs + (size_t)(row - 16384) * 32;
                        *(f32x4*)(o + 8 * fq) = v0; *(f32x4*)(o + 8 * fq + 4) = v1;
                        *(u32x4*)(KRB + (size_t)row * 32 + 8 * fq) = pack8(v0, v1);
                    } else if (wc == 1 && fq == 0) {
                        *(f32x4*)(GATES + (size_t)row * 8) = acc[ai][1][m][0]; *(f32x4*)(GATES + (size_t)row * 8 + 4) = acc[ai][1][m][1];
                    } }
        }
    }
    __device__ __forceinline__ void fused(f32x4 (&)[2][2][4][2], const Unit&, int, int, int, int, PG8_LAS unsigned char*, int, int) const {}
};
struct EpiQ {
    static constexpr bool PERM = true, AFTER_DRAIN = false;
    bf16_t* Q96; const float* SSQ; float qscale;
    __device__ __forceinline__ void operator()(const f32x4 (&acc)[2][2][4][2], const Unit& u, int wr, int wc, int fr, int fq) const {
        const int row0 = u.pm * BM + wr * 64 + fr, cw = wc * 32 + 8 * fq;
#pragma unroll
        for (int ai = 0; ai < 2; ++ai)
#pragma unroll
            for (int m = 0; m < 4; ++m) { const int row = row0 + ai * HALF + m * 16;
                const f32x4 p0 = *(const f32x4*)(SSQ + (size_t)row * 8), p1 = *(const f32x4*)(SSQ + (size_t)row * 8 + 4);
                const float ssum = ((p0[0] + p0[1]) + (p0[2] + p0[3])) + ((p1[0] + p1[1]) + (p1[2] + p1[3]));
                const float rs = __builtin_amdgcn_rsqf(ssum * (1.0f / 384.0f) + 1e-6f) * qscale;
#pragma unroll
                for (int bj = 0; bj < 2; ++bj) *(u32x4*)(Q96 + (size_t)row * 768 + u.pn * BM + bj * HALF + cw) = pack8(acc[ai][bj][m][0] * rs, acc[ai][bj][m][1] * rs);
                asm volatile("" ::: "memory"); }
    }
    __device__ __forceinline__ void fused(f32x4 (&)[2][2][4][2], const Unit&, int, int, int, int, PG8_LAS unsigned char*, int, int) const {}
};
struct EpiKV {
    static constexpr bool PERM = true, AFTER_DRAIN = false;
    bf16_t* KVB; const float* SSKV;
    __device__ __forceinline__ void operator()(const f32x4 (&acc)[2][2][4][2], const Unit& u, int wr, int wc, int fr, int fq) const {
        const int row0 = u.pm * BM + wr * 64 + fr, cw = wc * 32 + 8 * fq;
#pragma unroll
        for (int ai = 0; ai < 2; ++ai)
#pragma unroll
            for (int m = 0; m < 4; ++m) { const int row = row0 + ai * HALF + m * 16;
                const f32x4 p0 = *(const f32x4*)(SSKV + (size_t)row * 4);
                const float rs = __builtin_amdgcn_rsqf(((p0[0] + p0[1]) + (p0[2] + p0[3])) * (1.0f / 256.0f) + 1e-6f);
#pragma unroll
                for (int bj = 0; bj < 2; ++bj) *(u32x4*)(KVB + (size_t)row * 1024 + u.pn * BM + bj * HALF + cw) = pack8(acc[ai][bj][m][0] * rs, acc[ai][bj][m][1] * rs);
                asm volatile("" ::: "memory"); }
    }
    __device__ __forceinline__ void fused(f32x4 (&)[2][2][4][2], const Unit&, int, int, int, int, PG8_LAS unsigned char*, int, int) const {}
};
struct EpiF32 {
    static constexpr bool PERM = false, AFTER_DRAIN = false;
    float* C; int ldc;
    __device__ __forceinline__ void operator()(const f32x4 (&acc)[2][2][4][2], const Unit& u, int wr, int wc, int fr, int fq) const {
        const int row0 = u.pm * BM + wr * 64 + fr, col0 = u.pn * BM + wc * 32 + 4 * fq;
#pragma unroll
        for (int ai = 0; ai < 2; ++ai)
#pragma unroll
            for (int m = 0; m < 4; ++m) { float* rowp = C + (size_t)(row0 + ai * HALF + m * 16) * ldc + col0;
#pragma unroll
                for (int bj = 0; bj < 2; ++bj)
#pragma unroll
                    for (int n = 0; n < 2; ++n) *(f32x4*)(rowp + bj * HALF + n * 16) = acc[ai][bj][m][n]; }
    }
    __device__ __forceinline__ void fused(f32x4 (&)[2][2][4][2], const Unit&, int, int, int, int, PG8_LAS unsigned char*, int, int) const {}
};
template <class Epi, class Sched, bool ALIGN_EPI = false, bool SP2 = false>
__device__ __forceinline__ void gemm_phase(PG8_LAS unsigned char* lds, const Gemm g, const Sched& S, const Epi& E) {
    const int tid = threadIdx.x, wid = __builtin_amdgcn_readfirstlane(tid >> 6), lane = tid & 63, wr = wid >> 2, wc = wid & 3, fr = lane & 15, fq = lane >> 4;
    const int K = g.K, nt = K / BK;
    unsigned voffA[2], voffB[2];
#pragma unroll
    for (int i = 0; i < 2; ++i) { int R, C; stage_rc(tid * 16 + i * 8192, R, C); const int Rb = Epi::PERM ? ((R & ~31) + perm32(R & 31)) : R;
        voffA[i] = (unsigned)(R * K + C) * 2u; voffB[i] = (unsigned)(Rb * K + C) * 2u; }
    const size_t kstep = (size_t)(BK * 2);
    const size_t hstep = (size_t)HALF * K * 2;
    const size_t tstep = 2 * hstep;
    const unsigned ldsw = (unsigned)wid * 1024u;
    const int aoff = lds_byte(wr * 64 + fr, fq * 8), boff = lds_byte(wc * 32 + fr, fq * 8);
#define PG8_SA(b, h) (((b) * 2 + (h)) * HTB)
#define PG8_SB(b, h) ((4 + (b) * 2 + (h)) * HTB)
#define PG8_STAGE(bufoff, gbase, voff) do { _Pragma("unroll") for (int _i = 0; _i < 2; ++_i) \
        __builtin_amdgcn_global_load_lds((const unsigned*)((const char*)(gbase) + (voff)[_i]), (PG8_LAS unsigned*)(lds + (bufoff) + ldsw + _i * 8192), 16, 0, 0); } while (0)
#define PG8_LDA(dst, b, h) do { _Pragma("unroll") for (int m = 0; m < 4; ++m) _Pragma("unroll") for (int k = 0; k < 2; ++k) dst[m][k] = *(const PG8_LAS bf16x8*)(lds + PG8_SA(b, h) + aoff + m * 2048 + k * 1024); } while (0)
#define PG8_LDB(dst, b, h) do { _Pragma("unroll") for (int n = 0; n < 2; ++n) _Pragma("unroll") for (int k = 0; k < 2; ++k) dst[n][k] = *(const PG8_LAS bf16x8*)(lds + PG8_SB(b, h) + boff + n * 2048 + k * 1024); } while (0)
#define PG8_MMA(ai, bj, At, Bt) do { __builtin_amdgcn_s_setprio(1); _Pragma("unroll") for (int m = 0; m < 4; ++m) _Pragma("unroll") for (int n = 0; n < 2; ++n) _Pragma("unroll") for (int k = 0; k < 2; ++k) \
        acc[ai][bj][m][n] = __builtin_amdgcn_mfma_f32_16x16x32_bf16(Bt[n][k], At[m][k], acc[ai][bj][m][n], 0, 0, 0); __builtin_amdgcn_s_setprio(0); } while (0)
#define PG8_WAIT_V(n) asm volatile("s_waitcnt vmcnt(" #n ")" ::: "memory")
#define PG8_WAIT_L(n) asm volatile("s_waitcnt lgkmcnt(" #n ")" ::: "memory")
#define PG8_BAR __builtin_amdgcn_s_barrier()
#define PG8_SCHED __builtin_amdgcn_sched_barrier(0)
    Unit cur, nxt; int ui = 0;
    if (!S.next(0, cur)) return;
    f32x4 acc[2][2][4][2];
#pragma unroll
    for (int a = 0; a < 2; ++a)
#pragma unroll
        for (int b = 0; b < 2; ++b)
#pragma unroll
            for (int m = 0; m < 4; ++m)
#pragma unroll
                for (int n = 0; n < 2; ++n) acc[a][b][m][n] = (f32x4){0.f, 0.f, 0.f, 0.f};
    bf16x8 At[4][2], B0[2][2], B1[2][2];
    const char* cA = (const char*)g.A + (size_t)cur.pm * tstep; const char* cB = (const char*)g.Bt + (size_t)cur.pn * tstep;
    S.a_ready(cur);
    if constexpr (SP2) {
        PG8_STAGE(PG8_SB(0, 0), cB, voffB); PG8_STAGE(PG8_SB(0, 1), cB + hstep, voffB); PG8_STAGE(PG8_SA(0, 0), cA, voffA); PG8_STAGE(PG8_SA(0, 1), cA + hstep, voffA);
        if (wr == 1) PG8_BAR;
        PG8_WAIT_V(2); PG8_BAR;
        PG8_STAGE(PG8_SB(1, 0), cB + kstep, voffB); PG8_STAGE(PG8_SA(1, 0), cA + kstep, voffA); PG8_STAGE(PG8_SB(1, 1), cB + hstep + kstep, voffB);
        PG8_WAIT_V(6); PG8_BAR;
    } else {
        PG8_STAGE(PG8_SB(0, 0), cB, voffB); PG8_STAGE(PG8_SA(0, 0), cA, voffA); PG8_STAGE(PG8_SB(0, 1), cB + hstep, voffB); PG8_STAGE(PG8_SA(0, 1), cA + hstep, voffA);
        if (wr == 1) PG8_BAR;
        PG8_WAIT_V(4); PG8_BAR;
        PG8_STAGE(PG8_SB(1, 0), cB + kstep, voffB); PG8_STAGE(PG8_SA(1, 0), cA + kstep, voffA); PG8_STAGE(PG8_SB(1, 1), cB + hstep + kstep, voffB);
        PG8_WAIT_V(6); PG8_BAR;
    }
    for (;;) {
        const bool has_next = S.next(ui + 1, nxt);
        const char* nA = has_next ? (const char*)g.A + (size_t)nxt.pm * tstep : cA; const char* nB = has_next ? (const char*)g.Bt + (size_t)nxt.pn * tstep : cB;
        for (int t = 0; t < nt; t += 2) {
            const bool last = (t == nt - 2);
            const char* a1 = cA + (size_t)(t + 1) * kstep;
            const char* a2 = last ? nA : cA + (size_t)(t + 2) * kstep; const char* b2 = last ? nB : cB + (size_t)(t + 2) * kstep;
            const char* a3 = a2 + kstep; const char* b3 = b2 + kstep;
            if (last && has_next) S.a_ready(nxt);
            if constexpr (SP2) {
            PG8_LDB(B0, 0, 0); PG8_LDB(B1, 0, 1); PG8_SCHED; PG8_LDA(At, 0, 0); PG8_STAGE(PG8_SA(1, 1), a1 + hstep, voffA);
            PG8_WAIT_V(8); PG8_WAIT_L(0); PG8_BAR; PG8_MMA(0, 0, At, B0); PG8_MMA(0, 1, At, B1); PG8_BAR; PG8_SCHED;
            PG8_LDA(At, 0, 1); PG8_STAGE(PG8_SB(0, 0), b2, voffB); PG8_STAGE(PG8_SB(0, 1), b2 + hstep, voffB); PG8_STAGE(PG8_SA(0, 0), a2, voffA);
            PG8_WAIT_V(8); PG8_WAIT_L(0); PG8_BAR; PG8_MMA(1, 0, At, B0); PG8_MMA(1, 1, At, B1); PG8_BAR; PG8_SCHED;
            PG8_LDB(B0, 1, 0); PG8_LDB(B1, 1, 1); PG8_SCHED; PG8_LDA(At, 1, 0); PG8_STAGE(PG8_SA(0, 1), a2 + hstep, voffA);
            PG8_WAIT_V(8); PG8_WAIT_L(0); PG8_BAR; PG8_MMA(0, 0, At, B0); PG8_MMA(0, 1, At, B1); PG8_BAR; PG8_SCHED;
            PG8_LDA(At, 1, 1); PG8_STAGE(PG8_SB(1, 0), b3, voffB); PG8_STAGE(PG8_SB(1, 1), b3 + hstep, voffB); PG8_STAGE(PG8_SA(1, 0), a3, voffA);
            PG8_WAIT_V(8); PG8_WAIT_L(0); PG8_BAR; PG8_MMA(1, 0, At, B0); PG8_MMA(1, 1, At, B1); PG8_BAR; PG8_SCHED;
            } else {
            PG8_LDB(B0, 0, 0); PG8_SCHED; PG8_LDA(At, 0, 0); PG8_STAGE(PG8_SA(1, 1), a1 + hstep, voffA);
            PG8_WAIT_L(8); PG8_BAR; PG8_WAIT_L(0); PG8_MMA(0, 0, At, B0); PG8_BAR; PG8_SCHED;
            PG8_LDB(B1, 0, 1); PG8_STAGE(PG8_SB(0, 0), b2, voffB);
            PG8_BAR; PG8_WAIT_L(0); PG8_MMA(0, 1, At, B1); PG8_BAR;
            PG8_LDA(At, 0, 1); PG8_STAGE(PG8_SA(0, 0), a2, voffA);
            PG8_BAR; PG8_WAIT_L(0); PG8_MMA(1, 0, At, B0); PG8_BAR; PG8_SCHED;
            PG8_STAGE(PG8_SB(0, 1), b2 + hstep, voffB);
            PG8_WAIT_V(6); PG8_BAR; PG8_MMA(1, 1, At, B1); PG8_BAR;
            PG8_LDB(B0, 1, 0); PG8_SCHED; PG8_LDA(At, 1, 0); PG8_STAGE(PG8_SA(0, 1), a2 + hstep, voffA);
            PG8_WAIT_L(8); PG8_BAR; PG8_WAIT_L(0); PG8_MMA(0, 0, At, B0); PG8_BAR; PG8_SCHED;
            PG8_LDB(B1, 1, 1); PG8_STAGE(PG8_SB(1, 0), b3, voffB);
            PG8_BAR; PG8_WAIT_L(0); PG8_MMA(0, 1, At, B1); PG8_BAR;
            PG8_LDA(At, 1, 1); PG8_STAGE(PG8_SA(1, 0), a3, voffA);
            PG8_BAR; PG8_WAIT_L(0); PG8_MMA(1, 0, At, B0); PG8_BAR; PG8_SCHED;
            PG8_STAGE(PG8_SB(1, 1), b3 + hstep, voffB);
            PG8_WAIT_V(6); PG8_BAR; PG8_MMA(1, 1, At, B1); PG8_BAR;
            }
        }
        if constexpr (ALIGN_EPI) { if (wr == 0) PG8_BAR; }
        if constexpr (!Epi::AFTER_DRAIN) { E(acc, cur, wr, wc, fr, fq); S.done(cur); }
        if (!has_next) break;
#pragma unroll
        for (int a = 0; a < 2; ++a)
#pragma unroll
            for (int b = 0; b < 2; ++b)
#pragma unroll
                for (int m = 0; m < 4; ++m)
#pragma unroll
                    for (int n = 0; n < 2; ++n) acc[a][b][m][n] = (f32x4){0.f, 0.f, 0.f, 0.f};
        cur = nxt; cA = nA; cB = nB; ++ui;
        if constexpr (ALIGN_EPI) { if (wr == 1) PG8_BAR; }
    }
    PG8_WAIT_V(0);
    if constexpr (!ALIGN_EPI) { if (wr == 0) PG8_BAR; }
    PG8_BAR;
    if constexpr (Epi::AFTER_DRAIN) { E.fused(acc, cur, wr, wc, fr, fq, lds, wid, lane); S.done(cur); }
#undef PG8_SA
#undef PG8_SB
#undef PG8_STAGE
#undef PG8_LDA
#undef PG8_LDB
#undef PG8_MMA
#undef PG8_WAIT_V
#undef PG8_WAIT_L
#undef PG8_BAR
#undef PG8_SCHED
}
}
typedef unsigned short bf16;
typedef float f32x4v __attribute__((ext_vector_type(4)));
#define LAS __attribute__((address_space(3)))
namespace pa {
typedef short bf16x8 __attribute__((ext_vector_type(8)));
typedef short s16x4 __attribute__((ext_vector_type(4)));
typedef float f32x16 __attribute__((ext_vector_type(16)));
typedef unsigned u32x4 __attribute__((ext_vector_type(4)));
typedef unsigned u32x2 __attribute__((ext_vector_type(2)));
typedef float f32x2_t __attribute__((ext_vector_type(2))); typedef __bf16 bf16x2_t __attribute__((ext_vector_type(2)));
constexpr int KP = 208, VP = 128, KBUF = 64 * KP, VBUF = 64 * VP, L_K = 0, L_V = 2 * KBUF, LDS_BYTES = 2 * KBUF + 2 * VBUF;
__device__ __forceinline__ unsigned cvtpk(float lo, float hi) { f32x2_t v = {lo, hi}; bf16x2_t b = __builtin_convertvector(v, bf16x2_t); return __builtin_bit_cast(unsigned, b); }
__device__ __forceinline__ bf16x8 pack8(const f32x16& p, int s) { u32x4 w; w.x = cvtpk(p[8 * s], p[8 * s + 1]); w.y = cvtpk(p[8 * s + 2], p[8 * s + 3]); w.z = cvtpk(p[8 * s + 4], p[8 * s + 5]); w.w = cvtpk(p[8 * s + 6], p[8 * s + 7]); return __builtin_bit_cast(bf16x8, w); }
__device__ __forceinline__ s16x4 vtr(const LAS unsigned char* p) { return __builtin_bit_cast(s16x4, __builtin_amdgcn_ds_read_tr16_b64_v4i16((LAS s16x4*)p)); }
__device__ __forceinline__ int crow(int r, int hf) { return (r & 3) + 8 * (r >> 2) + 4 * hf; }
#define PA_MFMA(a, b, c) __builtin_amdgcn_mfma_f32_32x32x16_bf16((a), (b), (c), 0, 0, 0)

struct Tensors { const bf16* Q96; const bf16* KVB; const bf16* KRB; const bf16* ZB; const float* ropet; bf16* YCAT; };

__device__ __forceinline__ void unit(LAS unsigned char* lds, const Tensors& T, int b, int h, int qb) {
    int tid_ = threadIdx.x; asm volatile("" : "+v"(tid_)); const int tid = tid_, lane = tid & 63, w = __builtin_amdgcn_readfirstlane(tid >> 6), q32 = lane & 31, hf = lane >> 5;
    const int Q0 = qb * 256, NT = (Q0 + 256) / 64;
    const size_t rowb = (size_t)b * SP;
    const int rv = tid >> 3, cv = tid & 7;
    const bf16* gV = T.KVB + (rowb + rv) * 1024 + 512 + h * 64 + cv * 8;
    const bf16* gK = T.KVB + (rowb + rv) * 1024 + h * 64 + cv * 8;
    const bf16* gR = T.KRB + (rowb + (tid >> 2)) * 32 + (tid & 3) * 8;
    const int dV = L_V + rv * VP + ((cv ^ (((rv >> 1) & 1) << 2)) * 16), dK = L_K + rv * KP + cv * 16, dR = L_K + (tid >> 2) * KP + 128 + (tid & 3) * 16;
    u32x4 sV, sK, sR = {0u, 0u, 0u, 0u};
    sV = *(const u32x4*)gV; sK = *(const u32x4*)gK; if (tid < 256) sR = *(const u32x4*)gR;
    const int qg = Q0 + 32 * w + q32;
    const bf16* qrow = T.Q96 + (rowb + qg) * 768 + h * 96 + 8 * hf;
    bf16x8 qf[6];
#pragma unroll
    for (int ks = 0; ks < 6; ++ks) qf[ks] = *(const bf16x8*)(qrow + 16 * ks);
    {   const float* tb = T.ropet + (size_t)qg * 32 + 8 * hf;
        u32x4 y1, y2;
#pragma unroll
        for (int e = 0; e < 8; e += 2) {
            const float c0 = tb[e], c1 = tb[e + 1], s0 = tb[16 + e], s1 = tb[16 + e + 1];
            const float a0 = bf2f((unsigned short)qf[4][e]), a1 = bf2f((unsigned short)qf[4][e + 1]), b0 = bf2f((unsigned short)qf[5][e]), b1 = bf2f((unsigned short)qf[5][e + 1]);
            y1[e >> 1] = cvtpk(a0 * c0 - b0 * s0, a1 * c1 - b1 * s1); y2[e >> 1] = cvtpk(b0 * c0 + a0 * s0, b1 * c1 + a1 * s1);
        }
        qf[4] = __builtin_bit_cast(bf16x8, y1); qf[5] = __builtin_bit_cast(bf16x8, y2); }
    __syncthreads();
    *(LAS u32x4*)(lds + dV) = sV; *(LAS u32x4*)(lds + dK) = sK; if (tid < 256) *(LAS u32x4*)(lds + dR) = sR;
    __syncthreads();
    f32x16 o0, o1;
#pragma unroll
    for (int i = 0; i < 16; ++i) { o0[i] = 0.f; o1[i] = 0.f; }
    float mref = 0.f, l = 0.f;
    const int i16 = lane & 15, q4 = i16 >> 2, p4 = i16 & 3, blk = (lane >> 4) & 1;
    const int vo0 = q4 * VP + (((0 + 2 * blk + (p4 >> 1)) ^ (((q4 >> 1) & 1) << 2)) * 16) + (p4 & 1) * 8 + 4 * hf * VP;
    const int vo1 = q4 * VP + (((4 + 2 * blk + (p4 >> 1)) ^ (((q4 >> 1) & 1) << 2)) * 16) + (p4 & 1) * 8 + 4 * hf * VP;
    for (int t = 0; t < NT; ++t) {
        const int buf = t & 1;
        if (t + 1 < NT) { const size_t adv = (size_t)(t + 1) * 64; sV = *(const u32x4*)(gV + adv * 1024); sK = *(const u32x4*)(gK + adv * 1024); if (tid < 256) sR = *(const u32x4*)(gR + adv * 32); }
        const int kv0 = 64 * t;
        if (kv0 <= Q0 + 32 * w + 31) {
            f32x16 p0, p1;
#pragma unroll
            for (int i = 0; i < 16; ++i) { p0[i] = 0.f; p1[i] = 0.f; }
            const LAS unsigned char* kb = lds + L_K + buf * KBUF + q32 * KP + hf * 16;
#pragma unroll
            for (int ks = 0; ks < 6; ++ks) {
                const bf16x8 a0 = *(const LAS bf16x8*)(kb + ks * 32), a1 = *(const LAS bf16x8*)(kb + 32 * KP + ks * 32);
                p0 = PA_MFMA(a0, qf[ks], p0); p1 = PA_MFMA(a1, qf[ks], p1);
            }
            if (kv0 + 63 > Q0 + 32 * w) {
#pragma unroll
                for (int i = 0; i < 16; ++i) { const int kvg = kv0 + crow(i, hf); if (kvg > qg) p0[i] = -INFINITY; if (kvg + 32 > qg) p1[i] = -INFINITY; }
            }
            float rm = fmaxf(p0[0], p1[0]);
#pragma unroll
            for (int i = 1; i < 16; ++i) rm = fmaxf(rm, fmaxf(p0[i], p1[i]));
            rm = fmaxf(rm, __shfl_xor(rm, 32));
            if (t == 0) mref = rm == -INFINITY ? 0.f : rm;
            else if (__any(rm > mref + 8.f)) { const float mn = fmaxf(mref, rm), al = __builtin_amdgcn_exp2f(mref - mn); l *= al; mref = mn;
#pragma unroll
                for (int i = 0; i < 16; ++i) { o0[i] *= al; o1[i] *= al; } }
            float ls = 0.f;
#pragma unroll
            for (int i = 0; i < 16; ++i) { p0[i] = __builtin_amdgcn_exp2f(p0[i] - mref); p1[i] = __builtin_amdgcn_exp2f(p1[i] - mref); ls += p0[i] + p1[i]; }
            l += ls;
            const bf16x8 pb0 = pack8(p0, 0), pb1 = pack8(p0, 1), pb2 = pack8(p1, 0), pb3 = pack8(p1, 1);
            const LAS unsigned char* vb = lds + L_V + buf * VBUF;
#define PA_PV(PB, RB) do { const s16x4 l0 = vtr(vb + (RB) * VP + vo0), h0 = vtr(vb + ((RB) + 8) * VP + vo0), l1 = vtr(vb + (RB) * VP + vo1), h1 = vtr(vb + ((RB) + 8) * VP + vo1); \
                const bf16x8 a0 = __builtin_shufflevector(l0, h0, 0, 1, 2, 3, 4, 5, 6, 7), a1 = __builtin_shufflevector(l1, h1, 0, 1, 2, 3, 4, 5, 6, 7); \
                o0 = PA_MFMA(a0, PB, o0); o1 = PA_MFMA(a1, PB, o1); } while (0)
            PA_PV(pb0, 0); PA_PV(pb1, 16); PA_PV(pb2, 32); PA_PV(pb3, 48);
#undef PA_PV
        }
        if (t + 1 < NT) { const int nb = (buf ^ 1); *(LAS u32x4*)(lds + nb * VBUF + dV) = sV; *(LAS u32x4*)(lds + nb * KBUF + dK) = sK; if (tid < 256) *(LAS u32x4*)(lds + nb * KBUF + dR) = sR; }
        __syncthreads();
    }
    l += __shfl_xor(l, 32);
    const float il = 1.f / l;
    const size_t row = rowb + qg;
    const bf16* az = T.ZB + row * 3072 + ZAZ + h * 64 + 4 * hf; bf16* yo = T.YCAT + row * 1024 + 512 + h * 64 + 4 * hf;
#pragma unroll
    for (int d = 0; d < 2; ++d)
#pragma unroll
        for (int g = 0; g < 4; ++g) { const u32x2 a = *(const u32x2*)(az + 32 * d + 8 * g);
            const float z0 = bf2f((unsigned short)(a.x & 0xffff)), z1 = bf2f((unsigned short)(a.x >> 16)), z2 = bf2f((unsigned short)(a.y & 0xffff)), z3 = bf2f((unsigned short)(a.y >> 16));
            const f32x16& o = d == 0 ? o0 : o1;
            u32x2 r; r.x = cvtpk(o[4 * g] * il * siluf_(z0), o[4 * g + 1] * il * siluf_(z1)); r.y = cvtpk(o[4 * g + 2] * il * siluf_(z2), o[4 * g + 3] * il * siluf_(z3));
            *(u32x2*)(yo + 32 * d + 8 * g) = r; }
}
__device__ __forceinline__ void phase(LAS unsigned char* lds, const Tensors& T, int vcu, int G) {
    for (int v = vcu; v < 256; v += G) { const int bh = v >> 4, s = v & 15;
        unit(lds, T, bh >> 3, bh & 7, 31 - s); unit(lds, T, bh >> 3, bh & 7, s); }
}
}
namespace sa {
typedef short bf16x8 __attribute__((ext_vector_type(8)));
typedef short s16x4 __attribute__((ext_vector_type(4)));
typedef float f32x16 __attribute__((ext_vector_type(16)));
typedef float f32x4 __attribute__((ext_vector_type(4)));
typedef unsigned u32x4 __attribute__((ext_vector_type(4)));
typedef unsigned u32x2 __attribute__((ext_vector_type(2)));
constexpr int NSPLIT = 2, PPS = NPAGES / NSPLIT;
constexpr int KP = 592, PP = 272;
constexpr int L_KT = 0, L_Q = 128 * KP, L_P = L_Q + 64 * KP, L_SMAX = L_P + 64 * PP, L_SSUM = L_SMAX + 4 * 64 * 4, LDS_BYTES = L_SSUM + 4 * 64 * 4;
using pa::cvtpk; using pa::vtr; using pa::crow;
#define SA_MFMA(a, b, c) __builtin_amdgcn_mfma_f32_32x32x16_bf16((a), (b), (c), 0, 0, 0)
struct Tensors { const bf16* Q96; const bf16* WUKB; const float* cache_ckv; const float* cache_kr; const int* page_table; const float* ckv_new; const bf16* KRB; const float* ropet;
                 float* PARTO; float* PARTML; };

__device__ __forceinline__ void unit(LAS unsigned char* lds, const Tensors& T, int b, int sp) {
    int tid_ = threadIdx.x; asm volatile("" : "+v"(tid_)); const int tid = tid_, lane = tid & 63, w = __builtin_amdgcn_readfirstlane(tid >> 6), q32 = lane & 31, hf = lane >> 5;
    __syncthreads();
    {   const int h = w;
        bf16x8 qb[4];
#pragma unroll
        for (int ks = 0; ks < 4; ++ks) { bf16x8 z = {0, 0, 0, 0, 0, 0, 0, 0}; qb[ks] = q32 < DS ? *(const bf16x8*)(T.Q96 + (size_t)(MP + b * DS + q32) * 768 + h * 96 + 16 * ks + 8 * hf) : z; }
#pragma unroll
        for (int cb = 0; cb < 8; ++cb) {
            f32x16 acc;
#pragma unroll
            for (int i = 0; i < 16; ++i) acc[i] = 0.f;
#pragma unroll
            for (int ks = 0; ks < 4; ++ks) { const bf16x8 a = *(const bf16x8*)(T.WUKB + (size_t)(32 * cb + q32) * 512 + h * 64 + 16 * ks + 8 * hf); acc = SA_MFMA(a, qb[ks], acc); }
            if (q32 < DS) {
#pragma unroll
                for (int g = 0; g < 4; ++g) { u32x2 r; r.x = cvtpk(acc[4 * g], acc[4 * g + 1]); r.y = cvtpk(acc[4 * g + 2], acc[4 * g + 3]);
                    *(LAS u32x2*)(lds + L_Q + (h * 8 + q32) * KP + (32 * cb + 8 * g + 4 * hf) * 2) = r; }
            }
        }
#pragma unroll
        for (int e = 0; e < 2; ++e) { const int id = tid + 512 * e, r = id >> 4, j = id & 15, hh = r >> 3, t = r & 7;
            const bf16* qs = T.Q96 + (size_t)(MP + b * DS + t) * 768 + hh * 96 + 64; const float* tb = T.ropet + (size_t)(PAST + t) * 32;
            const float x1 = bf2f(qs[j]), x2 = bf2f(qs[16 + j]), cs = tb[j], sn = tb[16 + j];
            *(LAS unsigned short*)(lds + L_Q + r * KP + (256 + j) * 2) = f2bf(x1 * cs - x2 * sn); *(LAS unsigned short*)(lds + L_Q + r * KP + (272 + j) * 2) = f2bf(x2 * cs + x1 * sn); }
    }
    f32x4 st[18];
    const int pg0 = sp * PPS;
    auto issue = [&](int page) {
        const int phys = T.page_table[b * NPAGES + page];
        const float* gc = T.cache_ckv + (size_t)phys * (PAGE * KVL) + tid * 4; const float* gr = T.cache_kr + (size_t)phys * (PAGE * ROPE) + tid * 4;
#pragma unroll
        for (int j = 0; j < 16; ++j) st[j] = __builtin_nontemporal_load((const f32x4*)(gc + j * 2048));
#pragma unroll
        for (int j = 0; j < 2; ++j) st[16 + j] = __builtin_nontemporal_load((const f32x4*)(gr + j * 2048));
    };
    issue(pg0);
    f32x16 o0, o1;
#pragma unroll
    for (int i = 0; i < 16; ++i) { o0[i] = 0.f; o1[i] = 0.f; }
    float mrun0 = -INFINITY, mrun1 = -INFINITY, lrun0 = 0.f, lrun1 = 0.f;
    const int kvb = w >> 1, qbk = w & 1;
    const int i16 = lane & 15, q4 = i16 >> 2, p4 = i16 & 3, blk = (lane >> 4) & 1;
    const int vo = (8 * hf + q4) * KP + 64 * w + 32 * blk + 8 * p4;
    const bool has_tail = (sp == NSPLIT - 1);
    const int niter = PPS + (has_tail ? 1 : 0);
    for (int it = 0; it < niter; ++it) {
        const bool tail = (it == PPS);
        const int nblk = tail ? 1 : 4;
        __syncthreads();
        if (!tail) {
#pragma unroll
            for (int j = 0; j < 16; ++j) { const int id = tid + 512 * j, r = id >> 6, c = (id & 63) * 4; u32x2 v; v.x = cvtpk(st[j][0], st[j][1]); v.y = cvtpk(st[j][2], st[j][3]);
                *(LAS u32x2*)(lds + L_KT + r * KP + c * 2) = v; }
#pragma unroll
            for (int j = 0; j < 2; ++j) { const int id = tid + 512 * j, r = id >> 3, c = 256 + (id & 7) * 4; u32x2 v; v.x = cvtpk(st[16 + j][0], st[16 + j][1]); v.y = cvtpk(st[16 + j][2], st[16 + j][3]);
                *(LAS u32x2*)(lds + L_KT + r * KP + c * 2) = v; }
        } else {
            for (int id = tid; id < 32 * 72; id += 512) { const int r = id / 72, c4 = (id % 72) * 4; u32x2 v = {0u, 0u};
                if (r < DS) { if (c4 < KVL) { const f32x4 x = *(const f32x4*)(T.ckv_new + (size_t)(b * DS + r) * KVL + c4); v.x = cvtpk(x[0], x[1]); v.y = cvtpk(x[2], x[3]); }
                              else v = *(const u32x2*)(T.KRB + (size_t)(MP + b * DS + r) * ROPE + (c4 - KVL)); }
                *(LAS u32x2*)(lds + L_KT + r * KP + c4 * 2) = v; }
        }
        __syncthreads();
        if (it + 1 < PPS) issue(pg0 + it + 1);
        f32x16 s;
        float lmax = -INFINITY;
        if (kvb < nblk) {
#pragma unroll
            for (int i = 0; i < 16; ++i) s[i] = 0.f;
            const LAS unsigned char* ka = lds + L_KT + (32 * kvb + q32) * KP + hf * 16; const LAS unsigned char* qa = lds + L_Q + (32 * qbk + q32) * KP + hf * 16;
#pragma unroll
            for (int ks = 0; ks < 18; ++ks) s = SA_MFMA(*(const LAS bf16x8*)(ka + ks * 32), *(const LAS bf16x8*)(qa + ks * 32), s);
            if (tail) {
#pragma unroll
                for (int i = 0; i < 16; ++i) if (crow(i, hf) > (q32 & 7)) s[i] = -INFINITY;
            }
#pragma unroll
            for (int i = 0; i < 16; ++i) lmax = fmaxf(lmax, s[i]);
            lmax = fmaxf(lmax, __shfl_xor(lmax, 32));
        }
        if (hf == 0) *(LAS float*)(lds + L_SMAX + (kvb * 64 + 32 * qbk + q32) * 4) = lmax;
        __syncthreads();
        float tm0 = -INFINITY, tm1 = -INFINITY;
#pragma unroll
        for (int k = 0; k < 4; ++k) { tm0 = fmaxf(tm0, *(const LAS float*)(lds + L_SMAX + (k * 64 + q32) * 4)); tm1 = fmaxf(tm1, *(const LAS float*)(lds + L_SMAX + (k * 64 + 32 + q32) * 4)); }
        const float mn0 = fmaxf(mrun0, tm0), mn1 = fmaxf(mrun1, tm1);
        const float al0 = __builtin_amdgcn_exp2f(mrun0 - mn0), al1 = __builtin_amdgcn_exp2f(mrun1 - mn1);
        mrun0 = mn0; mrun1 = mn1;
        float lsum = 0.f;
        if (kvb < nblk) {
            const float mn = qbk ? mn1 : mn0;
#pragma unroll
            for (int i = 0; i < 16; ++i) { s[i] = __builtin_amdgcn_exp2f(s[i] - mn); lsum += s[i]; }
            lsum += __shfl_xor(lsum, 32);
#pragma unroll
            for (int g = 0; g < 4; ++g) { u32x2 r; r.x = cvtpk(s[4 * g], s[4 * g + 1]); r.y = cvtpk(s[4 * g + 2], s[4 * g + 3]);
                *(LAS u32x2*)(lds + L_P + (32 * qbk + q32) * PP + (32 * kvb + 8 * g + 4 * hf) * 2) = r; }
        }
        if (hf == 0) *(LAS float*)(lds + L_SSUM + (kvb * 64 + 32 * qbk + q32) * 4) = lsum;
        __syncthreads();
        float ts0 = 0.f, ts1 = 0.f;
#pragma unroll
        for (int k = 0; k < 4; ++k) { ts0 += *(const LAS float*)(lds + L_SSUM + (k * 64 + q32) * 4); ts1 += *(const LAS float*)(lds + L_SSUM + (k * 64 + 32 + q32) * 4); }
        lrun0 = lrun0 * al0 + ts0; lrun1 = lrun1 * al1 + ts1;
#pragma unroll
        for (int i = 0; i < 16; ++i) { o0[i] *= al0; o1[i] *= al1; }
        const LAS unsigned char* vb = lds + L_KT + vo; const LAS unsigned char* pb = lds + L_P + q32 * PP + hf * 16;
        const int nks = 2 * nblk;
#pragma unroll 2
        for (int ks = 0; ks < nks; ++ks) {
            const s16x4 lo = vtr(vb + (16 * ks) * KP), hi = vtr(vb + (16 * ks + 4) * KP);
            const bf16x8 a = __builtin_shufflevector(lo, hi, 0, 1, 2, 3, 4, 5, 6, 7);
            o0 = SA_MFMA(a, *(const LAS bf16x8*)(pb + ks * 32), o0); o1 = SA_MFMA(a, *(const LAS bf16x8*)(pb + 32 * PP + ks * 32), o1);
        }
    }
    float* po = T.PARTO + (size_t)(b * NSPLIT + sp) * 64 * KVL;
#pragma unroll
    for (int g = 0; g < 4; ++g) {
        *(f32x4*)(po + (size_t)q32 * KVL + 32 * w + 8 * g + 4 * hf) = (f32x4){o0[4 * g], o0[4 * g + 1], o0[4 * g + 2], o0[4 * g + 3]};
        *(f32x4*)(po + (size_t)(32 + q32) * KVL + 32 * w + 8 * g + 4 * hf) = (f32x4){o1[4 * g], o1[4 * g + 1], o1[4 * g + 2], o1[4 * g + 3]};
    }
    if (w == 0 && hf == 0) { float* pm = T.PARTML + (size_t)(b * NSPLIT + sp) * 128; pm[q32] = mrun0; pm[32 + q32] = mrun1; pm[64 + q32] = lrun0; pm[96 + q32] = lrun1; }
}
__device__ __forceinline__ void phase(LAS unsigned char* lds, const Tensors& T, int vcu, int G) {
    for (int v = vcu; v < DB * NSPLIT; v += G) unit(lds, T, v / NSPLIT, v % NSPLIT);
}
}
namespace ml {
typedef short bf16x8 __attribute__((ext_vector_type(8)));
typedef short s16x4 __attribute__((ext_vector_type(4)));
typedef float f32x16 __attribute__((ext_vector_type(16)));
typedef float f32x4 __attribute__((ext_vector_type(4)));
typedef unsigned u32x4 __attribute__((ext_vector_type(4)));
typedef unsigned u32x2 __attribute__((ext_vector_type(2)));
using pa::cvtpk; using pa::vtr; using pa::crow;
#define ML_MFMA(a, b, c) __builtin_amdgcn_mfma_f32_32x32x16_bf16((a), (b), (c), 0, 0, 0)
constexpr int RP = 272;
constexpr int L_Q = 0, L_K = 128 * RP, L_V = 2 * 128 * RP, L_C = L_V + 32768, L_F = L_C + 32768, L_B = L_F + 512, L_M = L_B + 512, L_N = L_M + 512, L_X = L_N + 512, LDS_BYTES = L_X + 2048;
__device__ __forceinline__ int swz(int r) { return (((r >> 1) & 1) << 2) ^ ((r & 1) << 3); }
__device__ __forceinline__ int tr_dst(int row, int c16) { return row * 256 + ((c16 ^ swz(row)) * 16); }
__device__ __forceinline__ int tr_off(int lane, int cb) { const int i16 = lane & 15, q4 = i16 >> 2, p4 = i16 & 3, blk = (lane >> 4) & 1; return q4 * 256 + (((4 * cb + 2 * blk + (p4 >> 1)) ^ swz(q4)) * 16) + (p4 & 1) * 8; }
__device__ __forceinline__ bf16x8 tr_frag(const LAS unsigned char* p, int second_rows) { const s16x4 lo = vtr(p), hi = vtr(p + second_rows * 256); return __builtin_shufflevector(lo, hi, 0, 1, 2, 3, 4, 5, 6, 7); }

__device__ __forceinline__ void chunk_gates(LAS unsigned char* lds, const float* GATES, size_t row0, int h, float bi, float bf_, int lane) {
    const float* g0 = GATES + (row0 + 2 * lane) * 8; const float* g1 = g0 + 8;
    const float x0 = logsigmoidf_(g0[4 + h] + bf_), x1 = logsigmoidf_(g1[4 + h] + bf_), i0 = g0[h] + bi, i1 = g1[h] + bi;
    float sc = x0 + x1;
#pragma unroll
    for (int o = 1; o < 64; o <<= 1) { const float y = __shfl_up(sc, o); if (lane >= o) sc += y; }
    const float F1 = sc, F0 = sc - x1, b0 = i0 - F0, b1 = i1 - F1;
    float mx = fmaxf(b0, b1);
#pragma unroll
    for (int o = 1; o < 64; o <<= 1) { const float y = __shfl_up(mx, o); if (lane >= o) mx = fmaxf(mx, y); }
    float pm = __shfl_up(mx, 1); if (lane == 0) pm = -INFINITY;
    LAS float* F = (LAS float*)(lds + L_F); LAS float* B = (LAS float*)(lds + L_B); LAS float* M = (LAS float*)(lds + L_M);
    F[2 * lane] = F0; F[2 * lane + 1] = F1; B[2 * lane] = b0; B[2 * lane + 1] = b1; M[2 * lane] = fmaxf(pm, b0); M[2 * lane + 1] = mx;
}

struct TensorsA { const bf16* ZB; const float* GATES; const float* b_i; const float* b_f; float* G; float* U; float* DC; float* DN; };
__device__ __forceinline__ void unit_a(LAS unsigned char* lds, const TensorsA& T, int ci) {
    int tid_ = threadIdx.x; asm volatile("" : "+v"(tid_)); const int tid = tid_, lane = tid & 63, w = __builtin_amdgcn_readfirstlane(tid >> 6), q32 = lane & 31, hf = lane >> 5;
    const int bh = ci / NCH, c = ci % NCH, b = bh / LH, h = bh % LH;
    const size_t row0 = (size_t)b * SP + (size_t)c * LC;
    __syncthreads();
    if (w == 0) chunk_gates(lds, T.GATES, row0, h, T.b_i[h], T.b_f[h], lane);
    u32x4 sk[4], sv[4];
#pragma unroll
    for (int j = 0; j < 4; ++j) { const int id = tid + 512 * j, r = id >> 4, c16 = id & 15; const bf16* z = T.ZB + (row0 + r) * 3072 + h * 128 + c16 * 8; sk[j] = *(const u32x4*)(z + ZK); sv[j] = *(const u32x4*)(z + ZV); }
    __syncthreads();
    const float Mx = *(const LAS float*)(lds + L_M + 127 * 4);
#pragma unroll
    for (int j = 0; j < 4; ++j) { const int id = tid + 512 * j, r = id >> 4, c16 = id & 15;
        const float wgt = __expf(*(const LAS float*)(lds + L_B + r * 4) - Mx);
        u32x4 kw;
#pragma unroll
        for (int e = 0; e < 4; ++e) kw[e] = cvtpk(bf2f((unsigned short)(sk[j][e] & 0xffff)) * wgt, bf2f((unsigned short)(sk[j][e] >> 16)) * wgt);
        *(LAS u32x4*)(lds + L_V + tr_dst(r, c16)) = kw; *(LAS u32x4*)(lds + L_C + tr_dst(r, c16)) = sv[j]; }
    __syncthreads();
    const int dkb = w >> 1, dvb0 = 2 * (w & 1);
    const int oa = tr_off(lane, dkb) + 8 * hf * 256, ob0 = tr_off(lane, dvb0) + 8 * hf * 256, ob1 = tr_off(lane, dvb0 + 1) + 8 * hf * 256;
    f32x16 a0, a1;
#pragma unroll
    for (int i = 0; i < 16; ++i) { a0[i] = 0.f; a1[i] = 0.f; }
#pragma unroll
    for (int ks = 0; ks < 8; ++ks) { const bf16x8 fa = tr_frag(lds + L_V + ks * 16 * 256 + oa, 4), fb0 = tr_frag(lds + L_C + ks * 16 * 256 + ob0, 4), fb1 = tr_frag(lds + L_C + ks * 16 * 256 + ob1, 4);
        a0 = ML_MFMA(fa, fb0, a0); a1 = ML_MFMA(fa, fb1, a1); }
    float* dc = T.DC + (size_t)ci * DK * DV;
#pragma unroll
    for (int i = 0; i < 16; ++i) { const int dk = 32 * dkb + crow(i, hf); dc[(size_t)dk * DV + 32 * dvb0 + q32] = a0[i]; dc[(size_t)dk * DV + 32 * dvb0 + 32 + q32] = a1[i]; }
    if (tid < DK) { float s = 0.f; const int c16 = tid >> 3, e = tid & 7;
        for (int r = 0; r < LC; ++r) s += bf2f(*(const LAS unsigned short*)(lds + L_V + tr_dst(r, c16) + e * 2));
        T.DN[(size_t)ci * DK + tid] = s; }
    if (tid == 0) { const float g = *(const LAS float*)(lds + L_F + 127 * 4); T.G[ci] = g; T.U[ci] = g + Mx; }
}

struct TensorsC { const bf16* ZB; const float* GATES; const float* b_i; const float* b_f; const float* CS; const float* NS; const float* MSs; const float* gn; bf16* YCAT; };
__device__ __forceinline__ void unit_c(LAS unsigned char* lds, const TensorsC& T, int ci) {
    int tid_ = threadIdx.x; asm volatile("" : "+v"(tid_)); const int tid = tid_, lane = tid & 63, w = __builtin_amdgcn_readfirstlane(tid >> 6), q32 = lane & 31, hf = lane >> 5;
    const int bh = ci / NCH, c = ci % NCH, b = bh / LH, h = bh % LH;
    const size_t row0 = (size_t)b * SP + (size_t)c * LC;
    __syncthreads();
    if (w == 0) chunk_gates(lds, T.GATES, row0, h, T.b_i[h], T.b_f[h], lane);
    if (tid >= 64 && tid < 64 + DK) *(LAS float*)(lds + L_N + (tid - 64) * 4) = T.NS[(size_t)ci * DK + tid - 64];
#pragma unroll
    for (int j = 0; j < 4; ++j) { const int id = tid + 512 * j, r = id >> 4, c16 = id & 15; const bf16* z = T.ZB + (row0 + r) * 3072 + h * 128 + c16 * 8;
        const u32x4 q = *(const u32x4*)(z + ZQ), k = *(const u32x4*)(z + ZK), v = *(const u32x4*)(z + ZV);
        *(LAS u32x4*)(lds + L_Q + r * RP + c16 * 16) = q; *(LAS u32x4*)(lds + L_K + r * RP + c16 * 16) = k; *(LAS u32x4*)(lds + L_V + tr_dst(r, c16)) = v; }
    {   const float* cs = T.CS + (size_t)ci * DK * DV;
#pragma unroll
        for (int j = 0; j < 8; ++j) { const int id = tid + 512 * j, r = id >> 5, c4 = (id & 31) * 4; const f32x4 x = *(const f32x4*)(cs + (size_t)r * DV + c4);
            u32x2 y; y.x = cvtpk(x[0], x[1]); y.y = cvtpk(x[2], x[3]);
            *(LAS u32x2*)(lds + L_C + tr_dst(r, c4 >> 3) + (c4 & 7) * 2) = y; } }
    __syncthreads();
    const int tb = w >> 1, dh = w & 1, t = 32 * tb + q32;
    const float mprev = T.MSs[ci];
    const float mu = fmaxf(mprev, *(const LAS float*)(lds + L_M + t * 4)), a_t = __expf(mprev - mu), m_t = *(const LAS float*)(lds + L_F + t * 4) + mu;
    bf16x8 qf[8]; float qn = 0.f;
#pragma unroll
    for (int ks = 0; ks < 8; ++ks) { qf[ks] = *(const LAS bf16x8*)(lds + L_Q + t * RP + ks * 32 + hf * 16);
#pragma unroll
        for (int e = 0; e < 8; ++e) qn += bf2f((unsigned short)qf[ks][e]) * *(const LAS float*)(lds + L_N + (16 * ks + 8 * hf + e) * 4); }
    qn += __shfl_xor(qn, 32);
    const int oc0 = tr_off(lane, 2 * dh) + 8 * hf * 256, oc1 = tr_off(lane, 2 * dh + 1) + 8 * hf * 256;
    f32x16 acc0, acc1;
#pragma unroll
    for (int i = 0; i < 16; ++i) { acc0[i] = 0.f; acc1[i] = 0.f; }
#pragma unroll
    for (int ks = 0; ks < 8; ++ks) { acc0 = ML_MFMA(tr_frag(lds + L_C + ks * 16 * 256 + oc0, 4), qf[ks], acc0); acc1 = ML_MFMA(tr_frag(lds + L_C + ks * 16 * 256 + oc1, 4), qf[ks], acc1); }
#pragma unroll
    for (int i = 0; i < 16; ++i) { acc0[i] *= a_t; acc1[i] *= a_t; }
    const int ov0 = tr_off(lane, 2 * dh) + 4 * hf * 256, ov1 = tr_off(lane, 2 * dh + 1) + 4 * hf * 256;
    float den = 0.f;
    for (int sb = 0; sb <= tb; ++sb) {
        f32x16 s;
#pragma unroll
        for (int i = 0; i < 16; ++i) s[i] = 0.f;
        const LAS unsigned char* ka = lds + L_K + (32 * sb + q32) * RP + hf * 16;
#pragma unroll
        for (int ks = 0; ks < 8; ++ks) s = ML_MFMA(*(const LAS bf16x8*)(ka + ks * 32), qf[ks], s);
#pragma unroll
        for (int i = 0; i < 16; ++i) { const int sidx = 32 * sb + crow(i, hf); const float wg = sidx <= t ? __expf(*(const LAS float*)(lds + L_B + sidx * 4) - mu) : 0.f; s[i] *= wg; den += s[i]; }
        const bf16x8 p0 = pa::pack8(s, 0), p1 = pa::pack8(s, 1);
        const LAS unsigned char* vb = lds + L_V + (32 * sb) * 256;
        acc0 = ML_MFMA(tr_frag(vb + ov0, 8), p0, acc0); acc1 = ML_MFMA(tr_frag(vb + ov1, 8), p0, acc1);
        acc0 = ML_MFMA(tr_frag(vb + 16 * 256 + ov0, 8), p1, acc0); acc1 = ML_MFMA(tr_frag(vb + 16 * 256 + ov1, 8), p1, acc1);
    }
    den += __shfl_xor(den, 32);
    den += a_t * qn;
    const float inv = 1.f / fmaxf(fabsf(den), __expf(-m_t));
    const size_t row = row0 + t;
    const bf16* zo = T.ZB + row * 3072 + ZO + h * 128 + 64 * dh + 4 * hf; const bf16* zz = T.ZB + row * 3072 + ZZ + h * 128 + 64 * dh + 4 * hf;
    float sum = 0.f, ssq = 0.f;
#pragma unroll
    for (int j = 0; j < 2; ++j)
#pragma unroll
        for (int g = 0; g < 4; ++g) { const u32x2 o = *(const u32x2*)(zo + 32 * j + 8 * g); f32x16& a = j == 0 ? acc0 : acc1;
            a[4 * g] = a[4 * g] * inv * sigmoidf_(bf2f((unsigned short)(o.x & 0xffff))); a[4 * g + 1] = a[4 * g + 1] * inv * sigmoidf_(bf2f((unsigned short)(o.x >> 16)));
            a[4 * g + 2] = a[4 * g + 2] * inv * sigmoidf_(bf2f((unsigned short)(o.y & 0xffff))); a[4 * g + 3] = a[4 * g + 3] * inv * sigmoidf_(bf2f((unsigned short)(o.y >> 16)));
            sum += (a[4 * g] + a[4 * g + 1]) + (a[4 * g + 2] + a[4 * g + 3]); ssq += (a[4 * g] * a[4 * g] + a[4 * g + 1] * a[4 * g + 1]) + (a[4 * g + 2] * a[4 * g + 2] + a[4 * g + 3] * a[4 * g + 3]); }
    sum += __shfl_xor(sum, 32); ssq += __shfl_xor(ssq, 32);
    LAS float* X = (LAS float*)(lds + L_X);
    if (hf == 0) { X[(t * 2 + dh) * 2] = sum; X[(t * 2 + dh) * 2 + 1] = ssq; }
    __syncthreads();
    sum += X[(t * 2 + (dh ^ 1)) * 2]; ssq += X[(t * 2 + (dh ^ 1)) * 2 + 1];
    const float mean = sum * (1.f / DV), var = fmaxf(ssq * (1.f / DV) - mean * mean, 0.f), rs = rsqrtf(var + EPS);
    const float* gnp = T.gn + h * 128 + 64 * dh + 4 * hf; bf16* yo = T.YCAT + row * 1024 + h * 128 + 64 * dh + 4 * hf;
#pragma unroll
    for (int j = 0; j < 2; ++j)
#pragma unroll
        for (int g = 0; g < 4; ++g) { const u32x2 z = *(const u32x2*)(zz + 32 * j + 8 * g); const f32x4 gv = *(const f32x4*)(gnp + 32 * j + 8 * g); const f32x16& a = j == 0 ? acc0 : acc1;
            u32x2 r; r.x = cvtpk((a[4 * g] - mean) * rs * gv[0] * siluf_(bf2f((unsigned short)(z.x & 0xffff))), (a[4 * g + 1] - mean) * rs * gv[1] * siluf_(bf2f((unsigned short)(z.x >> 16))));
            r.y = cvtpk((a[4 * g + 2] - mean) * rs * gv[2] * siluf_(bf2f((unsigned short)(z.y & 0xffff))), (a[4 * g + 3] - mean) * rs * gv[3] * siluf_(bf2f((unsigned short)(z.y >> 16))));
            *(u32x2*)(yo + 32 * j + 8 * g) = r; }
}
}
#define XB_TMO      128
#define XB_XCNT(j)  (256  + 64 * (j))
#define XB_XSUB(j)  (1280 + 64 * (j))
#define XB_XGEN(j)  (2304 + 64 * (j))
#define XB_TOP      3328
#define XB_TOPGEN   3392
#define XCD_BAR_WORDS 3456
#define XB_SPIN_CAP (1u << 18)
#define LAS __attribute__((address_space(3)))

__device__ __forceinline__ unsigned xb_ld(unsigned* p)              { return __hip_atomic_load(p, __ATOMIC_RELAXED, __HIP_MEMORY_SCOPE_AGENT); }
__device__ __forceinline__ unsigned xb_add(unsigned* p, unsigned v) { return __hip_atomic_fetch_add(p, v, __ATOMIC_RELAXED, __HIP_MEMORY_SCOPE_AGENT); }
__device__ __forceinline__ unsigned xb_xcc_id() { return (unsigned)__builtin_amdgcn_s_getreg((3 << 11) | 20) & 0xFu; }
#define XB_SPIN(cond, bar) do { unsigned _sp = 0; while (cond) { __builtin_amdgcn_s_sleep(1); \
    if ((++_sp & 255u) == 0u) { if (xb_ld(&(bar)[XB_TMO])) break; if (_sp > XB_SPIN_CAP) { atomicAdd(&(bar)[XB_TMO], 1u); break; } } } } while (0)

struct XcdBarrier {
    unsigned* bar; unsigned x;
    volatile LAS unsigned* st;
};

__device__ __forceinline__ XcdBarrier xcd_barrier_post(unsigned* bar, volatile LAS unsigned* st) {
    XcdBarrier b; b.bar = bar; b.x = xb_xcc_id(); b.st = st;
    if (threadIdx.x == 0) (void)xb_add(&bar[XB_XCNT(b.x)], 1u);
    return b;
}
__device__ __forceinline__ void xcd_barrier_complete(unsigned* bar, unsigned x, unsigned& nloc, unsigned& nx) {
    const unsigned G = gridDim.x * gridDim.y * gridDim.z;
    unsigned sum, cnt, mine, sp = 0u;
    for (;;) {
        sum = 0u; cnt = 0u; mine = 0u;
#pragma unroll
        for (unsigned j = 0; j < 16; ++j) { const unsigned c = xb_ld(&bar[XB_XCNT(j)]); sum += c; cnt += (c > 0u) ? 1u : 0u; mine = (j == x) ? c : mine; }
        if (sum == G) break;
        __builtin_amdgcn_s_sleep(1);
        if ((++sp & 255u) == 0u) { if (xb_ld(&bar[XB_TMO])) break; if (sp > XB_SPIN_CAP) { atomicAdd(&bar[XB_TMO], 1u); break; } }
    }
    nloc = mine > 0u ? mine : 1u; nx = cnt > 0u ? cnt : 1u;
}

__device__ __forceinline__ void xcd_barrier(const XcdBarrier& b) {
    asm volatile("s_waitcnt vmcnt(0)" ::: "memory");
    __syncthreads();
    if (threadIdx.x == 0) {
        unsigned* bar = b.bar;
        __builtin_amdgcn_s_waitcnt(0);
        unsigned nloc = b.st[0], nx = b.st[1];
        if (nloc == 0u) { xcd_barrier_complete(bar, b.x, nloc, nx); b.st[0] = nloc; b.st[1] = nx; }
        const unsigned old = xb_add(&bar[XB_XSUB(b.x)], 1u);
        const unsigned gen = old / nloc;
        if (old + 1u == (gen + 1u) * nloc) {
            __builtin_amdgcn_fence(__ATOMIC_RELEASE, "agent");
            asm volatile("s_waitcnt vmcnt(0)" ::: "memory");
            const unsigned og = xb_add(&bar[XB_TOP], 1u);
            const unsigned tg = og / nx;
            if (og + 1u == (tg + 1u) * nx) xb_add(&bar[XB_TOPGEN], 1u);
            else XB_SPIN(xb_ld(&bar[XB_TOPGEN]) == tg, bar);
            __builtin_amdgcn_fence(__ATOMIC_ACQUIRE, "agent");
            xb_add(&bar[XB_XGEN(b.x)], 1u);
            asm volatile("s_waitcnt vmcnt(0)" ::: "memory");
        } else {
            XB_SPIN(xb_ld(&bar[XB_XGEN(b.x)]) == gen, bar);
            __builtin_amdgcn_fence(__ATOMIC_ACQUIRE, "agent");
            asm volatile("s_waitcnt vmcnt(0)" ::: "memory");
        }
    }
    __syncthreads();
}
constexpr int FW_LDS = 147456, FW_MISC = FW_LDS - 64;
constexpr int NPH = 8;
struct FwdParams {
    const float *xp, *xs, *cp, *cs, *cache_ckv, *cache_kr, *st_C, *st_n, *st_m; const int* page_table;
    const float *w_ada, *b_ada, *w_in, *b_i, *b_f, *ml_gn, *qnorm, *kvnorm, *w_uq, *w_uk, *w_uv, *w_out, *ln_g, *ln_b;
    float* out; unsigned char* ws; int ph_lo, ph_hi;
};
struct WsPtrs {
    unsigned* bar; float* MOD; float* ROPET; bf16 *WIN, *WUQ, *WKV, *WOUT, *WUKB, *H, *ZB; float* GATES; bf16 *CKVR, *CQR; float *SSKV, *SSQ; bf16 *KRB, *Q96, *KVB;
    float *HML, *MLG, *MLU, *MLDC, *MLDN, *MLCS, *MLNS, *MLMS; bf16* YCAT; float *OUT, *PARTO, *PARTML;
};
constexpr size_t WS_BAR = 64 * 1024;

__device__ __forceinline__ void job_mod(LAS unsigned char* lds, const FwdParams& P, float* MOD, int vcu, int G) {
    int tid_ = threadIdx.x; asm volatile("" : "+v"(tid_)); const int tid = tid_, lane = tid & 63, w = __builtin_amdgcn_readfirstlane(tid >> 6), half = w >> 2, kq = w & 3;
    LAS float* part = (LAS float*)lds;
    for (int it = vcu; it < 240; it += G) {
        const int item = 2 * it + half, cb = item % 48, rg = item / 48, n = cb * 64 + lane, r0 = rg * 13;
        float acc[13];
#pragma unroll
        for (int i = 0; i < 13; ++i) acc[i] = 0.f;
        for (int k = kq * 256; k < kq * 256 + 256; ++k) {
            const float wv = P.w_ada[(size_t)k * 3072 + n];
#pragma unroll
            for (int i = 0; i < 13; ++i) { const int r = r0 + i; const float cv = r < 2 ? P.cp[r * D + k] : P.cs[(size_t)(r - 2) * D + k]; acc[i] += cv * wv; }
        }
        __syncthreads();
#pragma unroll
        for (int i = 0; i < 13; ++i) part[((half * 4 + kq) * 13 + i) * 64 + lane] = acc[i];
        __syncthreads();
        for (int e = tid; e < 2 * 13 * 64; e += 512) { const int hh = e / (13 * 64), i = (e / 64) % 13, l = e & 63; const int item2 = 2 * it + hh, cb2 = item2 % 48, rg2 = item2 / 48, nn = cb2 * 64 + l;
            const float s = (part[((hh * 4 + 0) * 13 + i) * 64 + l] + part[((hh * 4 + 1) * 13 + i) * 64 + l]) + (part[((hh * 4 + 2) * 13 + i) * 64 + l] + part[((hh * 4 + 3) * 13 + i) * 64 + l]);
            MOD[(size_t)(rg2 * 13 + i) * 3072 + nn] = s + P.b_ada[nn]; }
    }
    __syncthreads();
}
__device__ __forceinline__ void wt_item(const float* W, int ldw, int K, int nblk, bf16* WT, int mode, const float* gain, LAS float* scr, int item, int lane) {
    const int kb = item / nblk, nb = item % nblk, k0 = 64 * kb, n0 = 32 * nb;
    const int n = n0 + (lane & 31), src = mode ? zsrc(n) : n; const float cs = (mode && n >= ZK && n < ZV) ? KSCALE : 1.f;
#pragma unroll 8
    for (int i = 0; i < 32; ++i) { const int kk = 2 * i + (lane >> 5); scr[kk * 33 + (lane & 31)] = src >= 0 ? W[(size_t)(k0 + kk) * ldw + src] * cs * (gain ? gain[k0 + kk] : 1.f) : 0.f; }
    asm volatile("s_waitcnt lgkmcnt(0)" ::: "memory");
    const int c = lane & 7;
#pragma unroll
    for (int j = 0; j < 4; ++j) { const int nn = (lane >> 3) + 8 * j; const LAS float* s = scr + (8 * c) * 33 + nn;
        uint4 o; o.x = f2bf(s[0]) | ((unsigned)f2bf(s[33]) << 16); o.y = f2bf(s[2 * 33]) | ((unsigned)f2bf(s[3 * 33]) << 16); o.z = f2bf(s[4 * 33]) | ((unsigned)f2bf(s[5 * 33]) << 16); o.w = f2bf(s[6 * 33]) | ((unsigned)f2bf(s[7 * 33]) << 16);
        *(uint4*)(WT + (size_t)(n0 + nn) * K + k0 + 8 * c) = o; }
    asm volatile("s_waitcnt lgkmcnt(0)" ::: "memory");
}
__device__ __forceinline__ void job_weights(LAS unsigned char* lds, const FwdParams& P, const WsPtrs& W, int vcu, int G) {
    int tid_ = threadIdx.x; asm volatile("" : "+v"(tid_)); const int tid = tid_, lane = tid & 63, w = __builtin_amdgcn_readfirstlane(tid >> 6);
    LAS float* scr = (LAS float*)(lds + 32768 + w * 8448);
    const int gw = vcu * 8 + w, NGW = G * 8;
    constexpr int I_IN = 16 * 120, I_UQ = 6 * 24, I_UK = 4 * 16, I_UV = 4 * 16, I_OUT = 16 * 32, NIT = I_IN + I_UQ + I_UK + I_UV + I_OUT;
    for (int it = gw; it < NIT; it += NGW) {
        int r = it;
        if (r < I_IN) { wt_item(P.w_in, NIN, D, 120, W.WIN, 1, nullptr, scr, r, lane); continue; } r -= I_IN;
        if (r < I_UQ) { wt_item(P.w_uq, MH * QHD, QL, 24, W.WUQ, 0, P.qnorm, scr, r, lane); continue; } r -= I_UQ;
        if (r < I_UK) { wt_item(P.w_uk, 512, KVL, 16, W.WKV, 0, P.kvnorm, scr, r, lane); continue; } r -= I_UK;
        if (r < I_UV) { wt_item(P.w_uv, 512, KVL, 16, W.WKV + (size_t)512 * KVL, 0, P.kvnorm, scr, r, lane); continue; } r -= I_UV;
        wt_item(P.w_out, D, D, 32, W.WOUT, 0, nullptr, scr, r, lane);
    }
    const int gt = vcu * 512 + tid, NGT = G * 512;
    for (int i = gt; i < KVL * 512 / 4; i += NGT) { const f32x4v v = *(const f32x4v*)(P.w_uk + 4 * (size_t)i); ushort4 o; o.x = f2bf(v.x); o.y = f2bf(v.y); o.z = f2bf(v.z); o.w = f2bf(v.w); *(ushort4*)(W.WUKB + 4 * (size_t)i) = o; }
    for (int i = gt; i < (PAST + DS) * 16; i += NGT) { const int pos = i >> 4, j = i & 15; const float inv = powf(10000.f, -(float)j / 16.f), ang = (float)pos * inv; float sn, cs; sincosf(ang, &sn, &cs);
        W.ROPET[pos * 32 + j] = cs; W.ROPET[pos * 32 + 16 + j] = sn; }
}
__device__ __forceinline__ void job_hprep(const FwdParams& P, const WsPtrs& W, int vcu, int G) {
    const size_t gt = (size_t)vcu * 512 + threadIdx.x, NGT = (size_t)G * 512;
    for (size_t i4 = gt; i4 < (size_t)MT * 256; i4 += NGT) {
        const int m = (int)(i4 >> 8), c = (int)(i4 & 255) * 4;
        const float* x = m < MP ? P.xp + (size_t)m * D : P.xs + (size_t)(m - MP) * D; const float* mr = W.MOD + (size_t)row_modrow(m) * 3072;
        const f32x4v xv = *(const f32x4v*)(x + c), sh = *(const f32x4v*)(mr + c), sc = *(const f32x4v*)(mr + 1024 + c);
        ushort4 o; o.x = f2bf(xv.x * (1.f + sc.x) + sh.x); o.y = f2bf(xv.y * (1.f + sc.y) + sh.y); o.z = f2bf(xv.z * (1.f + sc.z) + sh.z); o.w = f2bf(xv.w * (1.f + sc.w) + sh.w);
        *(ushort4*)(W.H + (size_t)m * D + c) = o; }
}
__device__ __forceinline__ void job_rows_ckv(const FwdParams& P, const WsPtrs& W, int vcu, int G) {
    const int lane = threadIdx.x & 63, gw = vcu * 8 + (threadIdx.x >> 6), NGW = G * 8;
    for (int m = gw; m < MT; m += NGW) {
        const float4 p = *(const float4*)(W.SSKV + (size_t)m * 4); const float r = rsqrtf(((p.x + p.y) + (p.z + p.w)) * (1.f / KVL) + EPS);
        const ushort4 v = *(const ushort4*)(W.CKVR + (size_t)m * KVL + 4 * lane); const float4 g = *(const float4*)(P.kvnorm + 4 * lane);
        float* o = m < MP ? P.out + O_CKVP + (size_t)m * KVL : P.out + O_CKVS + (size_t)(m - MP) * KVL;
        *(float4*)(o + 4 * lane) = make_float4(bf2f(v.x) * r * g.x, bf2f(v.y) * r * g.y, bf2f(v.z) * r * g.z, bf2f(v.w) * r * g.w); }
}
namespace mls {
constexpr int O_Q = 0, O_K = 4096, O_V = 8192, O_QC = 12288, O_F = 28672, O_IG = O_F + 32, O_MT = O_IG + 32, O_A = O_MT + 32, O_WL = O_A + 32, O_DEN = O_WL + 32, O_S = O_DEN + 32, HALF_BYTES = O_S + 256;
__device__ __forceinline__ void pair(LAS unsigned char* lds, const FwdParams& P, const WsPtrs& W, int u0) {
    int tid_ = threadIdx.x; asm volatile("" : "+v"(tid_)); const int tid = tid_, hw = tid >> 8, t8 = tid & 255, u = u0 + hw, b = u / LH, h = u % LH;
    LAS unsigned char* L = lds + hw * HALF_BYTES;
    LAS float* s_q = (LAS float*)(L + O_Q); LAS float* s_k = (LAS float*)(L + O_K); LAS float* s_v = (LAS float*)(L + O_V); LAS float* s_qc = (LAS float*)(L + O_QC);
    LAS float* s_F = (LAS float*)(L + O_F); LAS float* s_ig = (LAS float*)(L + O_IG); LAS float* s_mt = (LAS float*)(L + O_MT); LAS float* s_a = (LAS float*)(L + O_A);
    LAS float* s_wl = (LAS float*)(L + O_WL); LAS float* s_den = (LAS float*)(L + O_DEN); LAS float* s_S = (LAS float*)(L + O_S);
    const size_t row0 = (size_t)MP + (size_t)b * DS;
    __syncthreads();
    for (int e = t8; e < DS * DK; e += 256) { const int t = e >> 7, d = e & 127; const bf16* z = W.ZB + (row0 + t) * 3072;
        s_q[e] = bf2f(z[ZQ + h * DK + d]); s_k[e] = bf2f(z[ZK + h * DK + d]); s_v[e] = bf2f(z[ZV + h * DV + d]); }
    if (t8 < DS) { const float* z = W.GATES + (row0 + t8) * 8; s_ig[t8] = z[h] + P.b_i[h]; s_F[t8] = logsigmoidf_(z[4 + h] + P.b_f[h]); }
    __syncthreads();
    const float mprev = P.st_m[u];
    if (t8 == 0) { float f = 0.f; for (int s = 0; s < DS; ++s) { f += s_F[s]; s_F[s] = f; }
        for (int t = 0; t < DS; ++t) { float mt = s_F[t] + mprev; for (int s = 0; s <= t; ++s) mt = fmaxf(mt, s_F[t] - s_F[s] + s_ig[s]); s_mt[t] = mt; s_a[t] = __expf(s_F[t] + mprev - mt); }
        for (int s = 0; s < DS; ++s) s_wl[s] = __expf(s_F[DS - 1] - s_F[s] + s_ig[s] - s_mt[DS - 1]); }
    __syncthreads();
    if (t8 < DS * DS) { const int t = t8 >> 3, s = t8 & 7; float v = 0.f;
        if (s <= t) { float dot = 0.f; for (int d = 0; d < DK; ++d) dot += s_q[t * DK + d] * s_k[s * DK + d]; v = dot * __expf(s_F[t] - s_F[s] + s_ig[s] - s_mt[t]); }
        s_S[t8] = v; }
    __syncthreads();
    const int dv = t8 & 127, hf2 = t8 >> 7;
    const float* c0 = P.st_C + (size_t)u * DK * DV; float* cn = P.out + O_CS + (size_t)u * DK * DV;
    const float al = s_a[DS - 1];
    float qc[DS];
#pragma unroll
    for (int t = 0; t < DS; ++t) qc[t] = 0.f;
    for (int d = hf2 * 64; d < hf2 * 64 + 64; ++d) {
        const float cv = c0[(size_t)d * DV + dv]; float nv = al * cv;
#pragma unroll
        for (int t = 0; t < DS; ++t) { qc[t] += s_q[t * DK + d] * cv; nv += s_wl[t] * s_k[t * DK + d] * s_v[t * DV + dv]; }
        cn[(size_t)d * DV + dv] = nv;
    }
#pragma unroll
    for (int t = 0; t < DS; ++t) s_qc[(hf2 * DS + t) * DV + dv] = qc[t];
    if (t8 < DS) { const int t = t8; float dn = 0.f; for (int s = 0; s <= t; ++s) dn += s_S[t * DS + s]; float qn = 0.f; const float* nn = P.st_n + (size_t)u * DK;
        for (int d = 0; d < DK; ++d) qn += s_q[t * DK + d] * nn[d]; s_den[t] = dn + s_a[t] * qn; }
    if (t8 >= 128 && t8 < 128 + DK) { const int d = t8 - 128; float nv = al * P.st_n[(size_t)u * DK + d];
        for (int s = 0; s < DS; ++s) nv += s_wl[s] * s_k[s * DK + d]; P.out[O_NS + (size_t)u * DK + d] = nv; }
    if (t8 == 0) P.out[O_MS + u] = s_mt[DS - 1];
    __syncthreads();
    for (int e = t8; e < DS * DV; e += 256) { const int t = e >> 7, d = e & 127; float num = s_a[t] * (s_qc[(0 * DS + t) * DV + d] + s_qc[(1 * DS + t) * DV + d]);
        for (int s = 0; s <= t; ++s) num += s_S[t * DS + s] * s_v[s * DV + d];
        W.HML[(row0 + t) * 512 + h * DV + d] = num / fmaxf(fabsf(s_den[t]), __expf(-s_mt[t])); }
}
}
__device__ __forceinline__ void job_ml_scan(const FwdParams& P, const WsPtrs& W, int vcu, int G) {
    const int gt = vcu * 512 + threadIdx.x, NGT = G * 512;
    for (int gid = gt; gid < BP * LH * (DK * DV + DK); gid += NGT) {
        const int bh = gid / (DK * DV + DK), e = gid % (DK * DV + DK);
        float m = -INFINITY, x = 0.f;
        for (int c = 0; c < NCH; ++c) {
            const int ci = bh * NCH + c;
            if (e < DK * DV) W.MLCS[(size_t)ci * DK * DV + e] = x; else W.MLNS[(size_t)ci * DK + (e - DK * DV)] = x;
            if (e == 0) W.MLMS[ci] = m;
            const float g = W.MLG[ci], u = W.MLU[ci], mn = fmaxf(g + m, u), al = __expf(g + m - mn), be = __expf(u - mn);
            const float d = e < DK * DV ? W.MLDC[(size_t)ci * DK * DV + e] : W.MLDN[(size_t)ci * DK + (e - DK * DV)];
            x = al * x + be * d; m = mn;
        }
        if (e < DK * DV) P.out[O_CP + (size_t)bh * DK * DV + e] = x; else P.out[O_NP + (size_t)bh * DK + (e - DK * DV)] = x;
        if (e == 0) P.out[O_MPR + bh] = m;
    }
}
__device__ __forceinline__ void job_sample_back(LAS unsigned char* lds, const FwdParams& P, const WsPtrs& W, int vcu, int G) {
    LAS float* os = (LAS float*)lds;
    int tid_ = threadIdx.x; asm volatile("" : "+v"(tid_)); const int tid = tid_, h = tid >> 6, lane = tid & 63;
    for (int ms = vcu; ms < MS; ms += G) {
        const int b = ms >> 3, t = ms & 7, m = MP + ms;
        __syncthreads();
        for (int e = tid; e < MH * KVL; e += 512) { const int hh = e >> 8, c = e & 255, q = hh * 8 + t;
            float mm = -INFINITY;
            for (int sp = 0; sp < sa::NSPLIT; ++sp) mm = fmaxf(mm, W.PARTML[(size_t)(b * sa::NSPLIT + sp) * 128 + q]);
            float num = 0.f, den = 0.f;
            for (int sp = 0; sp < sa::NSPLIT; ++sp) { const float* pm = W.PARTML + (size_t)(b * sa::NSPLIT + sp) * 128; const float f = exp2f(pm[q] - mm);
                num += f * W.PARTO[((size_t)(b * sa::NSPLIT + sp) * 64 + q) * KVL + c]; den += f * pm[64 + q]; }
            os[e] = num / den; }
        __syncthreads();
        float acc = 0.f;
        for (int c = 0; c < KVL; ++c) acc += os[h * KVL + c] * P.w_uv[(size_t)c * 512 + tid];
        const bf16* z = W.ZB + (size_t)m * 3072;
        W.YCAT[(size_t)m * D + 512 + tid] = f2bf(acc * siluf_(bf2f(z[ZAZ + tid])));
        if (h < LH) {
            const int c0 = h * DV + lane, c1 = c0 + 64;
            const float a0 = W.HML[(size_t)m * 512 + c0] * sigmoidf_(bf2f(z[ZO + c0])), a1 = W.HML[(size_t)m * 512 + c1] * sigmoidf_(bf2f(z[ZO + c1]));
            const float mu = wave_sum(a0 + a1) * (1.f / DV), d0 = a0 - mu, d1 = a1 - mu, var = wave_sum(d0 * d0 + d1 * d1) * (1.f / DV), r = rsqrtf(var + EPS);
            W.YCAT[(size_t)m * D + c0] = f2bf(d0 * r * P.ml_gn[c0] * siluf_(bf2f(z[ZZ + c0]))); W.YCAT[(size_t)m * D + c1] = f2bf(d1 * r * P.ml_gn[c1] * siluf_(bf2f(z[ZZ + c1])));
        }
    }
    __syncthreads();
}
__device__ __forceinline__ void job_final_ln(const FwdParams& P, const WsPtrs& W, int vcu, int G) {
    const int lane = threadIdx.x & 63, gw = vcu * 8 + (threadIdx.x >> 6), NGW = G * 8;
    for (int m = gw; m < MT; m += NGW) {
        const float* x = m < MP ? P.xp + (size_t)m * D : P.xs + (size_t)(m - MP) * D;
        const float* gate = W.MOD + (size_t)row_modrow(m) * 3072 + 2048;
        float* y = m < MP ? P.out + O_YP + (size_t)m * D : P.out + O_YS + (size_t)(m - MP) * D;
        f32x4v v[4]; float s = 0.f;
#pragma unroll
        for (int j = 0; j < 4; ++j) { const int c = 4 * lane + 256 * j; const f32x4v xv = *(const f32x4v*)(x + c), gv = *(const f32x4v*)(gate + c), ov = *(const f32x4v*)(W.OUT + (size_t)m * D + c);
            v[j] = xv * ALPHA + gv * ov; s += (v[j].x + v[j].y) + (v[j].z + v[j].w); }
        const float mu = wave_sum(s) * (1.f / D); float s2 = 0.f;
#pragma unroll
        for (int j = 0; j < 4; ++j) { v[j] = v[j] - mu; s2 += (v[j].x * v[j].x + v[j].y * v[j].y) + (v[j].z * v[j].z + v[j].w * v[j].w); }
        const float r = rsqrtf(wave_sum(s2) * (1.f / D) + EPS);
#pragma unroll
        for (int j = 0; j < 4; ++j) { const int c = 4 * lane + 256 * j; const f32x4v g = *(const f32x4v*)(P.ln_g + c), bb = *(const f32x4v*)(P.ln_b + c); *(f32x4v*)(y + c) = v[j] * r * g + bb; }
    }
}

__global__ void __launch_bounds__(512, 2) fwd_kernel(FwdParams P) {
    extern __shared__ __attribute__((aligned(16))) unsigned char lds_raw[];
    LAS unsigned char* lds = (LAS unsigned char*)lds_raw;
    int tid_ = threadIdx.x; asm volatile("" : "+v"(tid_)); const int tid = tid_, G = (int)gridDim.x, bx = (int)blockIdx.x;
    const int vcu = (G % 8 == 0) ? (bx % 8) * (G / 8) + bx / 8 : bx;
    unsigned char* ws = P.ws;
    WsPtrs W;
    W.bar = (unsigned*)(ws + WS_BAR); W.MOD = (float*)(ws + WS_MOD); W.ROPET = (float*)(ws + WS_ROPET); W.WIN = (bf16*)(ws + WS_WIN); W.WUQ = (bf16*)(ws + WS_WUQ); W.WKV = (bf16*)(ws + WS_WKV);
    W.WOUT = (bf16*)(ws + WS_WOUT); W.WUKB = (bf16*)(ws + WS_WUKB); W.H = (bf16*)(ws + WS_H); W.ZB = (bf16*)(ws + WS_ZB); W.GATES = (float*)(ws + WS_GATES); W.CKVR = (bf16*)(ws + WS_CKVR);
    W.CQR = (bf16*)(ws + WS_CQR); W.SSKV = (float*)(ws + WS_SSKV); W.SSQ = (float*)(ws + WS_SSQ); W.KRB = (bf16*)(ws + WS_KRB); W.Q96 = (bf16*)(ws + WS_Q96); W.KVB = (bf16*)(ws + WS_KVB);
    W.HML = (float*)(ws + WS_HML); W.MLG = (float*)(ws + WS_MLG); W.MLU = (float*)(ws + WS_MLU); W.MLDC = (float*)(ws + WS_MLDC); W.MLDN = (float*)(ws + WS_MLDN); W.MLCS = (float*)(ws + WS_MLCS);
    W.MLNS = (float*)(ws + WS_MLNS); W.MLMS = (float*)(ws + WS_MLMS); W.YCAT = (bf16*)(ws + WS_YCAT); W.OUT = (float*)(ws + WS_OUT); W.PARTO = (float*)(ws + WS_PARTO); W.PARTML = (float*)(ws + WS_PARTML);
    if (tid < 16) ((LAS unsigned*)(lds + FW_MISC))[tid] = 0u;
    __syncthreads();
    const int lo = P.ph_lo, hi = P.ph_hi;
    const bool one_launch = (hi - lo) > 1;
    XcdBarrier bar; bar.bar = W.bar; bar.x = 0; bar.st = nullptr;
    if (one_launch) bar = xcd_barrier_post(W.bar, (volatile LAS unsigned*)(lds + FW_MISC));
#define IN(k) (lo <= (k) && (k) < hi)
#define SEAM(k) do { if (IN(k) && IN((k) + 1)) xcd_barrier(bar); } while (0)
    if (IN(0)) { job_mod(lds, P, W.MOD, vcu, G); job_weights(lds, P, W, vcu, G); }
    SEAM(0);
    if (IN(1)) job_hprep(P, W, vcu, G);
    SEAM(1);
    if (IN(2)) {
        pg8::Gemm g{W.H, W.WIN, MT, NINP, D}; pg8::StaticOrder S; S.init(MT, NINP, G, bx);
        pg8::EpiInProj E{W.ZB, W.CKVR, W.CQR, W.SSKV, W.SSQ, W.GATES, W.KRB, P.out + O_KRP, P.out + O_KRS, W.ROPET};
        pg8::gemm_phase<pg8::EpiInProj, pg8::StaticOrder, true, true>(lds, g, S, E);
    }
    SEAM(2);
    if (IN(3)) {
        { int kk = KVL; asm volatile("" : "+s"(kk));
            pg8::Gemm g{W.CKVR, W.WKV, MP, 1024, kk}; pg8::StaticOrder S; S.init(MP, 1024, G, bx); pg8::EpiKV E{W.KVB, W.SSKV};
          pg8::gemm_phase<pg8::EpiKV, pg8::StaticOrder, true, true>(lds, g, S, E); }
        { int kk = QL; asm volatile("" : "+s"(kk));
            pg8::Gemm g{W.CQR, W.WUQ, MT, MH * QHD, kk}; pg8::StaticOrder S; S.init(MT, MH * QHD, G, bx); pg8::EpiQ E{W.Q96, W.SSQ, MLA_SCALE * LOG2E};
          pg8::gemm_phase<pg8::EpiQ, pg8::StaticOrder, true, true>(lds, g, S, E); }
        job_rows_ckv(P, W, vcu, G);
        { ml::TensorsA T{W.ZB, W.GATES, P.b_i, P.b_f, W.MLG, W.MLU, W.MLDC, W.MLDN};
          for (int ci = vcu; ci < BP * LH * NCH; ci += G) ml::unit_a(lds, T, ci); }
        for (int u0 = 2 * vcu; u0 < DB * LH; u0 += 2 * G) mls::pair(lds, P, W, u0);
    }
    SEAM(3);
    if (IN(4)) {
        job_ml_scan(P, W, vcu, G);
        { pa::Tensors T{W.Q96, W.KVB, W.KRB, W.ZB, W.ROPET, W.YCAT}; pa::phase(lds, T, vcu, G); }
        { sa::Tensors T{W.Q96, W.WUKB, P.cache_ckv, P.cache_kr, P.page_table, P.out + O_CKVS, W.KRB, W.ROPET, W.PARTO, W.PARTML}; sa::phase(lds, T, vcu, G); }
    }
    SEAM(4);
    if (IN(5)) {
        { ml::TensorsC T{W.ZB, W.GATES, P.b_i, P.b_f, W.MLCS, W.MLNS, W.MLMS, P.ml_gn, W.YCAT};
          for (int ci = vcu; ci < BP * LH * NCH; ci += G) ml::unit_c(lds, T, ci); }
        job_sample_back(lds, P, W, vcu, G);
    }
    SEAM(5);
    if (IN(6)) {
        pg8::Gemm g{W.YCAT, W.WOUT, MT, D, D}; pg8::StaticOrder S; S.init(MT, D, G, bx); pg8::EpiF32 E{W.OUT, D};
        pg8::gemm_phase<pg8::EpiF32, pg8::StaticOrder, true, true>(lds, g, S, E);
    }
    SEAM(6);
    if (IN(7)) job_final_ln(P, W, vcu, G);
#undef IN
#undef SEAM
}

#ifndef FW_N_LAUNCHES
#define FW_N_LAUNCHES 1
#endif
extern "C" void kernel_launch(void* const* d_in, const int* in_sizes, int n_in, void* d_out, int out_size, void* d_ws, size_t ws_size, hipStream_t stream) {
    static int grid = 0;
    if (grid == 0) {
        if (n_in != 24 || out_size != (int)O_END || ws_size < WS_END) { fprintf(stderr, "kernel_launch: unexpected shapes: n_in %d out %d ws %zu\n", n_in, out_size, ws_size); grid = -1; return; }
        int dev = 0, cus = 0, per_cu = 0;
        if (hipGetDevice(&dev) != hipSuccess || hipDeviceGetAttribute(&cus, hipDeviceAttributeMultiprocessorCount, dev) != hipSuccess) { fprintf(stderr, "kernel_launch: device query failed\n"); grid = -1; return; }
        if (hipFuncSetAttribute((const void*)fwd_kernel, hipFuncAttributeMaxDynamicSharedMemorySize, FW_LDS) != hipSuccess) { fprintf(stderr, "kernel_launch: hipFuncSetAttribute failed\n"); grid = -1; return; }
        if (hipOccupancyMaxActiveBlocksPerMultiprocessor(&per_cu, (const void*)fwd_kernel, 512, FW_LDS) != hipSuccess || per_cu < 1) { fprintf(stderr, "kernel_launch: occupancy query says %d blocks per CU\n", per_cu); grid = -1; return; }
        (void)hipGetLastError();
        grid = cus;
    }
    if (grid < 0) return;
    if (hipMemsetAsync((char*)d_ws + WS_CTL, 0, 1 * MiB, stream) != hipSuccess) { fprintf(stderr, "kernel_launch: memset failed\n"); return; }
    FwdParams p{};
    p.xp = (const float*)d_in[0]; p.xs = (const float*)d_in[1]; p.cp = (const float*)d_in[2]; p.cs = (const float*)d_in[3]; p.cache_ckv = (const float*)d_in[4]; p.cache_kr = (const float*)d_in[5];
    p.st_C = (const float*)d_in[6]; p.st_n = (const float*)d_in[7]; p.st_m = (const float*)d_in[8]; p.page_table = (const int*)d_in[9];
    p.w_ada = (const float*)d_in[10]; p.b_ada = (const float*)d_in[11]; p.w_in = (const float*)d_in[12]; p.b_i = (const float*)d_in[13]; p.b_f = (const float*)d_in[14]; p.ml_gn = (const float*)d_in[15];
    p.qnorm = (const float*)d_in[16]; p.kvnorm = (const float*)d_in[17]; p.w_uq = (const float*)d_in[18]; p.w_uk = (const float*)d_in[19]; p.w_uv = (const float*)d_in[20]; p.w_out = (const float*)d_in[21];
    p.ln_g = (const float*)d_in[22]; p.ln_b = (const float*)d_in[23]; p.out = (float*)d_out; p.ws = (unsigned char*)d_ws;
    for (int li = 0; li < FW_N_LAUNCHES; ++li) {
        p.ph_lo = (FW_N_LAUNCHES == 1) ? 0 : li; p.ph_hi = (FW_N_LAUNCHES == 1) ? NPH : li + 1;
        hipLaunchKernelGGL(fwd_kernel, dim3(grid), dim3(512), FW_LDS, stream, p);
        const hipError_t le = hipPeekAtLastError();
        if (le != hipSuccess) { fprintf(stderr, "kernel_launch: launch %d failed: %s\n", li, hipGetErrorName(le)); break; }
    }
}
```
